# Optimizing an MI355X kernel written in HIP

```python
import math
import jax
import jax.numpy as jnp
from jax import lax
import numpy as np

D_MODEL = 1024
BATCH = 8
SEQ = 2048
DEPTH = 2

GRID_W = 64
CTX_LEN = 256
EPS = 1e-6
NEG_BIG = -1e30

A_HEADS = 4
A_DK = 128
A_DV = 128
A_CHUNK = 64
B_HEADS = 4
B_DK = 128
B_DV = 128
B_CHUNK = 64
B_CONV = 3
C_HEADS = 4
C_DH = 64
C_DV = 2 * C_DH
Q_BLOCK = 128
ROPE_BASE = 10000.0
ROPE_PAIRS = C_DH // 4

A_QK_W = A_HEADS * A_DK
A_V_W = A_HEADS * A_DV
B_QK_W = B_HEADS * B_DK
B_V_W = B_HEADS * B_DV
B_GATE_W = 4 * B_HEADS
C_QK_W = C_HEADS * 2 * C_DH
C_V_W = C_HEADS * C_DV
BRANCH_W = 512
PROJ_WIDTHS = (A_QK_W, A_V_W, A_V_W, A_QK_W, A_QK_W,
               B_QK_W, B_QK_W, B_V_W, B_V_W, B_GATE_W,
               C_QK_W, C_QK_W, C_V_W)

N_GROUPS = 4
EXPERTS_PER_GROUP = 8
N_EXPERTS = N_GROUPS * EXPERTS_PER_GROUP
TOP_K = 2
D_EXPERT = 512
MOE_BLOCK = 128

kernel_name = 'hybrid_hgrn2_mlstm_diffattn_hmoe_dit'


def _rms_norm(x, g):
    x32 = x.astype(jnp.float32)
    y = x32 * lax.rsqrt(jnp.mean(x32 * x32, axis=-1, keepdims=True) + EPS)
    return (y * g.astype(jnp.float32)).astype(x.dtype)


def _head_rms_norm(x, g, n_heads):
    shp = x.shape
    xh = x.reshape(shp[:-1] + (n_heads, -1)).astype(jnp.float32)
    y = xh * lax.rsqrt(jnp.mean(xh * xh, axis=-1, keepdims=True) + EPS)
    return (y.reshape(shp) * g.astype(jnp.float32)).astype(x.dtype)


def _heads(t, n_heads):
    return t.reshape(t.shape[:-1] + (n_heads, -1))


def _centred_dwconv(x, w, b):
    k = w.shape[0]
    pad = k // 2
    t = x.shape[1]
    xp = jnp.pad(x, ((0, 0), (pad, k - 1 - pad), (0, 0)))
    out = b
    for j in range(k):
        out = out + xp[:, j:j + t] * w[j]
    return out


def _rope_tables(n_tokens):
    rows = n_tokens // GRID_W
    row = jnp.repeat(jnp.arange(rows, dtype=jnp.float32), GRID_W)
    col = jnp.tile(jnp.arange(GRID_W, dtype=jnp.float32), rows)
    inv = ROPE_BASE ** (-jnp.arange(ROPE_PAIRS, dtype=jnp.float32) / ROPE_PAIRS)
    ang = jnp.stack([row[:, None] * inv, col[:, None] * inv])
    return jnp.cos(ang), jnp.sin(ang)


def _axial_rope(x, cos, sin):
    p = ROPE_PAIRS
    parts = []
    for a in range(2):
        seg = x[..., a * 2 * p:(a + 1) * 2 * p]
        x1, x2 = seg[..., :p], seg[..., p:]
        ca = cos[a][None, :, None, None, :].astype(x.dtype)
        sa = sin[a][None, :, None, None, :].astype(x.dtype)
        parts.append(x1 * ca - x2 * sa)
        parts.append(x2 * ca + x1 * sa)
    return jnp.concatenate(parts, axis=-1)


def _to_chunks(t, size):
    b, n, h = t.shape[:3]
    t = t.reshape((b, n // size, size, h) + t.shape[3:])
    return jnp.moveaxis(t, (1, 3), (0, 2))


def _from_chunks(t):
    t = jnp.moveaxis(t, (0, 2), (1, 3))
    return t.reshape((t.shape[0], t.shape[1] * t.shape[2]) + t.shape[3:])


def _hgrn2_scan(q, k, v, log_f, state0, with_out):
    xs = tuple(_to_chunks(t.astype(jnp.float32), A_CHUNK) for t in (q, k, v, log_f))
    tri = jnp.tril(jnp.ones((A_CHUNK, A_CHUNK), bool))[:, :, None]

    def step(s_prev, chunk):
        qc, kc, vc, lf = chunk
        b = jnp.cumsum(lf, axis=2)
        b_end = b[:, :, -1]
        s_new = jnp.exp(b_end)[..., None] * s_prev + jnp.einsum(
            'bhlk,bhlv->bhkv', kc * jnp.exp(b_end[:, :, None] - b), vc)
        if not with_out:
            return s_new, None
        rel = jnp.where(tri, jnp.exp(jnp.minimum(b[:, :, :, None] - b[:, :, None], 0.0)), 0.0)
        scores = jnp.einsum('bhtc,bhtsc,bhsc->bhts', qc, rel, kc)
        o = jnp.einsum('bhts,bhsv->bhtv', scores, vc) + jnp.einsum(
            'bhtk,bhkv->bhtv', qc * jnp.exp(b), s_prev)
        return s_new, o

    s_fin, o = lax.scan(step, state0, xs)
    if not with_out:
        return None, s_fin
    return _from_chunks(o).astype(v.dtype), s_fin


def _mlstm_scan(q, k, v, log_i, log_f, state0, with_out):
    xs = tuple(_to_chunks(t.astype(jnp.float32), B_CHUNK) for t in (q, k, v, log_i, log_f))
    tri = jnp.tril(jnp.ones((B_CHUNK, B_CHUNK), bool))

    def step(carry, chunk):
        c_prev, n_prev, m_prev = carry
        qc, kc, vc, li, lf = chunk
        b = jnp.cumsum(lf, axis=-1)
        b_end = b[..., -1]
        w_end = b_end[..., None] - b + li
        m_new = jnp.maximum(b_end + m_prev, jnp.max(w_end, axis=-1))
        e_end = jnp.exp(w_end - m_new[..., None])
        keep = jnp.exp(b_end + m_prev - m_new)
        c_new = keep[..., None, None] * c_prev + jnp.einsum('bhl,bhlk,bhlv->bhkv', e_end, kc, vc)
        n_new = keep[..., None] * n_prev + jnp.einsum('bhl,bhlk->bhk', e_end, kc)
        if not with_out:
            return (c_new, n_new, m_new), None
        logw = jnp.where(tri, b[..., :, None] - b[..., None, :] + li[..., None, :], NEG_BIG)
        w_state = b + m_prev[..., None]
        m_t = jnp.maximum(jnp.max(logw, axis=-1), w_state)
        s = jnp.einsum('bhtk,bhsk->bhts', qc, kc) * jnp.exp(logw - m_t[..., None])
        a_state = jnp.exp(w_state - m_t)
        num = jnp.einsum('bhts,bhsv->bhtv', s, vc) + a_state[..., None] * jnp.einsum(
            'bhtk,bhkv->bhtv', qc, c_prev)
        den = jnp.sum(s, axis=-1) + a_state * jnp.einsum('bhtk,bhk->bht', qc, n_prev)
        h = num / jnp.maximum(jnp.abs(den), jnp.exp(-m_t))[..., None]
        return (c_new, n_new, m_new), h

    state, h = lax.scan(step, state0, xs)
    if not with_out:
        return None, state
    return _from_chunks(h).astype(v.dtype), state


def _diff_attend(q, k, v, lam):
    s = jnp.einsum('bqhcd,bkhcd->bhcqk', q, k).astype(jnp.float32) * (C_DH ** -0.5)
    p = jax.nn.softmax(s, axis=-1)
    a = (p[:, :, 0] - lam * p[:, :, 1]).astype(v.dtype)
    return jnp.einsum('bhqk,bkhv->bqhv', a, v)


def _token_mixer(h_ctx, h_lat, w_in, conv_w, conv_b, gate_b, lb, a_g, b_g, c_g, lam_vec, lam_init,
                 w_branch, w_gate, b_gate, w_out, rope_cos, rope_sin, with_ctx):
    bsz, t_lat, _ = h_lat.shape
    t_ctx = h_ctx.shape[1]
    bounds = np.cumsum(PROJ_WIDTHS)[:-1].tolist()
    pc = jnp.split(h_ctx @ w_in, bounds, axis=-1)
    pl = jnp.split(h_lat @ w_in, bounds, axis=-1)
    directions = ((0, lambda t: t), (1, lambda t: t[:, ::-1]))

    def hgrn_gates(z, lb_d):
        z = _heads(z, A_HEADS).astype(jnp.float32)
        lb_h = lb_d.reshape(A_HEADS, A_DK)
        log_f = jnp.logaddexp(jnp.log(lb_h), jnp.log1p(-lb_h) + jax.nn.log_sigmoid(z))
        k = (1.0 - lb_h) * jax.nn.sigmoid(-z)
        return log_f, k

    qa_c, ia_c = _heads(pc[0], A_HEADS), _heads(pc[1], A_HEADS)
    qa_l, ia_l = _heads(pl[0], A_HEADS), _heads(pl[1], A_HEADS)
    a_lat, a_ctx = 0.0, 0.0
    for d, fl in directions:
        lf_c, k_c = hgrn_gates(pc[3 + d], lb[d])
        lf_l, k_l = hgrn_gates(pl[3 + d], lb[d])
        s0 = jnp.zeros((bsz, A_HEADS, A_DK, A_DV), jnp.float32)
        o_c, s_c = _hgrn2_scan(fl(qa_c), fl(k_c), fl(ia_c), fl(lf_c), s0, with_ctx)
        o_l, _ = _hgrn2_scan(fl(qa_l), fl(k_l), fl(ia_l), fl(lf_l), s_c, True)
        a_lat = a_lat + fl(o_l)
        if with_ctx:
            a_ctx = a_ctx + fl(o_c)
    ya_lat = _head_rms_norm(a_lat.reshape(bsz, t_lat, A_V_W), a_g, A_HEADS) * jax.nn.silu(pl[2])

    def mlstm_inputs(p):
        qk = jax.nn.silu(_centred_dwconv(jnp.concatenate([p[5], p[6]], axis=-1), conv_w, conv_b))
        q, k = jnp.split(qk, 2, axis=-1)
        q = _heads(q, B_HEADS) * (B_DK ** -0.5)
        g = p[9].astype(jnp.float32).reshape(p[9].shape[:-1] + (4, B_HEADS)) + gate_b
        return q, _heads(k, B_HEADS), _heads(p[7], B_HEADS), g

    qb_c, kb_c, vb_c, gb_c = mlstm_inputs(pc)
    qb_l, kb_l, vb_l, gb_l = mlstm_inputs(pl)
    b_lat, b_ctx = 0.0, 0.0
    for d, fl in directions:
        st0 = (jnp.zeros((bsz, B_HEADS, B_DK, B_DV), jnp.float32),
               jnp.zeros((bsz, B_HEADS, B_DK), jnp.float32),
               jnp.zeros((bsz, B_HEADS), jnp.float32))
        h_c, st_c = _mlstm_scan(fl(qb_c), fl(kb_c), fl(vb_c), fl(gb_c[..., d, :]),
                                fl(jax.nn.log_sigmoid(gb_c[..., 2 + d, :])), st0, with_ctx)
        h_l, _ = _mlstm_scan(fl(qb_l), fl(kb_l), fl(vb_l), fl(gb_l[..., d, :]),
                             fl(jax.nn.log_sigmoid(gb_l[..., 2 + d, :])), st_c, True)
        b_lat = b_lat + fl(h_l)
        if with_ctx:
            b_ctx = b_ctx + fl(h_c)
    yb_lat = _head_rms_norm(b_lat.reshape(bsz, t_lat, B_V_W), b_g, B_HEADS) * jax.nn.sigmoid(pl[8])

    lam_vec = lam_vec.astype(jnp.float32)
    lam = jnp.exp(jnp.sum(lam_vec[0] * lam_vec[1])) - jnp.exp(jnp.sum(lam_vec[2] * lam_vec[3])) + lam_init
    qc_c = pc[10].reshape(bsz, t_ctx, C_HEADS, 2, C_DH)
    kc_c = pc[11].reshape(bsz, t_ctx, C_HEADS, 2, C_DH)
    vc_c = pc[12].reshape(bsz, t_ctx, C_HEADS, C_DV)
    qc_l = _axial_rope(pl[10].reshape(bsz, t_lat, C_HEADS, 2, C_DH), rope_cos, rope_sin)
    kc_l = _axial_rope(pl[11].reshape(bsz, t_lat, C_HEADS, 2, C_DH), rope_cos, rope_sin)
    vc_l = pl[12].reshape(bsz, t_lat, C_HEADS, C_DV)
    k_all = jnp.concatenate([kc_c, kc_l], axis=1)
    v_all = jnp.concatenate([vc_c, vc_l], axis=1)
    n_blk = t_lat // Q_BLOCK
    q_blocks = jnp.moveaxis(qc_l.reshape(bsz, n_blk, Q_BLOCK, C_HEADS, 2, C_DH), 1, 0)
    o_l = lax.map(lambda qq: _diff_attend(qq, k_all, v_all, lam), q_blocks)
    o_l = jnp.moveaxis(o_l, 0, 1).reshape(bsz, t_lat, C_V_W)
    yc_lat = _head_rms_norm(o_l, c_g, C_HEADS) * (1.0 - lam_init)

    def merge(h, ya, yb, yc):
        ga, gb, gc = jnp.split(jax.nn.sigmoid(h @ w_gate + b_gate), 3, axis=-1)
        y = ga * (ya @ w_branch[0]) + gb * (yb @ w_branch[1]) + gc * (yc @ w_branch[2])
        return y @ w_out

    y_lat = merge(h_lat, ya_lat, yb_lat, yc_lat)
    if not with_ctx:
        return None, y_lat
    ya_ctx = _head_rms_norm(a_ctx.reshape(bsz, t_ctx, A_V_W), a_g, A_HEADS) * jax.nn.silu(pc[2])
    yb_ctx = _head_rms_norm(b_ctx.reshape(bsz, t_ctx, B_V_W), b_g, B_HEADS) * jax.nn.sigmoid(pc[8])
    o_c = _diff_attend(qc_c, kc_c, vc_c, lam).reshape(bsz, t_ctx, C_V_W)
    yc_ctx = _head_rms_norm(o_c, c_g, C_HEADS) * (1.0 - lam_init)
    return merge(h_ctx, ya_ctx, yb_ctx, yc_ctx), y_lat


def _hier_moe(tokens, rg_w, rg_b, re_w, re_b, w1, w3, w2):
    n_tok, d = tokens.shape
    group_logits = (tokens @ rg_w + rg_b).astype(jnp.float32)
    g_idx = jnp.argmax(group_logits, axis=-1)
    p_group = jnp.take_along_axis(jax.nn.softmax(group_logits, axis=-1), g_idx[:, None], axis=-1)
    exp_logits = (tokens @ re_w + re_b).astype(jnp.float32).reshape(n_tok, N_GROUPS, EXPERTS_PER_GROUP)
    in_group = jnp.take_along_axis(exp_logits, g_idx[:, None, None], axis=1)[:, 0]
    top_p, top_i = lax.top_k(jax.nn.softmax(in_group, axis=-1), TOP_K)
    weights = p_group * top_p / jnp.sum(top_p, axis=-1, keepdims=True)
    expert = g_idx[:, None] * EXPERTS_PER_GROUP + top_i

    n_assign = n_tok * TOP_K
    flat_e = expert.reshape(-1)
    flat_tok = jnp.repeat(jnp.arange(n_tok), TOP_K)
    flat_w = weights.reshape(-1)
    order = jnp.argsort(flat_e)
    e_s, tok_s, w_s = flat_e[order], flat_tok[order], flat_w[order]
    counts = jnp.bincount(flat_e, length=N_EXPERTS)
    start = jnp.cumsum(counts) - counts
    padded = (counts + MOE_BLOCK - 1) // MOE_BLOCK * MOE_BLOCK
    p_end = jnp.cumsum(padded)
    p_start = p_end - padded
    dest = p_start[e_s] + jnp.arange(n_assign) - start[e_s]
    n_blocks = -(-n_assign // MOE_BLOCK) + N_EXPERTS
    x_disp = jnp.zeros((n_blocks * MOE_BLOCK, d), tokens.dtype).at[dest].set(tokens[tok_s])
    block_e = jnp.minimum(jnp.searchsorted(p_end, jnp.arange(n_blocks) * MOE_BLOCK, side='right'),
                          N_EXPERTS - 1)

    def expert_block(args):
        xb, e = args
        return (jax.nn.silu(xb @ w1[e]) * (xb @ w3[e])) @ w2[e]

    y_disp = lax.map(expert_block, (x_disp.reshape(n_blocks, MOE_BLOCK, d), block_e)).reshape(-1, d)
    return jnp.zeros_like(tokens).at[tok_s].add(y_disp[dest] * w_s[:, None].astype(tokens.dtype))


def setup_inputs(seed: int = 0) -> dict:
    key = jax.random.key(seed)
    ks = jax.random.split(key, 32)
    f32 = jnp.float32
    dm = D_MODEL

    def nrm(k, shape, scale):
        return jax.random.normal(k, shape, f32) * scale

    proj_w = sum(PROJ_WIDTHS)
    gate_i = nrm(ks[12], (DEPTH, 2, B_HEADS), 0.1)
    gate_f = jnp.linspace(3.0, 6.0, B_HEADS, dtype=f32) + nrm(ks[13], (DEPTH, 2, B_HEADS), 0.1)
    return {
        'x': nrm(ks[0], (BATCH, SEQ, dm), 1.0),
        'c': nrm(ks[1], (BATCH, dm), 1.0),
        'ctx': nrm(ks[2], (BATCH, CTX_LEN, dm), 1.0),
        'c_ctx': nrm(ks[3], (dm,), 1.0),
        'ada_w': nrm(ks[4], (DEPTH, dm, 6 * dm), 0.5 * dm ** -0.5),
        'ada_b': nrm(ks[5], (DEPTH, 6 * dm), 0.02),
        'norm1_g': 1.0 + nrm(ks[6], (DEPTH, dm), 0.02),
        'norm2_g': 1.0 + nrm(ks[7], (DEPTH, dm), 0.02),
        'w_in': nrm(ks[8], (DEPTH, dm, proj_w), dm ** -0.5),
        'mlstm_conv_w': nrm(ks[9], (DEPTH, B_CONV, 2 * B_QK_W), B_CONV ** -0.5),
        'mlstm_conv_b': nrm(ks[10], (DEPTH, 2 * B_QK_W), 0.02),
        'mlstm_gate_b': jnp.concatenate([gate_i, gate_f], axis=1),
        'hgrn_lb_raw': nrm(ks[11], (DEPTH, 2, A_QK_W), 0.5),
        'hgrn_norm_g': 1.0 + nrm(ks[14], (DEPTH, A_V_W), 0.02),
        'mlstm_norm_g': 1.0 + nrm(ks[15], (DEPTH, B_V_W), 0.02),
        'diff_norm_g': 1.0 + nrm(ks[16], (DEPTH, C_V_W), 0.02),
        'diff_lambda': nrm(ks[17], (DEPTH, 4, C_DH), 0.1),
        'w_branch': nrm(ks[18], (DEPTH, 3, BRANCH_W, dm), BRANCH_W ** -0.5),
        'w_gate': nrm(ks[19], (DEPTH, dm, 3 * dm), dm ** -0.5),
        'b_gate': nrm(ks[20], (DEPTH, 3 * dm), 0.02),
        'w_out': nrm(ks[21], (DEPTH, dm, dm), dm ** -0.5),
        'router_g_w': nrm(ks[22], (DEPTH, dm, N_GROUPS), dm ** -0.5),
        'router_g_b': nrm(ks[23], (DEPTH, N_GROUPS), 0.01),
        'router_e_w': nrm(ks[24], (DEPTH, dm, N_EXPERTS), dm ** -0.5),
        'router_e_b': nrm(ks[25], (DEPTH, N_EXPERTS), 0.01),
        'moe_w1': nrm(ks[26], (DEPTH, N_EXPERTS, dm, D_EXPERT), dm ** -0.5),
        'moe_w3': nrm(ks[27], (DEPTH, N_EXPERTS, dm, D_EXPERT), dm ** -0.5),
        'moe_w2': nrm(ks[28], (DEPTH, N_EXPERTS, D_EXPERT, dm), D_EXPERT ** -0.5),
        'final_g': 1.0 + nrm(ks[29], (dm,), 0.02),
    }


def reference(x, c, ctx, c_ctx, ada_w, ada_b, norm1_g, norm2_g, w_in, mlstm_conv_w, mlstm_conv_b,
              mlstm_gate_b, hgrn_lb_raw, hgrn_norm_g, mlstm_norm_g, diff_norm_g, diff_lambda, w_branch,
              w_gate, b_gate, w_out, router_g_w, router_g_b, router_e_w, router_e_b, moe_w1, moe_w3,
              moe_w2, final_g):
    bsz, t_lat, dm = x.shape
    t_ctx = ctx.shape[1]
    rope_cos, rope_sin = _rope_tables(t_lat)
    lb_cum = jnp.cumsum(jax.nn.softmax(hgrn_lb_raw.astype(jnp.float32), axis=0), axis=0)
    lower_bounds = lb_cum - lb_cum[0]
    x_lat, x_ctx = x, ctx
    for l in range(DEPTH):
        with_ctx = l < DEPTH - 1
        lam_init = 0.8 - 0.6 * math.exp(-0.3 * l)
        mod_lat = jnp.split(jax.nn.silu(c) @ ada_w[l] + ada_b[l], 6, axis=-1)
        sh1, sc1, g1, sh2, sc2, g2 = [m[:, None, :] for m in mod_lat]
        csh1, csc1, cg1, csh2, csc2, cg2 = jnp.split(jax.nn.silu(c_ctx) @ ada_w[l] + ada_b[l], 6, axis=-1)

        h_lat = _rms_norm(x_lat, norm1_g[l]) * (1.0 + sc1) + sh1
        h_ctx = _rms_norm(x_ctx, norm1_g[l]) * (1.0 + csc1) + csh1
        y_ctx, y_lat = _token_mixer(h_ctx, h_lat, w_in[l], mlstm_conv_w[l], mlstm_conv_b[l], mlstm_gate_b[l],
                                    lower_bounds[l], hgrn_norm_g[l], mlstm_norm_g[l], diff_norm_g[l],
                                    diff_lambda[l], lam_init, w_branch[l], w_gate[l], b_gate[l], w_out[l],
                                    rope_cos, rope_sin, with_ctx)
        x_lat = x_lat + g1 * y_lat
        h_lat = _rms_norm(x_lat, norm2_g[l]) * (1.0 + sc2) + sh2
        moe_params = (router_g_w[l], router_g_b[l], router_e_w[l], router_e_b[l],
                      moe_w1[l], moe_w3[l], moe_w2[l])
        if with_ctx:
            x_ctx = x_ctx + cg1 * y_ctx
            h_ctx = _rms_norm(x_ctx, norm2_g[l]) * (1.0 + csc2) + csh2
            tokens = jnp.concatenate([h_ctx.reshape(-1, dm), h_lat.reshape(-1, dm)], axis=0)
            y = _hier_moe(tokens, *moe_params)
            x_ctx = x_ctx + cg2 * y[:bsz * t_ctx].reshape(bsz, t_ctx, dm)
            x_lat = x_lat + g2 * y[bsz * t_ctx:].reshape(bsz, t_lat, dm)
        else:
            x_lat = x_lat + g2 * _hier_moe(h_lat.reshape(-1, dm), *moe_params).reshape(bsz, t_lat, dm)
    return _rms_norm(x_lat, final_g)
```

```cpp
#include <hip/hip_runtime.h>
#include <cstdio>
#include <cstdint>

#define GAS __attribute__((address_space(1)))
#define LAS __attribute__((address_space(3)))
typedef unsigned short bf16;
typedef short bf16x8 __attribute__((ext_vector_type(8)));
typedef short s16x4 __attribute__((ext_vector_type(4)));
typedef float f32x2 __attribute__((ext_vector_type(2)));
typedef float f32x4 __attribute__((ext_vector_type(4)));
typedef float f32x16 __attribute__((ext_vector_type(16)));
typedef unsigned u32x2 __attribute__((ext_vector_type(2)));
typedef unsigned u32x4 __attribute__((ext_vector_type(4)));
typedef GAS unsigned gu32;

constexpr int NB = 8, TL = 2048, TC = 256, RPB = TL + TC  , M = NB * RPB  , D = 1024;
constexpr int NP = 6144;
constexpr int NWAVES = 8, NTHR = 512;
constexpr int PA_Q = 0, PA_I = 512, PA_G = 1024, PA_F = 1536, PB_Q = 2560, PB_K = 3072, PB_V = 3584, PB_O = 4096, PC_Q = 4608, PC_K = 5120, PC_V = 5632;
constexpr int WIN_N = 6160, WIN_GATE0 = 4608;
constexpr int NEXP = 32, DEXP = 512;
constexpr int MAXSLOT = 45056;
constexpr float EPS = 1e-6f;

constexpr size_t MiB = 1u << 20;
constexpr size_t WS_CTL = 0, CTL_ZERO_BYTES = 1 * MiB;
constexpr size_t WS_MOD = 1 * MiB;
constexpr size_t WS_ROPE = 2 * MiB;
constexpr size_t WS_GATES = 3 * MiB;
constexpr size_t WS_ROUTE = 5 * MiB;
constexpr size_t WS_W = 8 * MiB;
constexpr size_t W_IN = 0, W_GP = 12 * MiB, W_BR = 20 * MiB, W_OUT = 23 * MiB, W_13 = 25 * MiB, W_2 = 89 * MiB, W_END = 121 * MiB;
constexpr size_t WS_X = WS_W + W_END;
constexpr size_t WS_H = WS_X + 72 * MiB;
constexpr size_t WS_R1 = WS_H + 36 * MiB;
constexpr size_t WS_R2 = WS_R1 + 216 * MiB;
constexpr size_t WS_END = WS_R2 + 108 * MiB;

constexpr int CW_QUEUE = 64;
constexpr int CW_ECNT = 512;
constexpr int CW_BAR = 4096;

constexpr int LDS_BYTES = 155648;
constexpr int LDSCTL_OFF = 154624;
constexpr int RING_OFF = 0;

#define RLX_AGENT __ATOMIC_RELAXED, __HIP_MEMORY_SCOPE_AGENT
#define LDS_WAIT() asm volatile("s_waitcnt lgkmcnt(0)" ::: "memory")
#define VM_WAIT() asm volatile("s_waitcnt vmcnt(0)" ::: "memory")
typedef __bf16 bf16x2_t __attribute__((ext_vector_type(2)));
__device__ __forceinline__ unsigned cvt_pk_bf16(float lo, float hi) { const f32x2 v = {lo, hi}; const bf16x2_t b = __builtin_convertvector(v, bf16x2_t); return __builtin_bit_cast(unsigned, b); }
__device__ __forceinline__ float bf2f(unsigned h) { return __uint_as_float(h << 16); }
__device__ __forceinline__ float bflo(unsigned w) { return __uint_as_float(w << 16); }
__device__ __forceinline__ float bfhi(unsigned w) { return __uint_as_float(w & 0xffff0000u); }
__device__ __forceinline__ bf16 f2bf(float f) { return (bf16)(cvt_pk_bf16(f, 0.f) & 0xffffu); }
__device__ __forceinline__ float wave_sum(float v) {
#pragma unroll
    for (int o = 1; o < 64; o <<= 1) v += __shfl_xor(v, o);
    return v;
}
__device__ __forceinline__ float sigmoidf_(float x) { return 1.f / (1.f + __expf(-x)); }
__device__ __forceinline__ float siluf_(float x) { return x / (1.f + __expf(-x)); }
__device__ __forceinline__ float log_sigmoidf_(float x) { return fminf(x, 0.f) - log1pf(__expf(-fabsf(x))); }

namespace pg8 {
constexpr int BM = 256, BK = 64, HALF = 128, HTB = HALF * BK * 2, NXCD = 8, WGM = 8;
__host__ __device__ __forceinline__ int lds_byte(int r, int c) { const int st = (r >> 4) * 2 + (c >> 5), rr = r & 15, cc = c & 31, ob = rr * 64 + cc * 2; return st * 1024 + (ob ^ (((ob >> 9) & 1) << 5)); }
__host__ __device__ __forceinline__ void stage_rc(int b, int& R, int& C) { const int st = b / 1024, sb = b % 1024, swz = sb ^ (((sb >> 9) & 1) << 5); R = (st >> 1) * 16 + swz / 64; C = (st & 1) * 32 + (swz % 64) / 2; }
__host__ __device__ __forceinline__ int perm32(int rho) { const int n = rho >> 4, i = rho & 15; return 8 * (i >> 2) + 4 * n + (i & 3); }

struct Unit { int pm, pn, z; size_t aoff, boff; };
struct Gemm { const bf16* A; const bf16* Bt; int K, lda, ldb; };

struct StaticOrder {
    int nM, nN, nwg, G, c, nz; size_t astride, bstride;
    __device__ void init(int M_, int N_, int G_, int c_, int nz_ = 1, size_t as_ = 0, size_t bs_ = 0) { nM = M_ / BM; nN = N_ / BM; nwg = nM * nN; G = G_; c = c_; nz = nz_; astride = as_; bstride = bs_; }
    __device__ bool next(int i, Unit& u) const {
        const long L0 = (long)i * G + c; if (L0 >= (long)nwg * nz) return false;
        const int z = (int)(L0 / nwg); const long L = L0 - (long)z * nwg; u.z = z; u.aoff = z * astride; u.boff = z * bstride;
        int wgid = (int)L; { const int q = nwg / NXCD, r = nwg % NXCD, xcd = wgid % NXCD, off = wgid / NXCD; wgid = (xcd < r ? xcd * (q + 1) : r * (q + 1) + (xcd - r) * q) + off; }
        const int nig = WGM * nN, gid = wgid / nig, fm = gid * WGM, gsz = (nM - fm) < WGM ? (nM - fm) : WGM;
        u.pm = fm + ((wgid % nig) % gsz); u.pn = (wgid % nig) / gsz; return true;
    }
};

template <class Epi, class Sched>
__device__ __forceinline__ void gemm_phase(LAS unsigned char* lds, const int tid, const Gemm g, const Sched& S, const Epi& E) {
    const int wid = __builtin_amdgcn_readfirstlane(tid >> 6), lane = tid & 63, wr = wid >> 2, wc = wid & 3, fr = lane & 15, fq = lane >> 4;
    const int K = g.K, nt = K / BK;
    unsigned voffA[2], voffB[2];
#pragma unroll
    for (int i = 0; i < 2; ++i) { int R, C; stage_rc(tid * 16 + i * 8192, R, C); const int Rb = ((R & ~31) + perm32(R & 31));
        voffA[i] = (unsigned)(R * g.lda + C) * 2u; voffB[i] = (unsigned)(Rb * g.ldb + C) * 2u; }
    const size_t kstep = (size_t)(BK * 2);
    const size_t hsA = (size_t)HALF * g.lda * 2, hsB = (size_t)HALF * g.ldb * 2;
    const size_t tsA = 2 * hsA, tsB = 2 * hsB;
    const unsigned ldsw = (unsigned)wid * 1024u;
    const int aoff = lds_byte(wr * 64 + fr, fq * 8), boff = lds_byte(wc * 32 + fr, fq * 8);
#define PG8_SA(b, h) (((b) * 2 + (h)) * HTB)
#define PG8_SB(b, h) ((4 + (b) * 2 + (h)) * HTB)
#define PG8_STAGE(bufoff, gbase, voff) do { _Pragma("unroll") for (int _i = 0; _i < 2; ++_i) \
        __builtin_amdgcn_global_load_lds((const unsigned*)((const char*)(gbase) + (voff)[_i]), (LAS unsigned*)(lds + (bufoff) + ldsw + _i * 8192), 16, 0, 0); } while (0)
#define PG8_LDA(dst, b, h) do { _Pragma("unroll") for (int m = 0; m < 4; ++m) _Pragma("unroll") for (int k = 0; k < 2; ++k) dst[m][k] = *(const LAS bf16x8*)(lds + PG8_SA(b, h) + aoff + m * 2048 + k * 1024); } while (0)
#define PG8_LDB(dst, b, h) do { _Pragma("unroll") for (int n = 0; n < 2; ++n) _Pragma("unroll") for (int k = 0; k < 2; ++k) dst[n][k] = *(const LAS bf16x8*)(lds + PG8_SB(b, h) + boff + n * 2048 + k * 1024); } while (0)
#define PG8_MMA(ai, bj, At, Bt) do { __builtin_amdgcn_s_setprio(1); _Pragma("unroll") for (int m = 0; m < 4; ++m) _Pragma("unroll") for (int n = 0; n < 2; ++n) _Pragma("unroll") for (int k = 0; k < 2; ++k) \
        acc[ai][bj][m][n] = __builtin_amdgcn_mfma_f32_16x16x32_bf16(Bt[n][k], At[m][k], acc[ai][bj][m][n], 0, 0, 0); __builtin_amdgcn_s_setprio(0); } while (0)
#define PG8_WAIT_V(n) asm volatile("s_waitcnt vmcnt(" #n ")" ::: "memory")
#define PG8_WAIT_L(n) asm volatile("s_waitcnt lgkmcnt(" #n ")" ::: "memory")
#define PG8_BAR __builtin_amdgcn_s_barrier()
#define PG8_SCHED __builtin_amdgcn_sched_barrier(0)
    Unit cur, nxt; int ui = 0;
    if (!S.next(0, cur)) return;
    f32x4 acc[2][2][4][2];
#pragma unroll
    for (int a = 0; a < 2; ++a)
#pragma unroll
        for (int b = 0; b < 2; ++b)
#pragma unroll
            for (int m = 0; m < 4; ++m)
#pragma unroll
                for (int n = 0; n < 2; ++n) acc[a][b][m][n] = (f32x4){0.f, 0.f, 0.f, 0.f};
    bf16x8 At[4][2], B0[2][2], B1[2][2];
    const char* cA = (const char*)g.A + cur.aoff + (size_t)cur.pm * tsA; const char* cB = (const char*)g.Bt + cur.boff + (size_t)cur.pn * tsB;
    PG8_STAGE(PG8_SB(0, 0), cB, voffB); PG8_STAGE(PG8_SB(0, 1), cB + hsB, voffB); PG8_STAGE(PG8_SA(0, 0), cA, voffA); PG8_STAGE(PG8_SA(0, 1), cA + hsA, voffA);
    if (wr == 1) PG8_BAR;
    PG8_WAIT_V(2); PG8_BAR;
    PG8_STAGE(PG8_SB(1, 0), cB + kstep, voffB); PG8_STAGE(PG8_SA(1, 0), cA + kstep, voffA); PG8_STAGE(PG8_SB(1, 1), cB + hsB + kstep, voffB);
    PG8_WAIT_V(6); PG8_BAR;
    for (;;) {
        const bool has_next = S.next(ui + 1, nxt);
        const char* nA = has_next ? (const char*)g.A + nxt.aoff + (size_t)nxt.pm * tsA : cA; const char* nB = has_next ? (const char*)g.Bt + nxt.boff + (size_t)nxt.pn * tsB : cB;
        for (int t = 0; t < nt; t += 2) {
            const bool last = (t == nt - 2);
            const char* a1 = cA + (size_t)(t + 1) * kstep;
            const char* a2 = last ? nA : cA + (size_t)(t + 2) * kstep; const char* b2 = last ? nB : cB + (size_t)(t + 2) * kstep;
            const char* a3 = a2 + kstep; const char* b3 = b2 + kstep;
            PG8_LDB(B0, 0, 0); PG8_LDB(B1, 0, 1); PG8_SCHED; PG8_LDA(At, 0, 0); PG8_STAGE(PG8_SA(1, 1), a1 + hsA, voffA);
            PG8_WAIT_V(8); PG8_WAIT_L(0); PG8_BAR; PG8_MMA(0, 0, At, B0); PG8_MMA(0, 1, At, B1); PG8_BAR; PG8_SCHED;
            PG8_LDA(At, 0, 1); PG8_STAGE(PG8_SB(0, 0), b2, voffB); PG8_STAGE(PG8_SB(0, 1), b2 + hsB, voffB); PG8_STAGE(PG8_SA(0, 0), a2, voffA);
            PG8_WAIT_V(8); PG8_WAIT_L(0); PG8_BAR; PG8_MMA(1, 0, At, B0); PG8_MMA(1, 1, At, B1); PG8_BAR; PG8_SCHED;
            PG8_LDB(B0, 1, 0); PG8_LDB(B1, 1, 1); PG8_SCHED; PG8_LDA(At, 1, 0); PG8_STAGE(PG8_SA(0, 1), a2 + hsA, voffA);
            PG8_WAIT_V(8); PG8_WAIT_L(0); PG8_BAR; PG8_MMA(0, 0, At, B0); PG8_MMA(0, 1, At, B1); PG8_BAR; PG8_SCHED;
            PG8_LDA(At, 1, 1); PG8_STAGE(PG8_SB(1, 0), b3, voffB); PG8_STAGE(PG8_SB(1, 1), b3 + hsB, voffB); PG8_STAGE(PG8_SA(1, 0), a3, voffA);
            PG8_WAIT_V(8); PG8_WAIT_L(0); PG8_BAR; PG8_MMA(1, 0, At, B0); PG8_MMA(1, 1, At, B1); PG8_BAR; PG8_SCHED;
        }
        if (wr == 0) PG8_BAR;
        E(acc, cur, wr, wc, fr, fq);
        if (!has_next) break;
#pragma unroll
        for (int a = 0; a < 2; ++a)
#pragma unroll
            for (int b = 0; b < 2; ++b)
#pragma unroll
                for (int m = 0; m < 4; ++m)
#pragma unroll
                    for (int n = 0; n < 2; ++n) acc[a][b][m][n] = (f32x4){0.f, 0.f, 0.f, 0.f};
        cur = nxt; cA = nA; cB = nB; ++ui;
        if (wr == 1) PG8_BAR;
    }
    PG8_WAIT_V(0);
    PG8_BAR;
#undef PG8_SA
#undef PG8_SB
#undef PG8_STAGE
#undef PG8_LDA
#undef PG8_LDB
#undef PG8_MMA
#undef PG8_WAIT_V
#undef PG8_WAIT_L
#undef PG8_BAR
#undef PG8_SCHED
}
}

#define XB_TMO      128
#define XB_XCNT(j)  (256  + 64 * (j))
#define XB_XSUB(j)  (1280 + 64 * (j))
#define XB_XGEN(j)  (2304 + 64 * (j))
#define XB_TOP      3328
#define XB_TOPGEN   3392
#define XCD_BAR_WORDS 3456
#define XB_SPIN_CAP (1u << 22)
__device__ __forceinline__ unsigned xb_ld(unsigned* p)              { return __hip_atomic_load(p, __ATOMIC_RELAXED, __HIP_MEMORY_SCOPE_AGENT); }
__device__ __forceinline__ unsigned xb_add(unsigned* p, unsigned v) { return __hip_atomic_fetch_add(p, v, __ATOMIC_RELAXED, __HIP_MEMORY_SCOPE_AGENT); }
__device__ __forceinline__ unsigned xb_xcc_id() { return (unsigned)__builtin_amdgcn_s_getreg((3 << 11) | 20) & 0xFu; }
#define XB_SPIN(cond, bar) do { unsigned _sp = 0; while (cond) { __builtin_amdgcn_s_sleep(1); \
    if ((++_sp & 255u) == 0u) { if (xb_ld(&(bar)[XB_TMO])) break; if (_sp > XB_SPIN_CAP) { atomicAdd(&(bar)[XB_TMO], 1u); break; } } } } while (0)
struct XcdBarrier { unsigned* bar; unsigned x; volatile LAS unsigned* st; };
__device__ __forceinline__ XcdBarrier xcd_barrier_post(unsigned* bar, volatile LAS unsigned* st) {
    XcdBarrier b; b.bar = bar; b.x = xb_xcc_id(); b.st = st;
    if (threadIdx.x == 0) (void)xb_add(&bar[XB_XCNT(b.x)], 1u);
    return b;
}
__device__ __forceinline__ void xcd_barrier_complete(unsigned* bar, unsigned x, unsigned& nloc, unsigned& nx) {
    const unsigned G = gridDim.x * gridDim.y * gridDim.z;
    unsigned sum, cnt, mine, sp = 0u;
    for (;;) {
        sum = 0u; cnt = 0u; mine = 0u;
#pragma unroll
        for (unsigned j = 0; j < 16; ++j) { const unsigned c = xb_ld(&bar[XB_XCNT(j)]); sum += c; cnt += (c > 0u) ? 1u : 0u; mine = (j == x) ? c : mine; }
        if (sum == G) break;
        __builtin_amdgcn_s_sleep(1);
        if ((++sp & 255u) == 0u) { if (xb_ld(&bar[XB_TMO])) break; if (sp > XB_SPIN_CAP) { atomicAdd(&bar[XB_TMO], 1u); break; } }
    }
    nloc = mine > 0u ? mine : 1u; nx = cnt > 0u ? cnt : 1u;
}
__device__ __forceinline__ void xcd_barrier(const XcdBarrier& b) {
    asm volatile("s_waitcnt vmcnt(0)" ::: "memory");
    __syncthreads();
    if (threadIdx.x == 0) {
        unsigned* bar = b.bar;
        __builtin_amdgcn_s_waitcnt(0);
        unsigned nloc = b.st[0], nx = b.st[1];
        if (nloc == 0u) { xcd_barrier_complete(bar, b.x, nloc, nx); b.st[0] = nloc; b.st[1] = nx; }
        const unsigned old = xb_add(&bar[XB_XSUB(b.x)], 1u);
        const unsigned gen = old / nloc;
        if (old + 1u == (gen + 1u) * nloc) {
            __builtin_amdgcn_fence(__ATOMIC_RELEASE, "agent");
            asm volatile("s_waitcnt vmcnt(0)" ::: "memory");
            const unsigned og = xb_add(&bar[XB_TOP], 1u);
            const unsigned tg = og / nx;
            if (og + 1u == (tg + 1u) * nx) xb_add(&bar[XB_TOPGEN], 1u);
            else XB_SPIN(xb_ld(&bar[XB_TOPGEN]) == tg, bar);
            __builtin_amdgcn_fence(__ATOMIC_ACQUIRE, "agent");
            xb_add(&bar[XB_XGEN(b.x)], 1u);
            asm volatile("s_waitcnt vmcnt(0)" ::: "memory");
        } else {
            XB_SPIN(xb_ld(&bar[XB_XGEN(b.x)]) == gen, bar);
            __builtin_amdgcn_fence(__ATOMIC_ACQUIRE, "agent");
            asm volatile("s_waitcnt vmcnt(0)" ::: "memory");
        }
    }
    __syncthreads();
}

typedef const float* cfp_t;
typedef __attribute__((address_space(4))) const cfp_t* KargIn;
struct Frame {
    LAS unsigned char* lds; unsigned char* lds_generic;
    unsigned char* ws;
    unsigned* ctl;
    int tid, lane, wave, G, bid;
    KargIn in;
    float* out;
};
__device__ __forceinline__ unsigned long long opaque_ptr(unsigned long long w) {
    unsigned lo = (unsigned)w, hi = (unsigned)(w >> 32); asm volatile("" : "+v"(lo), "+v"(hi));
    lo = __builtin_amdgcn_readfirstlane(lo); hi = __builtin_amdgcn_readfirstlane(hi); return ((unsigned long long)hi << 32) | lo;
}
__device__ __forceinline__ Frame fresh(const Frame& F0) {
    Frame F = F0; int t = F0.tid; asm volatile("" : "+v"(t)); F.tid = t; F.lane = t & 63; F.wave = __builtin_amdgcn_readfirstlane(t >> 6);
    F.ws = (unsigned char*)opaque_ptr((unsigned long long)F0.ws); F.ctl = (unsigned*)(F.ws + WS_CTL);
    return F;
}
enum { I_X = 0, I_C, I_CTX, I_CCTX, I_ADAW, I_ADAB, I_N1G, I_N2G, I_WIN, I_CONVW, I_CONVB, I_GATEB, I_LBRAW, I_AG, I_BG, I_CG, I_LAM, I_WBR, I_WGATE, I_BGATE, I_WOUT,
       I_RGW, I_RGB, I_REW, I_REB, I_W1, I_W3, I_W2, I_FING };

__device__ __forceinline__ float* ws_mod(const Frame& F, int l, int mi) { return (float*)(F.ws + WS_MOD) + ((size_t)l * 9 + mi) * 6144; }
__device__ __forceinline__ int row_mi(int r) { const int b = r / RPB, s = r - b * RPB; return s < TC ? 8 : b; }

template <class RowMap>
__device__ __forceinline__ void tr_item(const float* W, int ldw, int K, bf16* WT, LAS float* scr, int kb, int n0, int lane, const RowMap& rm) {
    const int k0 = 64 * kb;
#pragma unroll
    for (int i = 0; i < 8; ++i) {
        const int kk = 8 * i + (lane >> 3), n4 = 4 * (lane & 7);
        const f32x4 v = *(const f32x4*)(W + (size_t)(k0 + kk) * ldw + n0 + n4);
        LAS float* s = scr + kk * 33 + n4; s[0] = v.x; s[1] = v.y; s[2] = v.z; s[3] = v.w;
    }
    LDS_WAIT(); asm volatile("" ::: "memory");
    const int c = lane & 7;
#pragma unroll
    for (int j = 0; j < 4; ++j) { const int n = (lane >> 3) + 8 * j; const LAS float* s = scr + (8 * c) * 33 + n;
        u32x4 o; o.x = cvt_pk_bf16(s[0 * 33], s[1 * 33]); o.y = cvt_pk_bf16(s[2 * 33], s[3 * 33]); o.z = cvt_pk_bf16(s[4 * 33], s[5 * 33]); o.w = cvt_pk_bf16(s[6 * 33], s[7 * 33]);
        *(u32x4*)(WT + (size_t)rm(n0 + n) * K + k0 + 8 * c) = o; }
    LDS_WAIT(); asm volatile("" ::: "memory");
}
struct RmIdent { int off; __device__ int operator()(int n) const { return n + off; } };
struct RmGate { int br; __device__ int operator()(int o) const {
    return 256 * (o >> 6) + 128 * (br >> 1) + 32 * ((o >> 4) & 3) + 8 * ((o >> 2) & 3) + 4 * (br & 1) + (o & 3); } };
struct Rm13 { int which; __device__ int operator()(int j) const { return 256 * (j >> 7) + 128 * which + (j & 127); } };

__device__ __forceinline__ void phase_convert(Frame& F, int l) {
    LAS float* scr = (LAS float*)(F.lds + F.wave * 8448);
    const int gw = F.bid * NWAVES + F.wave, NGW = F.G * NWAVES;
    bf16* Wb = (bf16*)(F.ws + WS_W);
    constexpr int I_IN1 = 16 * 144, I_IN2 = 16 * 48, I_G = 16 * 96, I_BR1 = 8 * 32, I_O = 16 * 32, I_E13 = 16 * 16, I_E2 = 8 * 32;
    constexpr int NITEMS = I_IN1 + I_IN2 + I_G + 3 * I_BR1 + I_O + NEXP * (2 * I_E13 + I_E2);
    const float* win = F.in[I_WIN] + (size_t)l * 1024 * WIN_N;
    const float* wgate = F.in[I_WGATE] + (size_t)l * 1024 * 3072;
    const float* wbr = F.in[I_WBR] + (size_t)l * 3 * 512 * 1024;
    const float* wout = F.in[I_WOUT] + (size_t)l * 1024 * 1024;
    const float* w1 = F.in[I_W1] + (size_t)l * NEXP * 1024 * 512;
    const float* w3 = F.in[I_W3] + (size_t)l * NEXP * 1024 * 512;
    const float* w2 = F.in[I_W2] + (size_t)l * NEXP * 512 * 1024;
    for (int it = gw; it < NITEMS; it += NGW) {
        int r = it;
        if (r < I_IN1) { tr_item(win, WIN_N, 1024, Wb + W_IN / 2, scr, r / 144, 32 * (r % 144), F.lane, RmIdent{0}); continue; } r -= I_IN1;
        if (r < I_IN2) { tr_item(win + 4624, WIN_N, 1024, Wb + W_IN / 2, scr, r / 48, 32 * (r % 48), F.lane, RmIdent{4608}); continue; } r -= I_IN2;
        if (r < I_G) { const int nb = r % 96, br = nb / 32; tr_item(wgate + br * 1024, 3072, 1024, Wb + W_GP / 2, scr, r / 96, 32 * (nb % 32), F.lane, RmGate{br}); continue; } r -= I_G;
        if (r < 3 * I_BR1) { const int br = r / I_BR1, q = r % I_BR1; tr_item(wbr + (size_t)br * 512 * 1024, 1024, 512, Wb + W_BR / 2 + (size_t)br * 1024 * 512, scr, q / 32, 32 * (q % 32), F.lane, RmIdent{0}); continue; } r -= 3 * I_BR1;
        if (r < I_O) { tr_item(wout, 1024, 1024, Wb + W_OUT / 2, scr, r / 32, 32 * (r % 32), F.lane, RmIdent{0}); continue; } r -= I_O;
        { const int e = r / (2 * I_E13 + I_E2); int q = r % (2 * I_E13 + I_E2);
          if (q < I_E13) { tr_item(w1 + (size_t)e * 1024 * 512, 512, 1024, Wb + W_13 / 2 + (size_t)e * 1024 * 1024, scr, q / 16, 32 * (q % 16), F.lane, Rm13{0}); continue; } q -= I_E13;
          if (q < I_E13) { tr_item(w3 + (size_t)e * 1024 * 512, 512, 1024, Wb + W_13 / 2 + (size_t)e * 1024 * 1024, scr, q / 16, 32 * (q % 16), F.lane, Rm13{1}); continue; } q -= I_E13;
          tr_item(w2 + (size_t)e * 512 * 1024, 1024, 512, Wb + W_2 / 2 + (size_t)e * 1024 * 512, scr, q / 32, 32 * (q % 32), F.lane, RmIdent{0}); }
    }
    for (int i = gw; i < 1024; i += NGW) {
        const int row = RmGate{3}(i);
        u32x4* p = (u32x4*)(Wb + W_GP / 2 + (size_t)row * 1024) + F.lane;
        p[0] = (u32x4){0, 0, 0, 0}; p[64] = (u32x4){0, 0, 0, 0};
    }
}

__device__ __forceinline__ void phase_init(Frame& F) {
    const int gw = F.bid * NWAVES + F.wave, NGW = F.G * NWAVES;
    float* X = (float*)(F.ws + WS_X);
    for (int r = gw; r < M; r += NGW) {
        const int b = r / RPB, s = r - b * RPB;
        const float* src = s < TC ? F.in[I_CTX] + ((size_t)b * TC + s) * D : F.in[I_X] + ((size_t)b * TL + (s - TC)) * D;
        const f32x4* sp = (const f32x4*)src + F.lane; f32x4* dp = (f32x4*)(X + (size_t)r * D) + F.lane;
#pragma unroll
        for (int j = 0; j < 4; ++j) dp[64 * j] = sp[64 * j];
    }
#ifdef DBG_ZERO_R2
    { u32x4* z = (u32x4*)(F.ws + WS_R2); const size_t n16 = (108 * MiB) / 16;
      for (size_t i = (size_t)F.bid * NTHR + F.tid; i < n16; i += (size_t)F.G * NTHR) z[i] = (u32x4){0, 0, 0, 0}; }
#endif
    if (F.bid == F.G - 1) {
        float* rt = (float*)(F.ws + WS_ROPE);
        for (int i = F.tid; i < 64 * 16; i += NTHR) { const int pos = i >> 4, p = i & 15;
            const float inv = powf(10000.f, -(float)p / 16.f); const float ang = (float)pos * inv; rt[2 * i] = cosf(ang); rt[2 * i + 1] = sinf(ang); }
    }
    LAS float* sc = (LAS float*)(F.lds);
    LAS float* red = (LAS float*)(F.lds + 40960);
    if (F.bid < 192) {
        for (int i = F.tid; i < 9 * 1024; i += NTHR) { const int mi = i >> 10, k = i & 1023; const float v = mi < 8 ? F.in[I_C][mi * 1024 + k] : F.in[I_CCTX][k]; sc[i] = siluf_(v); }
        __syncthreads();
        const int it = F.bid, l = it / 96, n0 = (it % 96) * 64;
        const float* aw = F.in[I_ADAW] + (size_t)l * 1024 * 6144 + n0 + F.lane;
        float acc[9];
#pragma unroll
        for (int m = 0; m < 9; ++m) acc[m] = 0.f;
        const int kb = F.wave * 128;
#pragma unroll 8
        for (int k = 0; k < 128; ++k) { const float w = aw[(size_t)(kb + k) * 6144];
#pragma unroll
            for (int m = 0; m < 9; ++m) acc[m] += sc[m * 1024 + kb + k] * w; }
#pragma unroll
        for (int m = 0; m < 9; ++m) red[(F.wave * 9 + m) * 64 + F.lane] = acc[m];
        __syncthreads();
        for (int i = F.tid; i < 9 * 64; i += NTHR) { const int m = i >> 6, n = i & 63; float s = 0.f;
#pragma unroll
            for (int w = 0; w < 8; ++w) s += red[(w * 9 + m) * 64 + n];
            ws_mod(F, l, m)[n0 + n] = s + F.in[I_ADAB][l * 6144 + n0 + n]; }
        __syncthreads();
    }
}

__device__ __forceinline__ void stage_gate_w(Frame& F, int l) {
    LAS float* gw_ = (LAS float*)F.lds;
    const float* win = F.in[I_WIN] + (size_t)l * 1024 * WIN_N + WIN_GATE0;
    for (int i = F.tid; i < 1024 * 4; i += NTHR) { const int k = i >> 2, q = i & 3; *(LAS f32x4*)(gw_ + k * 16 + (k >> 2) * 4 + q * 4) = *(const f32x4*)(win + (size_t)k * WIN_N + q * 4); }
    __syncthreads();
}
__device__ __forceinline__ void norm1_row(Frame& F, int l, int r, const f32x4 (&xv)[4]) {
    float ss = 0.f;
#pragma unroll
    for (int j = 0; j < 4; ++j) ss += (xv[j].x * xv[j].x + xv[j].y * xv[j].y) + (xv[j].z * xv[j].z + xv[j].w * xv[j].w);
    const float rstd = rsqrtf(wave_sum(ss) * (1.f / D) + EPS);
    const float* mod = ws_mod(F, l, row_mi(r));
    const float* ng = F.in[I_N1G] + l * 1024;
    LAS float* gw_ = (LAS float*)F.lds;
    bf16* H = (bf16*)(F.ws + WS_H);
    float ga[16];
#pragma unroll
    for (int q = 0; q < 16; ++q) ga[q] = 0.f;
#pragma unroll
    for (int j = 0; j < 4; ++j) {
        const int c0 = 4 * F.lane + 256 * j;
        const f32x4 g = *(const f32x4*)(ng + c0), sh = *(const f32x4*)(mod + c0), scv = *(const f32x4*)(mod + 1024 + c0);
        f32x4 h; h.x = xv[j].x * rstd * g.x * (1.f + scv.x) + sh.x; h.y = xv[j].y * rstd * g.y * (1.f + scv.y) + sh.y;
        h.z = xv[j].z * rstd * g.z * (1.f + scv.z) + sh.z; h.w = xv[j].w * rstd * g.w * (1.f + scv.w) + sh.w;
        u32x2 o; o.x = cvt_pk_bf16(h.x, h.y); o.y = cvt_pk_bf16(h.z, h.w);
        *(u32x2*)(H + (size_t)r * D + c0) = o;
#pragma unroll
        for (int e = 0; e < 4; ++e) { const float hv = h[e];
#pragma unroll
            for (int q4 = 0; q4 < 4; ++q4) { const f32x4 w = *(const LAS f32x4*)(gw_ + (c0 + e) * 16 + (c0 >> 2) * 4 + q4 * 4);
                ga[q4 * 4 + 0] += hv * w.x; ga[q4 * 4 + 1] += hv * w.y; ga[q4 * 4 + 2] += hv * w.z; ga[q4 * 4 + 3] += hv * w.w; } }
    }
#pragma unroll
    for (int q = 0; q < 16; ++q) ga[q] = wave_sum(ga[q]);
    float mine = 0.f;
#pragma unroll
    for (int q = 0; q < 16; ++q) mine = (F.lane == q) ? ga[q] : mine;
    if (F.lane < 16) { float v = mine + F.in[I_GATEB][l * 16 + F.lane]; if (F.lane >= 8) v = log_sigmoidf_(v); ((float*)(F.ws + WS_GATES))[(size_t)r * 16 + F.lane] = v; }
}
__device__ __forceinline__ void phase_norm1(Frame& F, int l) {
    stage_gate_w(F, l);
    const int gw = F.bid * NWAVES + F.wave, NGW = F.G * NWAVES;
    const float* X = (const float*)(F.ws + WS_X);
    for (int r = gw; r < M; r += NGW) {
        f32x4 xv[4]; const f32x4* xp = (const f32x4*)(X + (size_t)r * D) + F.lane;
#pragma unroll
        for (int j = 0; j < 4; ++j) xv[j] = xp[64 * j];
        norm1_row(F, l, r, xv);
    }
    __syncthreads();
}

struct EpiPlain {
    bf16* O; int ldc, coff, zoff;
    __device__ __forceinline__ void operator()(const f32x4 (&acc)[2][2][4][2], const pg8::Unit& u, int wr, int wc, int fr, int fq) const {
        const int row0 = u.pm * 256 + wr * 64 + fr, col0 = coff + u.z * zoff + u.pn * 256 + wc * 32 + 8 * fq;
#pragma unroll
        for (int ai = 0; ai < 2; ++ai)
#pragma unroll
            for (int m = 0; m < 4; ++m) { bf16* rowp = O + (size_t)(row0 + ai * 128 + m * 16) * ldc + col0;
#pragma unroll
                for (int bj = 0; bj < 2; ++bj) { const f32x4 v0 = acc[ai][bj][m][0], v1 = acc[ai][bj][m][1];
                    u32x4 w; w.x = cvt_pk_bf16(v0[0], v0[1]); w.y = cvt_pk_bf16(v0[2], v0[3]); w.z = cvt_pk_bf16(v1[0], v1[1]); w.w = cvt_pk_bf16(v1[2], v1[3]);
                    *(u32x4*)(rowp + bj * 128) = w; } }
    }
};
struct EpiInProj {
    bf16* P; const float* rope;
    __device__ __forceinline__ void operator()(const f32x4 (&acc)[2][2][4][2], const pg8::Unit& u, int wr, int wc, int fr, int fq) const {
        const int pn = u.pn;
        const int mode = (pn == 4 || pn == 5) ? 1 : (pn == 16 || pn == 17) ? 2 : (pn >= 18 && pn < 22 && (u.pm % 9) != 0) ? 3 : 0;
        const int row0 = u.pm * 256 + wr * 64 + fr, col0 = pn * 256 + wc * 32 + 8 * fq;
#pragma unroll
        for (int ai = 0; ai < 2; ++ai)
#pragma unroll
            for (int m = 0; m < 4; ++m) { const int row = row0 + ai * 128 + m * 16; bf16* rowp = P + (size_t)row * NP + col0;
                f32x4 cs[4];
                if (mode == 3) { const int s = row % RPB - TC; const int pos = (wc & 1) ? (s & 63) : (s >> 6);
                    const f32x4* tp = (const f32x4*)(rope + (pos * 16 + 8 * (fq & 1)) * 2);
                    cs[0] = tp[0]; cs[1] = tp[1]; cs[2] = tp[2]; cs[3] = tp[3]; }
#pragma unroll
                for (int bj = 0; bj < 2; ++bj) { f32x4 v0 = acc[ai][bj][m][0], v1 = acc[ai][bj][m][1];
                    if (mode == 1) {
#pragma unroll
                        for (int e = 0; e < 4; ++e) { v0[e] = siluf_(v0[e]); v1[e] = siluf_(v1[e]); } }
                    else if (mode == 2) {
#pragma unroll
                        for (int e = 0; e < 4; ++e) { v0[e] = sigmoidf_(v0[e]); v1[e] = sigmoidf_(v1[e]); } }
                    else if (mode == 3) {
                        f32x4 p0, p1;
#pragma unroll
                        for (int e = 0; e < 4; ++e) { p0[e] = __shfl_xor(v0[e], 32); p1[e] = __shfl_xor(v1[e], 32); }
                        const float sg = (fq < 2) ? -1.f : 1.f;
                        f32x4 r0, r1;
                        r0[0] = v0[0] * cs[0][0] + sg * p0[0] * cs[0][1]; r0[1] = v0[1] * cs[0][2] + sg * p0[1] * cs[0][3];
                        r0[2] = v0[2] * cs[1][0] + sg * p0[2] * cs[1][1]; r0[3] = v0[3] * cs[1][2] + sg * p0[3] * cs[1][3];
                        r1[0] = v1[0] * cs[2][0] + sg * p1[0] * cs[2][1]; r1[1] = v1[1] * cs[2][2] + sg * p1[1] * cs[2][3];
                        r1[2] = v1[2] * cs[3][0] + sg * p1[2] * cs[3][1]; r1[3] = v1[3] * cs[3][2] + sg * p1[3] * cs[3][3];
                        v0 = r0; v1 = r1; }
                    u32x4 w; w.x = cvt_pk_bf16(v0[0], v0[1]); w.y = cvt_pk_bf16(v0[2], v0[3]); w.z = cvt_pk_bf16(v1[0], v1[1]); w.w = cvt_pk_bf16(v1[2], v1[3]);
                    *(u32x4*)(rowp + bj * 128) = w; } }
    }
};
struct EpiGates {
    const bf16* U; bf16* YB; const float* bgate;
    __device__ __forceinline__ void operator()(const f32x4 (&acc)[2][2][4][2], const pg8::Unit& u, int wr, int wc, int fr, int fq) const {
        const int row0 = u.pm * 256 + wr * 64 + fr, o0 = 64 * u.pn + 16 * wc + 4 * fq;
        const f32x4 b0 = *(const f32x4*)(bgate + o0), b1 = *(const f32x4*)(bgate + 1024 + o0), b2 = *(const f32x4*)(bgate + 2048 + o0);
#pragma unroll
        for (int ai = 0; ai < 2; ++ai)
#pragma unroll
            for (int m = 0; m < 4; ++m) { const int row = row0 + ai * 128 + m * 16; const bf16* up = U + (size_t)row * 3072 + o0;
                const u32x2 u0 = *(const u32x2*)(up), u1 = *(const u32x2*)(up + 1024), u2 = *(const u32x2*)(up + 2048);
                const f32x4 g0 = acc[ai][0][m][0], g1 = acc[ai][0][m][1], g2 = acc[ai][1][m][0];
                float y[4];
                y[0] = sigmoidf_(g0[0] + b0[0]) * bflo(u0.x) + sigmoidf_(g1[0] + b1[0]) * bflo(u1.x) + sigmoidf_(g2[0] + b2[0]) * bflo(u2.x);
                y[1] = sigmoidf_(g0[1] + b0[1]) * bfhi(u0.x) + sigmoidf_(g1[1] + b1[1]) * bfhi(u1.x) + sigmoidf_(g2[1] + b2[1]) * bfhi(u2.x);
                y[2] = sigmoidf_(g0[2] + b0[2]) * bflo(u0.y) + sigmoidf_(g1[2] + b1[2]) * bflo(u1.y) + sigmoidf_(g2[2] + b2[2]) * bflo(u2.y);
                y[3] = sigmoidf_(g0[3] + b0[3]) * bfhi(u0.y) + sigmoidf_(g1[3] + b1[3]) * bfhi(u1.y) + sigmoidf_(g2[3] + b2[3]) * bfhi(u2.y);
                u32x2 w; w.x = cvt_pk_bf16(y[0], y[1]); w.y = cvt_pk_bf16(y[2], y[3]);
                *(u32x2*)(YB + (size_t)row * 1024 + o0) = w; }
    }
};
struct EpiOut {
    float* X; const float* modl;
    __device__ __forceinline__ void operator()(const f32x4 (&acc)[2][2][4][2], const pg8::Unit& u, int wr, int wc, int fr, int fq) const {
        const int row0 = u.pm * 256 + wr * 64 + fr, col0 = u.pn * 256 + wc * 32 + 8 * fq;
        const int mi = (u.pm % 9) == 0 ? 8 : u.pm / 9;
        const float* gp = modl + (size_t)mi * 6144 + 2048 + col0;
        f32x4 g[2][2];
#pragma unroll
        for (int bj = 0; bj < 2; ++bj) { g[bj][0] = *(const f32x4*)(gp + bj * 128); g[bj][1] = *(const f32x4*)(gp + bj * 128 + 4); }
#pragma unroll
        for (int ai = 0; ai < 2; ++ai)
#pragma unroll
            for (int m = 0; m < 4; ++m) { float* rowp = X + (size_t)(row0 + ai * 128 + m * 16) * D + col0;
#pragma unroll
                for (int bj = 0; bj < 2; ++bj) { f32x4* xp = (f32x4*)(rowp + bj * 128); f32x4 x0 = xp[0], x1 = xp[1];
                    x0 = x0 + g[bj][0] * acc[ai][bj][m][0]; x1 = x1 + g[bj][1] * acc[ai][bj][m][1]; xp[0] = x0; xp[1] = x1; } }
    }
};
struct EpiMoe1 {
    bf16* UM;
    __device__ __forceinline__ void operator()(const f32x4 (&acc)[2][2][4][2], const pg8::Unit& u, int wr, int wc, int fr, int fq) const {
        const int row0 = u.pm * 256 + wr * 64 + fr, col0 = u.pn * 128 + wc * 32 + 8 * fq;
#pragma unroll
        for (int ai = 0; ai < 2; ++ai)
#pragma unroll
            for (int m = 0; m < 4; ++m) { bf16* rowp = UM + (size_t)(row0 + ai * 128 + m * 16) * DEXP + col0;
                float y[8];
#pragma unroll
                for (int n = 0; n < 2; ++n)
#pragma unroll
                    for (int e = 0; e < 4; ++e) y[4 * n + e] = siluf_(acc[ai][0][m][n][e]) * acc[ai][1][m][n][e];
                u32x4 w; w.x = cvt_pk_bf16(y[0], y[1]); w.y = cvt_pk_bf16(y[2], y[3]); w.z = cvt_pk_bf16(y[4], y[5]); w.w = cvt_pk_bf16(y[6], y[7]);
                *(u32x4*)rowp = w; }
    }
};
struct GroupedOrder {
    const volatile LAS int* tile_e; int ntiles, G, c; size_t estride;
    __device__ bool next(int i, pg8::Unit& u) const {
        const long L = (long)i * G + c; if (L >= (long)ntiles * 4) return false;
        const int t = (int)(L >> 2); u.pm = t; u.pn = (int)(L & 3); u.z = 0; u.aoff = 0; u.boff = (size_t)tile_e[t] * estride; return true;
    }
};

namespace att {
constexpr int NW = 8, QBLK = 32, KVBLK = 64;
constexpr float SCALE = 0.125f, THR = 8.f;
constexpr int SHM_V = KVBLK * 128 * 2, SHM_K = KVBLK * 64 * 2, SHM_ATTN = 2 * SHM_V + 2 * SHM_K + NW * 64 * 4;
#define KSWZ64(row, colB) ((row) * 128 + ((colB) ^ ((((row) >> 1) & 7) << 4)))
#define SBAR() __builtin_amdgcn_sched_barrier(0)
__device__ __forceinline__ int crow(int r, int hi) { return (r & 3) + 8 * (r >> 2) + 4 * hi; }
__device__ __forceinline__ unsigned cvtpk(float lo, float hi) { unsigned r; asm volatile("v_cvt_pk_bf16_f32 %0, %1, %2" : "=v"(r) : "v"(lo), "v"(hi)); return r; }
__device__ __forceinline__ void partialSM(f32x16& p0, f32x16& p1, float& m_reg, float& mn, float& alpha) {
  constexpr float C = SCALE * 1.4426950408889634f;
  float pmax = p0[0];
#pragma unroll
  for (int r = 1; r < 16; ++r) pmax = fmaxf(pmax, p0[r]);
#pragma unroll
  for (int r = 0; r < 16; ++r) pmax = fmaxf(pmax, p1[r]);
  { auto rr = __builtin_amdgcn_permlane32_swap(__float_as_uint(pmax), __float_as_uint(pmax), false, false);
    pmax = fmaxf(__uint_as_float(rr[0]), __uint_as_float(rr[1])); }
  if (__builtin_expect(__all(pmax - m_reg <= THR / SCALE), 1)) { mn = m_reg; alpha = 1.f; }
  else { mn = fmaxf(m_reg, pmax); alpha = __builtin_amdgcn_exp2f((m_reg - mn) * C); m_reg = mn; }
  float mnC = -mn * C;
#pragma unroll
  for (int r = 0; r < 16; ++r) p0[r] = fmaf(p0[r], C, mnC);
#pragma unroll
  for (int r = 0; r < 16; ++r) p1[r] = fmaf(p1[r], C, mnC);
#pragma unroll
  for (int r = 0; r < 16; ++r) p0[r] = __builtin_amdgcn_exp2f(p0[r]);
}
__device__ __forceinline__ void finishSM(f32x16& p0, f32x16& p1, float alpha, float& l_reg, bf16x8& pa0, bf16x8& pa1, bf16x8& pa2, bf16x8& pa3) {
#pragma unroll
  for (int r = 0; r < 16; ++r) p1[r] = __builtin_amdgcn_exp2f(p1[r]);
  float ps = 0;
#pragma unroll
  for (int r = 0; r < 16; ++r) ps += p0[r];
#pragma unroll
  for (int r = 0; r < 16; ++r) ps += p1[r];
  { auto rr = __builtin_amdgcn_permlane32_swap(__float_as_uint(ps), __float_as_uint(ps), false, false);
    ps = __uint_as_float(rr[0]) + __uint_as_float(rr[1]); }
  l_reg = l_reg * alpha + ps;
#define PK4(P, BASE, OUT) do { unsigned a0 = cvtpk(P[BASE + 0], P[BASE + 1]), a1 = cvtpk(P[BASE + 2], P[BASE + 3]);   \
    unsigned b0 = cvtpk(P[BASE + 4], P[BASE + 5]), b1 = cvtpk(P[BASE + 6], P[BASE + 7]);                              \
    auto r0 = __builtin_amdgcn_permlane32_swap(a0, b0, false, false); auto r1 = __builtin_amdgcn_permlane32_swap(a1, b1, false, false); \
    u32x4 w = {r0[0], r1[0], r0[1], r1[1]}; OUT = *reinterpret_cast<bf16x8*>(&w); } while (0)
  PK4(p0, 0, pa0); PK4(p0, 8, pa1); PK4(p1, 0, pa2); PK4(p1, 8, pa3);
#undef PK4
}
__device__ __forceinline__ void qkt(f32x16& p0, f32x16& p1, const char* Ks, const bf16x8* qr, int r32, int hi) {
  p0 = f32x16{}; p1 = f32x16{};
#pragma unroll
  for (int d0 = 0; d0 < 4; ++d0) { int cb = (d0 * 16 + hi * 8) * 2;
    bf16x8 b0 = *reinterpret_cast<const bf16x8*>(Ks + KSWZ64(r32, cb));
    bf16x8 b1 = *reinterpret_cast<const bf16x8*>(Ks + KSWZ64(32 + r32, cb));
    p0 = __builtin_amdgcn_mfma_f32_32x32x16_bf16(b0, qr[d0], p0, 0, 0, 0);
    p1 = __builtin_amdgcn_mfma_f32_32x32x16_bf16(b1, qr[d0], p1, 0, 0, 0); }
}
__device__ __forceinline__ int v_st(int k, int c) { const int kk = (k & ~0xC) | ((k & 4) << 1) | ((k & 8) >> 1); return ((kk >> 3) * 4 + (c >> 5)) * 512 + ((kk & 7) * 32 + (c & 31)) * 2; }
__device__ __forceinline__ int v_rd_base(int lane) { return ((lane & 3) << 3) | (((lane >> 2) & 3) << 6) | (((lane >> 4) & 1) << 5) | (((lane >> 5) & 1) << 8); }
constexpr int v_rd_off(int d0, int ks, int half) { return d0 * 512 + ks * 4096 + half * 2048; }
template <int OFF> __device__ __forceinline__ s16x4 tr_read(int vb) {
  s16x4 r; asm volatile("ds_read_b64_tr_b16 %0, %1 offset:%2" : "=&v"(r) : "v"(vb), "i"(OFF) : "memory"); return r;
}
template <int D0> __device__ __forceinline__ void pv_one(f32x16& od, int vb, bf16x8 pa0, bf16x8 pa1, bf16x8 pa2, bf16x8 pa3) {
  const s16x4 l0 = tr_read<v_rd_off(D0, 0, 0)>(vb), h0 = tr_read<v_rd_off(D0, 0, 1)>(vb), l1 = tr_read<v_rd_off(D0, 1, 0)>(vb), h1 = tr_read<v_rd_off(D0, 1, 1)>(vb);
  const s16x4 l2 = tr_read<v_rd_off(D0, 2, 0)>(vb), h2 = tr_read<v_rd_off(D0, 2, 1)>(vb), l3 = tr_read<v_rd_off(D0, 3, 0)>(vb), h3 = tr_read<v_rd_off(D0, 3, 1)>(vb);
  asm volatile("s_waitcnt lgkmcnt(0)" ::: "memory"); SBAR();
#define PK(L, H) (bf16x8){L[0], L[1], L[2], L[3], H[0], H[1], H[2], H[3]}
  od = __builtin_amdgcn_mfma_f32_32x32x16_bf16(pa0, PK(l0, h0), od, 0, 0, 0);
  od = __builtin_amdgcn_mfma_f32_32x32x16_bf16(pa1, PK(l1, h1), od, 0, 0, 0);
  od = __builtin_amdgcn_mfma_f32_32x32x16_bf16(pa2, PK(l2, h2), od, 0, 0, 0);
  od = __builtin_amdgcn_mfma_f32_32x32x16_bf16(pa3, PK(l3, h3), od, 0, 0, 0);
#undef PK
}
__device__ __forceinline__ void pv_d0(f32x16* o, int vb, bf16x8 pa0, bf16x8 pa1, bf16x8 pa2, bf16x8 pa3) {
  pv_one<0>(o[0], vb, pa0, pa1, pa2, pa3); pv_one<1>(o[1], vb, pa0, pa1, pa2, pa3); pv_one<2>(o[2], vb, pa0, pa1, pa2, pa3); pv_one<3>(o[3], vb, pa0, pa1, pa2, pa3);
}
__device__ __forceinline__ void attn_unit(const bf16* __restrict__ Qb, const bf16* __restrict__ Kh, const bf16* __restrict__ Vh, bf16* __restrict__ Ob, int seq, char* lds, const int tid) {
  const int wid = tid >> 6, lane = tid & 63, r32 = lane & 31, hi = lane >> 5;
  char* V_lds = lds; char* K_lds = lds + 2 * SHM_V;
  float* ws = (float*)(lds + 2 * SHM_V + 2 * SHM_K) + wid * 64; float* li_l = ws; float* al_l = ws + 32;
  float m_reg = -1e30f, l_reg = 0; f32x16 o[4] = {}; bf16x8 qr[4];
  const bf16* Qw = Qb + (long)(wid * QBLK + r32) * NP + hi * 8;
#pragma unroll
  for (int d0 = 0; d0 < 4; ++d0) qr[d0] = *reinterpret_cast<const bf16x8*>(Qw + d0 * 16);
  const int sr = tid >> 4, sc = (tid & 15) * 8, vst0 = v_st(sr, sc), vst1 = v_st(32 + sr, sc);
  const int ksr = tid >> 3, ksc = (tid & 7) * 8, kst = KSWZ64(ksr, ksc * 2);
  const int vb0 = (int)(uintptr_t)V_lds + v_rd_base(lane);
  struct { bf16x8 vs0, vs1, ks0; } sr_[2];
#define SLOAD(i, k0) do { sr_[i].vs0 = *reinterpret_cast<const bf16x8*>(&Vh[(long)((k0) + sr) * NP + sc]); sr_[i].vs1 = *reinterpret_cast<const bf16x8*>(&Vh[(long)((k0) + 32 + sr) * NP + sc]); \
    sr_[i].ks0 = *reinterpret_cast<const bf16x8*>(&Kh[(long)((k0) + ksr) * NP + ksc]); } while (0)
#define SWRITE(b, i) do { *(bf16x8*)(V_lds + (b) * SHM_V + vst0) = sr_[i].vs0; *(bf16x8*)(V_lds + (b) * SHM_V + vst1) = sr_[i].vs1; \
    *(bf16x8*)(K_lds + (b) * SHM_K + kst) = sr_[i].ks0; } while (0)
#define SWAIT() asm volatile("s_waitcnt vmcnt(3)" ::: "memory")
#define RESC(a) do { if (__any((a) < 1.f)) { if (hi == 0) al_l[r32] = (a); asm volatile("s_waitcnt lgkmcnt(0)" ::: "memory"); \
    _Pragma("unroll") for (int d = 0; d < 4; ++d) _Pragma("unroll") for (int r = 0; r < 16; ++r) o[d][r] *= al_l[crow(r, hi)]; } } while (0)
  f32x16 pA0, pA1, pB0, pB1; float mnA, mnB, alA, alB; bf16x8 pa0, pa1, pa2, pa3; const int NT = seq / KVBLK;
  constexpr int SE = 0, SO = 1;
  SLOAD(SE, 0); asm volatile("s_waitcnt vmcnt(0)" ::: "memory"); SWRITE(0, SE); __syncthreads();
  qkt(pA0, pA1, K_lds, qr, r32, hi); partialSM(pA0, pA1, m_reg, mnA, alA);
  SLOAD(SO, KVBLK); if (2 < NT) SLOAD(SE, 2 * KVBLK);
  SWAIT(); SWRITE(1, SO); __syncthreads();
  for (int j = 1; j + 1 < NT; j += 2) {
    SBAR(); qkt(pB0, pB1, K_lds + SHM_K, qr, r32, hi);
    finishSM(pA0, pA1, alA, l_reg, pa0, pa1, pa2, pa3); SBAR();
    SLOAD(SO, (j + 2) * KVBLK); SBAR();
    pv_d0(o, vb0, pa0, pa1, pa2, pa3); partialSM(pB0, pB1, m_reg, mnB, alB);
    __syncthreads(); SWAIT(); SWRITE(0, SE);
    RESC(alB); __syncthreads();
    SBAR(); qkt(pA0, pA1, K_lds, qr, r32, hi);
    finishSM(pB0, pB1, alB, l_reg, pa0, pa1, pa2, pa3); SBAR();
    if (j + 3 < NT) SLOAD(SE, (j + 3) * KVBLK); SBAR();
    pv_d0(o, vb0 + SHM_V, pa0, pa1, pa2, pa3); partialSM(pA0, pA1, m_reg, mnA, alA);
    __syncthreads(); SWAIT(); SWRITE(1, SO);
    RESC(alA); __syncthreads();
  }
  SBAR(); qkt(pB0, pB1, K_lds + SHM_K, qr, r32, hi);
  finishSM(pA0, pA1, alA, l_reg, pa0, pa1, pa2, pa3); SBAR();
  pv_d0(o, vb0, pa0, pa1, pa2, pa3); partialSM(pB0, pB1, m_reg, mnB, alB);
  __syncthreads(); RESC(alB);
  finishSM(pB0, pB1, alB, l_reg, pa0, pa1, pa2, pa3); SBAR();
  pv_d0(o, vb0 + SHM_V, pa0, pa1, pa2, pa3);
  if (hi == 0) li_l[r32] = l_reg; asm volatile("s_waitcnt lgkmcnt(0)" ::: "memory");
  float rli[16];
#pragma unroll
  for (int r = 0; r < 16; ++r) rli[r] = __builtin_amdgcn_rcpf(li_l[crow(r, hi)]);
  bf16* Ow = Ob + (long)(wid * QBLK) * D;
#pragma unroll
  for (int r = 0; r < 16; ++r) { int orow = crow(r, hi);
#pragma unroll
    for (int d0 = 0; d0 < 4; ++d0) Ow[(long)orow * D + d0 * 32 + r32] = f2bf(o[d0][r] * rli[r]); }
  __syncthreads();
#undef SLOAD
#undef SWRITE
#undef SWAIT
#undef RESC
}
}

#define MFMA16(a, b, c) __builtin_amdgcn_mfma_f32_16x16x32_bf16((a), (b), (c), 0, 0, 0)
constexpr int CH_RS = 288, CH_TS = 96;
constexpr int OFF_QT = 0, OFF_KT = 9216, OFF_QS = 18432, OFF_KST = 27648, OFF_VT = 39936, OFF_DEC = 52224, OFF_QSUM = 52736, CH_BUF = 55296;
constexpr int OFF_NV = 2 * CH_BUF;
__device__ __forceinline__ int chain_row(int b, int dir, int p) {
    if (p < TC) return b * RPB + (dir ? TC - 1 - p : p);
    const int q = p - TC; return b * RPB + TC + (dir ? TL - 1 - q : q);
}
__device__ __forceinline__ bf16x8 pack8(const f32x4 a, const f32x4 b) {
    u32x4 w; w.x = cvt_pk_bf16(a[0], a[1]); w.y = cvt_pk_bf16(a[2], a[3]); w.z = cvt_pk_bf16(b[0], b[1]); w.w = cvt_pk_bf16(b[2], b[3]); return __builtin_bit_cast(bf16x8, w);
}
__device__ __forceinline__ bf16x8 ld2x8(const LAS char* p0, const LAS char* p1) {
    const u32x2 a = *(const LAS u32x2*)p0, b = *(const LAS u32x2*)p1; u32x4 w = {a.x, a.y, b.x, b.y}; return __builtin_bit_cast(bf16x8, w);
}

__device__ __forceinline__ void chain_a(Frame& F, int l, int item) {
    const int b = item >> 3, h = (item >> 1) & 3, dir = item & 1;
    const bf16* P = (const bf16*)(F.ws + WS_R1);
    bf16* OA = (bf16*)(F.ws + WS_R2 + 36 * MiB) + (size_t)dir * M * 512;
    const int tid = F.tid, lane = F.lane, w = F.wave, c = tid & 127, tq = tid >> 7, i16 = lane & 15, g = lane >> 4;
    LAS char* L = (LAS char*)F.lds;
    float lb = 0.f;
    if (l == 1) { const float r0 = F.in[I_LBRAW][dir * 512 + h * 128 + c], r1 = F.in[I_LBRAW][1024 + dir * 512 + h * 128 + c]; lb = 1.f / (1.f + __expf(r0 - r1)); }
    const float omlb = 1.f - lb;
    f32x4 S[8];
#pragma unroll
    for (int i = 0; i < 8; ++i) S[i] = (f32x4){0.f, 0.f, 0.f, 0.f};
    unsigned short zr[8], qr[8], vr[8];
#define CA_LOAD(ch) do { _Pragma("unroll") for (int j = 0; j < 8; ++j) { const int row = chain_row(b, dir, (ch) * 32 + 8 * tq + j); const bf16* pr = P + (size_t)row * NP + h * 128 + c; \
        zr[j] = pr[PA_F + dir * 512]; qr[j] = pr[PA_Q]; vr[j] = pr[PA_I]; } } while (0)
    CA_LOAD(0);
    for (int ch = 0; ch < 72; ++ch) {
        float loc[8], kk[8], run = 0.f;
#pragma unroll
        for (int j = 0; j < 8; ++j) { const float z = fmaxf(bf2f(zr[j]), -60.f); const float e = __expf(-z); const float sig = __builtin_amdgcn_rcpf(1.f + e);
            const float f = lb + omlb * sig; run += __logf(f); loc[j] = run; kk[j] = omlb * e * sig; }
        ((LAS float*)(L + OFF_QSUM))[tq * 128 + c] = run;
        __syncthreads();
        const float q0 = ((LAS float*)(L + OFF_QSUM))[c], q1 = ((LAS float*)(L + OFF_QSUM))[128 + c], q2 = ((LAS float*)(L + OFF_QSUM))[256 + c], q3 = ((LAS float*)(L + OFF_QSUM))[384 + c];
        const float off = tq == 0 ? 0.f : tq == 1 ? q0 : tq == 2 ? q0 + q1 : q0 + q1 + q2;
        const float rr = q0 + q1, tot = rr + q2 + q3;
        const float Er = __expf(rr), Eer = __expf(tot - rr);
        float ks[8];
#pragma unroll
        for (int j = 0; j < 8; ++j) { const float bb = off + loc[j]; const float e1 = __expf(bb - rr), ie1 = __expf(rr - bb); const float q = bf2f(qr[j]);
            const float qt = q * e1, kt = kk[j] * ie1; const int t = 8 * tq + j;
            *(LAS bf16*)(L + OFF_QT + t * CH_RS + c * 2) = f2bf(qt); *(LAS bf16*)(L + OFF_KT + t * CH_RS + c * 2) = f2bf(kt);
            *(LAS bf16*)(L + OFF_QS + t * CH_RS + c * 2) = f2bf(qt * Er); ks[j] = kt * Eer; }
        { u32x4 wv; wv.x = cvt_pk_bf16(ks[0], ks[1]); wv.y = cvt_pk_bf16(ks[2], ks[3]); wv.z = cvt_pk_bf16(ks[4], ks[5]); wv.w = cvt_pk_bf16(ks[6], ks[7]);
          *(LAS u32x4*)(L + OFF_KST + c * CH_TS + tq * 16) = wv;
          u32x4 vv; vv.x = (unsigned)vr[0] | ((unsigned)vr[1] << 16); vv.y = (unsigned)vr[2] | ((unsigned)vr[3] << 16); vv.z = (unsigned)vr[4] | ((unsigned)vr[5] << 16); vv.w = (unsigned)vr[6] | ((unsigned)vr[7] << 16);
          *(LAS u32x4*)(L + OFF_VT + c * CH_TS + tq * 16) = vv; }
        if (tq == 0) ((LAS float*)(L + OFF_DEC))[c] = __expf(tot);
        if (ch + 1 < 72) CA_LOAD(ch + 1);
        __syncthreads();
        f32x4 sc00 = {0.f, 0.f, 0.f, 0.f}, sc01 = sc00, sc11 = sc00;
#pragma unroll
        for (int ks_ = 0; ks_ < 4; ++ks_) { const int co = (32 * ks_ + 8 * g) * 2;
            const bf16x8 a0 = *(const LAS bf16x8*)(L + OFF_KT + i16 * CH_RS + co), a1 = *(const LAS bf16x8*)(L + OFF_KT + (16 + i16) * CH_RS + co);
            const bf16x8 b0 = *(const LAS bf16x8*)(L + OFF_QT + i16 * CH_RS + co), b1 = *(const LAS bf16x8*)(L + OFF_QT + (16 + i16) * CH_RS + co);
            sc00 = MFMA16(a0, b0, sc00); sc01 = MFMA16(a0, b1, sc01); sc11 = MFMA16(a1, b1, sc11); }
#pragma unroll
        for (int r = 0; r < 4; ++r) { const bool keep = (4 * g + r) <= i16; sc00[r] = keep ? sc00[r] : 0.f; sc11[r] = keep ? sc11[r] : 0.f; }
        const bf16x8 pb0 = pack8(sc00, (f32x4){0.f, 0.f, 0.f, 0.f}), pb1 = pack8(sc01, sc11);
        const LAS char* vrow = L + OFF_VT + (16 * w + i16) * CH_TS;
        const bf16x8 av = ld2x8(vrow + 8 * g, vrow + 32 + 8 * g);
        f32x4 o0 = MFMA16(av, pb0, ((f32x4){0.f, 0.f, 0.f, 0.f})), o1 = MFMA16(av, pb1, ((f32x4){0.f, 0.f, 0.f, 0.f}));
#pragma unroll
        for (int ks_ = 0; ks_ < 4; ++ks_) { const bf16x8 as = pack8(S[2 * ks_], S[2 * ks_ + 1]);
            const LAS char* q0p = L + OFF_QS + i16 * CH_RS + (32 * ks_ + 4 * g) * 2; const LAS char* q1p = q0p + 16 * CH_RS;
            o0 = MFMA16(as, ld2x8(q0p, q0p + 32), o0); o1 = MFMA16(as, ld2x8(q1p, q1p + 32), o1); }
        { const int r0 = chain_row(b, dir, ch * 32 + i16), r1 = chain_row(b, dir, ch * 32 + 16 + i16);
          u32x2 w0 = {cvt_pk_bf16(o0[0], o0[1]), cvt_pk_bf16(o0[2], o0[3])}, w1 = {cvt_pk_bf16(o1[0], o1[1]), cvt_pk_bf16(o1[2], o1[3])};
          *(u32x2*)(OA + (size_t)r0 * 512 + h * 128 + 16 * w + 4 * g) = w0; *(u32x2*)(OA + (size_t)r1 * 512 + h * 128 + 16 * w + 4 * g) = w1; }
        const bf16x8 bvt = *(const LAS bf16x8*)(vrow + 16 * g);
#pragma unroll
        for (int cb = 0; cb < 8; ++cb) { const f32x4 d4 = *(const LAS f32x4*)(L + OFF_DEC + (16 * cb + 4 * g) * 4);
            const bf16x8 a = *(const LAS bf16x8*)(L + OFF_KST + (16 * cb + i16) * CH_TS + 16 * g);
            S[cb] = MFMA16(a, bvt, S[cb] * d4); }
    }
    __syncthreads();
#undef CA_LOAD
}

__device__ __forceinline__ void chain_b(Frame& F, int l, int item) {
    const int b = item >> 3, h = (item >> 1) & 3, dir = item & 1;
    const bf16* P = (const bf16*)(F.ws + WS_R1);
    const float* GT = (const float*)(F.ws + WS_GATES);
    bf16* OB = (bf16*)(F.ws + WS_R2 + 72 * MiB) + (size_t)dir * M * 512;
    const int tid = F.tid, lane = F.lane, w = F.wave, c = tid & 127, tq = tid >> 7, i16 = lane & 15, g = lane >> 4;
    LAS char* L0 = (LAS char*)F.lds;
    const float* cw = F.in[I_CONVW] + l * 3 * 1024; const float* cbp = F.in[I_CONVB] + l * 1024;
    const int qc = h * 128 + c, kc = 512 + h * 128 + c;
    const float wq0 = cw[qc], wq1 = cw[1024 + qc], wq2 = cw[2048 + qc], cbq = cbp[qc];
    const float wk0 = cw[kc], wk1 = cw[1024 + kc], wk2 = cw[2048 + kc], cbk = cbp[kc];
    f32x4 S[8];
#pragma unroll
    for (int i = 0; i < 8; ++i) S[i] = (f32x4){0.f, 0.f, 0.f, 0.f};
    if (tid < 128) ((LAS float*)(L0 + OFF_NV))[tid] = 0.f;
    unsigned short xq[10], xk[10], vr[8]; float li_t, lf_t;
#define CB_LOAD(ch) do { const int isl = (ch) >= 8; const int len = isl ? TL : TC, rbase = b * RPB + (isl ? TC : 0); const int pl = ((ch) - (isl ? 8 : 0)) * 32 + 8 * tq; \
        const int nmin = dir ? len - 1 - (pl + 7) : pl; \
        _Pragma("unroll") for (int m = 0; m < 10; ++m) { const int n = nmin - 1 + m; const bool ok = (n >= 0) && (n < len); const bf16* pr = P + (size_t)(rbase + (ok ? n : 0)) * NP + h * 128 + c; \
            const unsigned short a = pr[PB_Q], bq_ = pr[PB_K]; xq[m] = ok ? a : (unsigned short)0; xk[m] = ok ? bq_ : (unsigned short)0; } \
        _Pragma("unroll") for (int j = 0; j < 8; ++j) { const int n = dir ? len - 1 - (pl + j) : pl + j; vr[j] = P[(size_t)(rbase + n) * NP + PB_V + h * 128 + c]; } \
        { const int row = chain_row(b, dir, (ch) * 32 + (lane & 31)); li_t = GT[(size_t)row * 16 + dir * 4 + h]; lf_t = GT[(size_t)row * 16 + 8 + dir * 4 + h]; } } while (0)
    CB_LOAD(0);
    for (int ch = 0; ch < 72; ++ch) {
        LAS char* L = L0 + (ch & 1) * CH_BUF;
        float bval = lf_t;
#pragma unroll
        for (int o = 1; o < 32; o <<= 1) { const float v = __shfl_up(bval, o); if ((lane & 31) >= o) bval += v; }
        const float b_end = __shfl(bval, 31);
        if (w == 0 && lane < 32) { ((LAS float*)(L + OFF_DEC))[lane] = bval; ((LAS float*)(L + OFF_DEC))[32 + lane] = li_t; }
        float kw[8];
#pragma unroll
        for (int j = 0; j < 8; ++j) { const int m = dir ? 7 - j : j; const int t = 8 * tq + j;
            const float qv = siluf_(cbq + wq0 * bf2f(xq[m]) + wq1 * bf2f(xq[m + 1]) + wq2 * bf2f(xq[m + 2])) * 0.088388347648318440f;
            const float kv = siluf_(cbk + wk0 * bf2f(xk[m]) + wk1 * bf2f(xk[m + 1]) + wk2 * bf2f(xk[m + 2]));
            const float bt = __shfl(bval, t), lit = __shfl(li_t, t);
            *(LAS bf16*)(L + OFF_QT + t * CH_RS + c * 2) = f2bf(qv); *(LAS bf16*)(L + OFF_KT + t * CH_RS + c * 2) = f2bf(kv);
            kw[j] = kv * __expf(b_end - bt + lit); }
        { u32x4 wv; wv.x = cvt_pk_bf16(kw[0], kw[1]); wv.y = cvt_pk_bf16(kw[2], kw[3]); wv.z = cvt_pk_bf16(kw[4], kw[5]); wv.w = cvt_pk_bf16(kw[6], kw[7]);
          *(LAS u32x4*)(L + OFF_KST + c * CH_TS + tq * 16) = wv;
          u32x4 vv; vv.x = (unsigned)vr[0] | ((unsigned)vr[1] << 16); vv.y = (unsigned)vr[2] | ((unsigned)vr[3] << 16); vv.z = (unsigned)vr[4] | ((unsigned)vr[5] << 16); vv.w = (unsigned)vr[6] | ((unsigned)vr[7] << 16);
          *(LAS u32x4*)(L + OFF_VT + c * CH_TS + tq * 16) = vv; }
        if (ch + 1 < 72) CB_LOAD(ch + 1);
        __syncthreads();
        const LAS float* BB = (const LAS float*)(L + OFF_DEC); const LAS float* LI = BB + 32;
        const LAS float* NVc = (const LAS float*)(L0 + OFF_NV) + (ch & 1) * 128; LAS float* NVn = (LAS float*)(L0 + OFF_NV) + ((ch + 1) & 1) * 128;
        f32x4 sc00 = {0.f, 0.f, 0.f, 0.f}, sc01 = sc00, sc11 = sc00;
#pragma unroll
        for (int ks_ = 0; ks_ < 4; ++ks_) { const int co = (32 * ks_ + 8 * g) * 2;
            const bf16x8 a0 = *(const LAS bf16x8*)(L + OFF_KT + i16 * CH_RS + co), a1 = *(const LAS bf16x8*)(L + OFF_KT + (16 + i16) * CH_RS + co);
            const bf16x8 b0 = *(const LAS bf16x8*)(L + OFF_QT + i16 * CH_RS + co), b1 = *(const LAS bf16x8*)(L + OFF_QT + (16 + i16) * CH_RS + co);
            sc00 = MFMA16(a0, b0, sc00); sc01 = MFMA16(a0, b1, sc01); sc11 = MFMA16(a1, b1, sc11); }
        const float bt0 = BB[i16], bt1 = BB[16 + i16], bend = BB[31];
        const f32x4 bs0 = *(const LAS f32x4*)(BB + 4 * g), bs1 = *(const LAS f32x4*)(BB + 16 + 4 * g), ls0 = *(const LAS f32x4*)(LI + 4 * g), ls1 = *(const LAS f32x4*)(LI + 16 + 4 * g);
        float dsum0 = 0.f, dsum1 = 0.f;
#pragma unroll
        for (int r = 0; r < 4; ++r) { const bool keep = (4 * g + r) <= i16;
            sc00[r] = keep ? sc00[r] * __expf(bt0 - bs0[r] + ls0[r]) : 0.f;
            sc01[r] = sc01[r] * __expf(bt1 - bs0[r] + ls0[r]);
            sc11[r] = keep ? sc11[r] * __expf(bt1 - bs1[r] + ls1[r]) : 0.f;
            dsum0 += sc00[r]; dsum1 += sc01[r] + sc11[r]; }
        float qn0 = 0.f, qn1 = 0.f;
#pragma unroll
        for (int k8 = 0; k8 < 4; ++k8) { const int c0 = 32 * g + 8 * k8;
            const u32x4 qa = *(const LAS u32x4*)(L + OFF_QT + i16 * CH_RS + c0 * 2), qb = *(const LAS u32x4*)(L + OFF_QT + (16 + i16) * CH_RS + c0 * 2);
            const f32x4 n0 = *(const LAS f32x4*)(NVc + c0), n1 = *(const LAS f32x4*)(NVc + c0 + 4);
            qn0 += bflo(qa.x) * n0[0] + bfhi(qa.x) * n0[1] + bflo(qa.y) * n0[2] + bfhi(qa.y) * n0[3] + bflo(qa.z) * n1[0] + bfhi(qa.z) * n1[1] + bflo(qa.w) * n1[2] + bfhi(qa.w) * n1[3];
            qn1 += bflo(qb.x) * n0[0] + bfhi(qb.x) * n0[1] + bflo(qb.y) * n0[2] + bfhi(qb.y) * n0[3] + bflo(qb.z) * n1[0] + bfhi(qb.z) * n1[1] + bflo(qb.w) * n1[2] + bfhi(qb.w) * n1[3]; }
        dsum0 += __shfl_xor(dsum0, 16); dsum0 += __shfl_xor(dsum0, 32); dsum1 += __shfl_xor(dsum1, 16); dsum1 += __shfl_xor(dsum1, 32);
        qn0 += __shfl_xor(qn0, 16); qn0 += __shfl_xor(qn0, 32); qn1 += __shfl_xor(qn1, 16); qn1 += __shfl_xor(qn1, 32);
        const bf16x8 pb0 = pack8(sc00, (f32x4){0.f, 0.f, 0.f, 0.f}), pb1 = pack8(sc01, sc11);
        const LAS char* vrow = L + OFF_VT + (16 * w + i16) * CH_TS;
        const bf16x8 av = ld2x8(vrow + 8 * g, vrow + 32 + 8 * g);
        const f32x4 z4 = {0.f, 0.f, 0.f, 0.f};
        f32x4 o0 = MFMA16(av, pb0, z4), o1 = MFMA16(av, pb1, z4), i0 = z4, i1 = z4;
#pragma unroll
        for (int ks_ = 0; ks_ < 4; ++ks_) { const bf16x8 as = pack8(S[2 * ks_], S[2 * ks_ + 1]);
            const LAS char* q0p = L + OFF_QT + i16 * CH_RS + (32 * ks_ + 4 * g) * 2; const LAS char* q1p = q0p + 16 * CH_RS;
            i0 = MFMA16(as, ld2x8(q0p, q0p + 32), i0); i1 = MFMA16(as, ld2x8(q1p, q1p + 32), i1); }
        { const float e0 = __expf(bt0), e1 = __expf(bt1);
          const float den0 = dsum0 + e0 * qn0, den1 = dsum1 + e1 * qn1;
          const float s0 = __builtin_amdgcn_rcpf(fmaxf(fabsf(den0), 1.f)), s1 = __builtin_amdgcn_rcpf(fmaxf(fabsf(den1), 1.f));
          o0 = (o0 + i0 * e0) * s0; o1 = (o1 + i1 * e1) * s1;
          const int r0 = chain_row(b, dir, ch * 32 + i16), r1 = chain_row(b, dir, ch * 32 + 16 + i16);
          u32x2 w0 = {cvt_pk_bf16(o0[0], o0[1]), cvt_pk_bf16(o0[2], o0[3])}, w1 = {cvt_pk_bf16(o1[0], o1[1]), cvt_pk_bf16(o1[2], o1[3])};
          *(u32x2*)(OB + (size_t)r0 * 512 + h * 128 + 16 * w + 4 * g) = w0; *(u32x2*)(OB + (size_t)r1 * 512 + h * 128 + 16 * w + 4 * g) = w1; }
        const float dec = __expf(bend);
        const bf16x8 bvt = *(const LAS bf16x8*)(vrow + 16 * g);
#pragma unroll
        for (int cb = 0; cb < 8; ++cb) { const bf16x8 a = *(const LAS bf16x8*)(L + OFF_KST + (16 * cb + i16) * CH_TS + 16 * g);
            S[cb] = MFMA16(a, bvt, S[cb] * dec); }
        if (tid < 128) { const LAS u32x4* kr = (const LAS u32x4*)(L + OFF_KST + tid * CH_TS); float s = 0.f;
#pragma unroll
            for (int k4 = 0; k4 < 4; ++k4) { const u32x4 x = kr[k4]; s += (bflo(x.x) + bfhi(x.x)) + (bflo(x.y) + bfhi(x.y)) + (bflo(x.z) + bfhi(x.z)) + (bflo(x.w) + bfhi(x.w)); }
            NVn[tid] = dec * NVc[tid] + s; }
    }
    __syncthreads();
#undef CB_LOAD
}

__device__ __forceinline__ void phase_mix(Frame& F, int l) {
    volatile LAS unsigned* MISC = (volatile LAS unsigned*)(F.lds + LDSCTL_OFF);
    for (;;) {
        if (F.tid == 0) MISC[16] = __hip_atomic_fetch_add(F.ctl + CW_QUEUE + 64 * l, 1u, RLX_AGENT);
        __syncthreads();
        const int idx = (int)MISC[16];
        __syncthreads();
        if (idx >= 704) break;
#ifndef MIXMASK
#define MIXMASK 7
#endif
        if (idx < 64) { if (MIXMASK & 1) { Frame Fi = fresh(F); chain_a(Fi, l, idx); } }
        else if (idx < 128) { if (MIXMASK & 2) { Frame Fi = fresh(F); chain_b(Fi, l, idx - 64); } }
        else if (!(MIXMASK & 4)) {}
        else if (idx < 640) { Frame Fi = fresh(F); const bf16* P = (const bf16*)(Fi.ws + WS_R1); bf16* OC = (bf16*)(Fi.ws + WS_R2); const int u = idx - 128, qb = u & 7, cm = (u >> 3) & 1, h = (u >> 4) & 3, b = u >> 6;
            const size_t r0 = (size_t)b * RPB + TC + qb * 256, k0 = (size_t)b * RPB;
            att::attn_unit(P + r0 * NP + PC_Q + h * 128 + cm * 64, P + k0 * NP + PC_K + h * 128 + cm * 64, P + k0 * NP + PC_V + h * 128, OC + r0 * D + (h * 2 + cm) * 128, RPB, (char*)Fi.lds_generic, Fi.tid); }
        else { Frame Fi = fresh(F); const bf16* P = (const bf16*)(Fi.ws + WS_R1); bf16* OC = (bf16*)(Fi.ws + WS_R2); const int u = idx - 640, cm = u & 1, h = (u >> 1) & 3, b = u >> 3; const size_t r0 = (size_t)b * RPB;
            att::attn_unit(P + r0 * NP + PC_Q + h * 128 + cm * 64, P + r0 * NP + PC_K + h * 128 + cm * 64, P + r0 * NP + PC_V + h * 128, OC + r0 * D + (h * 2 + cm) * 128, TC, (char*)Fi.lds_generic, Fi.tid); }
    }
}

__device__ __forceinline__ float head_rstd(float ss) {
    ss += __shfl_xor(ss, 1); ss += __shfl_xor(ss, 2); ss += __shfl_xor(ss, 4); ss += __shfl_xor(ss, 8);
    return rsqrtf(ss * (1.f / 128.f) + EPS);
}
__device__ __forceinline__ void unpack8(const u32x4 w, float (&v)[8]) { v[0] = bflo(w.x); v[1] = bfhi(w.x); v[2] = bflo(w.y); v[3] = bfhi(w.y); v[4] = bflo(w.z); v[5] = bfhi(w.z); v[6] = bflo(w.w); v[7] = bfhi(w.w); }
__device__ __forceinline__ u32x4 pack8f(const float (&v)[8]) { u32x4 w; w.x = cvt_pk_bf16(v[0], v[1]); w.y = cvt_pk_bf16(v[2], v[3]); w.z = cvt_pk_bf16(v[4], v[5]); w.w = cvt_pk_bf16(v[6], v[7]); return w; }
__device__ __forceinline__ void phase_prep(Frame& F, int l) {
    const int gw = F.bid * NWAVES + F.wave, NGW = F.G * NWAVES, lane = F.lane, c8 = 8 * lane, head = lane >> 4;
    bf16* P = (bf16*)(F.ws + WS_R1);
    const bf16* OC = (const bf16*)(F.ws + WS_R2); const bf16* OA = (const bf16*)(F.ws + WS_R2 + 36 * MiB); const bf16* OB = (const bf16*)(F.ws + WS_R2 + 72 * MiB);
    const float lam_init = 0.8f - 0.6f * expf(-0.3f * (float)l);
    const float* lv = F.in[I_LAM] + l * 256;
    const float lam = expf(wave_sum(lv[lane] * lv[64 + lane])) - expf(wave_sum(lv[128 + lane] * lv[192 + lane])) + lam_init;
    float ag[8], bg[8], cg[8];
#pragma unroll
    for (int e = 0; e < 8; ++e) { ag[e] = F.in[I_AG][l * 512 + c8 + e]; bg[e] = F.in[I_BG][l * 512 + c8 + e]; cg[e] = F.in[I_CG][l * 512 + c8 + e] * (1.f - lam_init); }
    for (int r = gw; r < M; r += NGW) {
        bf16* pr = P + (size_t)r * NP;
        float a0[8], a1[8], gt[8], y[8];
        unpack8(*(const u32x4*)(OA + (size_t)r * 512 + c8), a0); unpack8(*(const u32x4*)(OA + (size_t)M * 512 + (size_t)r * 512 + c8), a1); unpack8(*(const u32x4*)(pr + PA_G + c8), gt);
        float ss = 0.f;
#pragma unroll
        for (int e = 0; e < 8; ++e) { a0[e] += a1[e]; ss += a0[e] * a0[e]; }
        float rs = head_rstd(ss);
#pragma unroll
        for (int e = 0; e < 8; ++e) y[e] = a0[e] * rs * ag[e] * gt[e];
        const u32x4 ya = pack8f(y);
        unpack8(*(const u32x4*)(OB + (size_t)r * 512 + c8), a0); unpack8(*(const u32x4*)(OB + (size_t)M * 512 + (size_t)r * 512 + c8), a1); unpack8(*(const u32x4*)(pr + PB_O + c8), gt);
        ss = 0.f;
#pragma unroll
        for (int e = 0; e < 8; ++e) { a0[e] += a1[e]; ss += a0[e] * a0[e]; }
        rs = head_rstd(ss);
#pragma unroll
        for (int e = 0; e < 8; ++e) y[e] = a0[e] * rs * bg[e] * gt[e];
        const u32x4 yb = pack8f(y);
        unpack8(*(const u32x4*)(OC + (size_t)r * D + (head * 2) * 128 + (c8 & 127)), a0); unpack8(*(const u32x4*)(OC + (size_t)r * D + (head * 2 + 1) * 128 + (c8 & 127)), a1);
        ss = 0.f;
#pragma unroll
        for (int e = 0; e < 8; ++e) { a0[e] -= lam * a1[e]; ss += a0[e] * a0[e]; }
        rs = head_rstd(ss);
#pragma unroll
        for (int e = 0; e < 8; ++e) y[e] = a0[e] * rs * cg[e];
        const u32x4 yc = pack8f(y);
        *(u32x4*)(pr + c8) = ya; *(u32x4*)(pr + 512 + c8) = yb; *(u32x4*)(pr + 1024 + c8) = yc;
    }
}

__device__ __forceinline__ void phase_norm2(Frame& F, int l) {
    LAS float* WR = (LAS float*)F.lds;
    const float* rgw = F.in[I_RGW] + (size_t)l * 1024 * 4; const float* rew = F.in[I_REW] + (size_t)l * 1024 * 32;
    for (int i = F.tid; i < 1024 * 9; i += NTHR) { const int k = i / 9, q = i % 9;
        const f32x4 v = q == 0 ? *(const f32x4*)(rgw + k * 4) : *(const f32x4*)(rew + k * 32 + (q - 1) * 4);
        *(LAS f32x4*)(WR + k * 36 + q * 4) = v; }
    __syncthreads();
    const int gw = F.bid * NWAVES + F.wave, NGW = F.G * NWAVES, lane = F.lane;
    const float* X = (const float*)(F.ws + WS_X); bf16* H = (bf16*)(F.ws + WS_H);
    const float* ng = F.in[I_N2G] + l * 1024;
    unsigned* cnt = F.ctl + CW_ECNT + 64 * l;
    for (int r = gw; r < M; r += NGW) {
        const float* xr = X + (size_t)r * D; const float* mod = ws_mod(F, l, row_mi(r));
        float hv[16], ss = 0.f;
#pragma unroll
        for (int i = 0; i < 16; ++i) { hv[i] = xr[lane + 64 * i]; ss += hv[i] * hv[i]; }
        const float rstd = rsqrtf(wave_sum(ss) * (1.f / D) + EPS);
        float lg[36];
#pragma unroll
        for (int q = 0; q < 36; ++q) lg[q] = 0.f;
#pragma unroll
        for (int i = 0; i < 16; ++i) { const int c = lane + 64 * i;
            const float h = hv[i] * rstd * ng[c] * (1.f + mod[4096 + c]) + mod[3072 + c];
            H[(size_t)r * D + c] = f2bf(h);
#pragma unroll
            for (int q4 = 0; q4 < 9; ++q4) { const f32x4 w = *(const LAS f32x4*)(WR + c * 36 + q4 * 4);
                lg[q4 * 4 + 0] += h * w.x; lg[q4 * 4 + 1] += h * w.y; lg[q4 * 4 + 2] += h * w.z; lg[q4 * 4 + 3] += h * w.w; } }
#pragma unroll
        for (int q = 0; q < 36; ++q) lg[q] = wave_sum(lg[q]);
        float gl[4];
#pragma unroll
        for (int q = 0; q < 4; ++q) gl[q] = lg[q] + F.in[I_RGB][l * 4 + q];
        int gi = 0; float gm = gl[0];
#pragma unroll
        for (int q = 1; q < 4; ++q) if (gl[q] > gm) { gm = gl[q]; gi = q; }
        float gs = 0.f;
#pragma unroll
        for (int q = 0; q < 4; ++q) gs += expf(gl[q] - gm);
        const float pg = 1.f / gs;
        float el[8];
#pragma unroll
        for (int q = 0; q < 8; ++q) { float v = 0.f;
#pragma unroll
            for (int gq = 0; gq < 4; ++gq) v = (gi == gq) ? lg[4 + gq * 8 + q] + F.in[I_REB][l * 32 + gq * 8 + q] : v;
            el[q] = v; }
        int i0 = 0; float m0 = el[0];
#pragma unroll
        for (int q = 1; q < 8; ++q) if (el[q] > m0) { m0 = el[q]; i0 = q; }
        int i1 = -1; float m1 = -3.0e38f;
#pragma unroll
        for (int q = 0; q < 8; ++q) if (q != i0 && el[q] > m1) { m1 = el[q]; i1 = q; }
        const float t = expf(m1 - m0);
        const float w0 = pg / (1.f + t), w1 = pg * t / (1.f + t);
        if (lane == 0) { const int e0 = gi * 8 + i0, e1 = gi * 8 + i1;
            const unsigned p0 = __hip_atomic_fetch_add(cnt + e0, 1u, RLX_AGENT), p1 = __hip_atomic_fetch_add(cnt + e1, 1u, RLX_AGENT);
            int* rt = (int*)(F.ws + WS_ROUTE) + (size_t)r * 8; rt[0] = e0; rt[1] = e1; rt[2] = (int)p0; rt[3] = (int)p1; ((float*)rt)[4] = w0; ((float*)rt)[5] = w1; }
    }
    __syncthreads();
}

__device__ __forceinline__ int expert_pstart(const unsigned* cnt, int e) {
    int s = 0;
    for (int q = 0; q < e; ++q) s += (int)((cnt[q] + 255u) & ~255u);
    return s;
}
__device__ __forceinline__ void phase_dispatch(Frame& F, int l) {
    const int gw = F.bid * NWAVES + F.wave, NGW = F.G * NWAVES, lane = F.lane;
    const unsigned* cnt = F.ctl + CW_ECNT + 64 * l;
    const bf16* H = (const bf16*)(F.ws + WS_H); bf16* XD = (bf16*)(F.ws + WS_R1);
    for (int r = gw; r < M; r += NGW) {
        int* rt = (int*)(F.ws + WS_ROUTE) + (size_t)r * 8;
        const int e0 = rt[0], e1 = rt[1], p0 = rt[2], p1 = rt[3];
        const int s0 = expert_pstart(cnt, e0) + p0, s1 = expert_pstart(cnt, e1) + p1;
        const u32x4* hp = (const u32x4*)(H + (size_t)r * D) + lane; const u32x4 v0 = hp[0], v1 = hp[64];
        u32x4* d0 = (u32x4*)(XD + (size_t)s0 * D) + lane; d0[0] = v0; d0[64] = v1;
        u32x4* d1 = (u32x4*)(XD + (size_t)s1 * D) + lane; d1[0] = v0; d1[64] = v1;
        if (lane == 0) { rt[6] = s0; rt[7] = s1; }
    }
}
__device__ __forceinline__ int build_tile_table(Frame& F, int l) {
    volatile LAS unsigned* MISC = (volatile LAS unsigned*)(F.lds + LDSCTL_OFF);
    const unsigned* cnt = F.ctl + CW_ECNT + 64 * l;
    if (F.tid == 0) { int t = 0; for (int e = 0; e < NEXP; ++e) { const int nt = (int)((cnt[e] + 255u) >> 8); for (int k = 0; k < nt && t < 176; ++k) MISC[32 + t++] = (unsigned)e; } MISC[17] = (unsigned)t; }
    __syncthreads();
    return (int)MISC[17];
}

__device__ __forceinline__ void phase_combine(Frame& F, int l) {
    const int gw = F.bid * NWAVES + F.wave, NGW = F.G * NWAVES, lane = F.lane;
    float* X = (float*)(F.ws + WS_X); const bf16* YM = (const bf16*)(F.ws + WS_R2);
    if (l == 0) stage_gate_w(F, 1);
    for (int r = gw; r < M; r += NGW) {
        const int* rt = (const int*)(F.ws + WS_ROUTE) + (size_t)r * 8;
        const float w0 = ((const float*)rt)[4], w1 = ((const float*)rt)[5]; const int s0 = rt[6], s1 = rt[7];
        const float* g2 = ws_mod(F, l, row_mi(r)) + 5120;
        f32x4 xv[4]; f32x4* xp = (f32x4*)(X + (size_t)r * D) + lane;
#pragma unroll
        for (int j = 0; j < 4; ++j) { const int c0 = 4 * lane + 256 * j;
            const u32x2 a = *(const u32x2*)(YM + (size_t)s0 * D + c0), b = *(const u32x2*)(YM + (size_t)s1 * D + c0);
            const f32x4 g = *(const f32x4*)(g2 + c0); f32x4 x = xp[64 * j];
            x.x += g.x * (w0 * bflo(a.x) + w1 * bflo(b.x)); x.y += g.y * (w0 * bfhi(a.x) + w1 * bfhi(b.x));
            x.z += g.z * (w0 * bflo(a.y) + w1 * bflo(b.y)); x.w += g.w * (w0 * bfhi(a.y) + w1 * bfhi(b.y));
            xv[j] = x; }
        if (l == 0) {
#pragma unroll
            for (int j = 0; j < 4; ++j) xp[64 * j] = xv[j];
            norm1_row(F, 1, r, xv);
        } else {
            const int b = r / RPB, s = r - b * RPB;
            if (s >= TC) {
                float ss = 0.f;
#pragma unroll
                for (int j = 0; j < 4; ++j) ss += (xv[j].x * xv[j].x + xv[j].y * xv[j].y) + (xv[j].z * xv[j].z + xv[j].w * xv[j].w);
                const float rstd = rsqrtf(wave_sum(ss) * (1.f / D) + EPS);
                f32x4* op = (f32x4*)(F.out + ((size_t)b * TL + (s - TC)) * D) + lane;
#pragma unroll
                for (int j = 0; j < 4; ++j) { const f32x4 g = *(const f32x4*)(F.in[I_FING] + 4 * lane + 256 * j); op[64 * j] = xv[j] * rstd * g; }
            }
        }
    }
    __syncthreads();
}

__device__ __forceinline__ void dbg_final(Frame& Fp) {
    const int gw = Fp.bid * NWAVES + Fp.wave, NGW = Fp.G * NWAVES;
    const float* X = (const float*)(Fp.ws + WS_X);
    for (int r = gw; r < M; r += NGW) { const int b = r / RPB, s = r - b * RPB; if (s < TC) continue;
        f32x4 xv[4]; const f32x4* xp = (const f32x4*)(X + (size_t)r * D) + Fp.lane; float ss = 0.f;
#pragma unroll
        for (int j = 0; j < 4; ++j) { xv[j] = xp[64 * j]; ss += (xv[j].x * xv[j].x + xv[j].y * xv[j].y) + (xv[j].z * xv[j].z + xv[j].w * xv[j].w); }
        const float rstd = rsqrtf(wave_sum(ss) * (1.f / D) + EPS);
        f32x4* op = (f32x4*)(Fp.out + ((size_t)b * TL + (s - TC)) * D) + Fp.lane;
#pragma unroll
        for (int j = 0; j < 4; ++j) { const f32x4 g = *(const f32x4*)(Fp.in[I_FING] + 4 * Fp.lane + 256 * j); op[64 * j] = xv[j] * rstd * g; } }
}
struct Args { const float* in[29]; float* out; unsigned char* ws; int pad[2]; };
__global__ void __launch_bounds__(NTHR, 2) fwd_kernel(Args args) {
    extern __shared__ __attribute__((aligned(16))) unsigned char lds[];
    Frame F;
    F.lds = (LAS unsigned char*)lds; F.lds_generic = lds;
    F.ws = args.ws; F.ctl = (unsigned*)(args.ws + WS_CTL);
    F.tid = threadIdx.x; F.lane = F.tid & 63; F.wave = __builtin_amdgcn_readfirstlane(F.tid >> 6); F.G = gridDim.x; F.bid = blockIdx.x;
    F.in = (KargIn)__builtin_amdgcn_kernarg_segment_ptr(); F.out = args.out;
    volatile LAS unsigned* MISC = (volatile LAS unsigned*)(F.lds + LDSCTL_OFF);
    for (int u = F.tid; u < 256; u += NTHR) MISC[u] = 0u;
    __syncthreads();
    (void)xcd_barrier_post(F.ctl + CW_BAR, MISC + 8);
#define GRID_BAR() do { XcdBarrier bb_; bb_.bar = (unsigned*)((unsigned char*)opaque_ptr((unsigned long long)F.ws) + WS_CTL) + CW_BAR; bb_.x = xb_xcc_id(); bb_.st = MISC + 8; xcd_barrier(bb_); } while (0)
#ifdef DBG_IDENT
    { { Frame Fp = fresh(F); phase_init(Fp); } GRID_BAR(); GRID_BAR(); Frame Fp = fresh(F); dbg_final(Fp); return; }
#endif
#ifndef PHMASK
#define PHMASK 0xffff
#endif
#define ON(k) ((PHMASK >> (k)) & 1)
    if (ON(0)) { Frame Fp = fresh(F); phase_convert(Fp, 0); __syncthreads(); phase_init(Fp); }
    GRID_BAR();
    if (ON(1)) { Frame Fp = fresh(F); phase_norm1(Fp, 0); }
    GRID_BAR();
    for (int l = 0; l < 2; ++l) {
        if (ON(2)) {
            Frame Fp = fresh(F); bf16* Wb = (bf16*)(Fp.ws + WS_W);
            pg8::Gemm g{(bf16*)(Fp.ws + WS_H), Wb + W_IN / 2, 1024, 1024, 1024}; pg8::StaticOrder S; S.init(M, NP, Fp.G, Fp.bid);
            EpiInProj E{(bf16*)(Fp.ws + WS_R1), (const float*)(Fp.ws + WS_ROPE)};
            pg8::gemm_phase(Fp.lds, Fp.tid, g, S, E);
        }
        GRID_BAR();
        if (ON(3)) { Frame Fp = fresh(F); phase_mix(Fp, l); }
        GRID_BAR();
        if (ON(4)) { Frame Fp = fresh(F); phase_prep(Fp, l); }
        GRID_BAR();
        if (ON(5)) {
            Frame Fp = fresh(F); bf16* Wb = (bf16*)(Fp.ws + WS_W);
            pg8::Gemm g{(bf16*)(Fp.ws + WS_R1), Wb + W_BR / 2, 512, NP, 512}; pg8::StaticOrder S; S.init(M, 1024, Fp.G, Fp.bid, 3, (size_t)512 * 2, (size_t)1024 * 512 * 2);
            EpiPlain E{(bf16*)(Fp.ws + WS_R2), 3072, 0, 1024};
            pg8::gemm_phase(Fp.lds, Fp.tid, g, S, E);
        }
        GRID_BAR();
        if (ON(6)) {
            Frame Fp = fresh(F); bf16* Wb = (bf16*)(Fp.ws + WS_W);
            pg8::Gemm g{(bf16*)(Fp.ws + WS_H), Wb + W_GP / 2, 1024, 1024, 1024}; pg8::StaticOrder S; S.init(M, 4096, Fp.G, Fp.bid);
            EpiGates E{(bf16*)(Fp.ws + WS_R2), (bf16*)(Fp.ws + WS_R1), Fp.in[I_BGATE] + l * 3072};
            pg8::gemm_phase(Fp.lds, Fp.tid, g, S, E);
        }
        GRID_BAR();
        if (ON(7)) {
            Frame Fp = fresh(F); bf16* Wb = (bf16*)(Fp.ws + WS_W);
            pg8::Gemm g{(bf16*)(Fp.ws + WS_R1), Wb + W_OUT / 2, 1024, 1024, 1024}; pg8::StaticOrder S; S.init(M, 1024, Fp.G, Fp.bid);
            EpiOut E{(float*)(Fp.ws + WS_X), ws_mod(Fp, l, 0)};
            pg8::gemm_phase(Fp.lds, Fp.tid, g, S, E);
        }
        GRID_BAR();
#if defined(DBG_STOP) && DBG_STOP == 7
        { Frame Fp = fresh(F); dbg_final(Fp); return; }
#endif
        if (ON(8)) { Frame Fp = fresh(F); phase_norm2(Fp, l); }
        GRID_BAR();
        if (ON(9)) { Frame Fp = fresh(F); phase_dispatch(Fp, l); }
        GRID_BAR();
        if (ON(10)) {
            Frame Fp = fresh(F); bf16* Wb = (bf16*)(Fp.ws + WS_W);
            const int ntiles = build_tile_table(Fp, l);
            pg8::Gemm g{(bf16*)(Fp.ws + WS_R1), Wb + W_13 / 2, 1024, 1024, 1024}; GroupedOrder S{(const volatile LAS int*)(MISC + 32), ntiles, Fp.G, Fp.bid, (size_t)1024 * 1024 * 2};
            EpiMoe1 E{(bf16*)(Fp.ws + WS_R1 + 88 * MiB)};
            pg8::gemm_phase(Fp.lds, Fp.tid, g, S, E);
        }
        GRID_BAR();
        if (ON(11)) {
            Frame Fp = fresh(F); bf16* Wb = (bf16*)(Fp.ws + WS_W);
            const int ntiles = build_tile_table(Fp, l);
            pg8::Gemm g{(bf16*)(Fp.ws + WS_R1 + 88 * MiB), Wb + W_2 / 2, 512, 512, 512}; GroupedOrder S{(const volatile LAS int*)(MISC + 32), ntiles, Fp.G, Fp.bid, (size_t)1024 * 512 * 2};
            EpiPlain E{(bf16*)(Fp.ws + WS_R2), 1024, 0, 0};
            pg8::gemm_phase(Fp.lds, Fp.tid, g, S, E);
        }
        GRID_BAR();
        if (ON(12)) { Frame Fp = fresh(F); if (l == 0) { phase_convert(Fp, 1); __syncthreads(); } phase_combine(Fp, l); }
        if (l == 0) GRID_BAR();
#if defined(DBG_STOP) && DBG_STOP == 12
        { Frame Fp = fresh(F); dbg_final(Fp); return; }
#endif
    }
}

extern "C" void kernel_launch(void* const* d_in, const int* in_sizes, int n_in, void* d_out, int out_size, void* d_ws, size_t ws_size, hipStream_t stream) {
    static int grid = 0;
    if (grid == 0) {
        if (n_in != 29 || out_size != NB * TL * D || ws_size < WS_END) { fprintf(stderr, "kernel_launch: unexpected shapes: n_in %d out %d ws %zu (need %zu)\n", n_in, out_size, ws_size, (size_t)WS_END); grid = -1; return; }
        int dev = 0, cus = 0, per_cu = 0;
        if (hipGetDevice(&dev) != hipSuccess || hipDeviceGetAttribute(&cus, hipDeviceAttributeMultiprocessorCount, dev) != hipSuccess) { grid = -1; return; }
        if (hipFuncSetAttribute((const void*)fwd_kernel, hipFuncAttributeMaxDynamicSharedMemorySize, LDS_BYTES) != hipSuccess) { fprintf(stderr, "kernel_launch: hipFuncSetAttribute failed\n"); grid = -1; return; }
        if (hipOccupancyMaxActiveBlocksPerMultiprocessor(&per_cu, (const void*)fwd_kernel, NTHR, LDS_BYTES) != hipSuccess || per_cu < 1) { fprintf(stderr, "kernel_launch: occupancy query says %d blocks per CU\n", per_cu); }
        (void)hipGetLastError();
        grid = cus;
    }
    if (grid < 0) return;
    if (hipMemsetAsync((char*)d_ws + WS_CTL, 0, CTL_ZERO_BYTES, stream) != hipSuccess) return;
    Args a{};
    for (int i = 0; i < 29; ++i) a.in[i] = (const float*)d_in[i];
    a.out = (float*)d_out; a.ws = (unsigned char*)d_ws;
    hipLaunchKernelGGL(fwd_kernel, dim3(grid), dim3(NTHR), LDS_BYTES, stream, a);
}
```

```cpp
#include <hip/hip_runtime.h>
#include <cstdio>
#include <cstdint>

#define GAS __attribute__((address_space(1)))
#define LAS __attribute__((address_space(3)))
typedef unsigned short bf16;
typedef short bf16x8 __attribute__((ext_vector_type(8)));
typedef short s16x4 __attribute__((ext_vector_type(4)));
typedef float f32x2 __attribute__((ext_vector_type(2)));
typedef float f32x4 __attribute__((ext_vector_type(4)));
typedef float f32x16 __attribute__((ext_vector_type(16)));
typedef unsigned u32x2 __attribute__((ext_vector_type(2)));
typedef unsigned u32x4 __attribute__((ext_vector_type(4)));
typedef GAS unsigned gu32;
typedef int i32x4 __attribute__((ext_vector_type(4)));
typedef int i32x8 __attribute__((ext_vector_type(8)));
#ifndef F8MOE
#define F8MOE 3
#endif
#ifndef F8GT
#define F8GT 3
#endif
static_assert(F8GT == 0 || F8MOE == 3, "the fp8 copy of the norm1 output lives in the half of the expert-weight region that fp8 expert weights leave free");
constexpr float F8_SH = 8.f, F8_SW = 256.f, F8_SU = 4.f;

constexpr int NB = 8, TL = 2048, TC = 256, RPB = TL + TC  , M = NB * RPB  , D = 1024;
constexpr int NP = 6144;
constexpr int NWAVES = 8, NTHR = 512;
constexpr int PA_Q = 0, PA_I = 512, PA_G = 1024, PA_F = 1536, PB_Q = 2560, PB_K = 3072, PB_V = 3584, PB_O = 4096, PC_Q = 4608, PC_K = 5120, PC_V = 5632;
constexpr int WIN_N = 6160, WIN_GATE0 = 4608;
constexpr int NEXP = 32, DEXP = 512;
constexpr int ECAP = NB * RPB;
constexpr int MAXSLOT = 45056;
constexpr float EPS = 1e-6f;

constexpr size_t MiB = 1u << 20;
constexpr size_t WS_CTL = 0, CTL_ZERO_BYTES = 1 * MiB;
constexpr size_t WS_MOD = 1 * MiB;
constexpr size_t WS_ROPE = 2 * MiB;
constexpr size_t WS_GATES = 3 * MiB;
constexpr size_t WS_ROUTE = 5 * MiB;
constexpr size_t WS_WRT = 7 * MiB;
constexpr size_t WS_W = 8 * MiB;
constexpr size_t W_IN = 0, W_GP = 12 * MiB, W_BR = 20 * MiB, W_OUT = 23 * MiB, W_13 = 25 * MiB, W_2 = 89 * MiB, W_END = 121 * MiB;
constexpr size_t WS_X = WS_W + W_END;
constexpr size_t WS_H = WS_X + 72 * MiB;
constexpr size_t WS_R1 = WS_H + 36 * MiB;
constexpr size_t WS_R2 = WS_R1 + 216 * MiB;
constexpr size_t WS_H8 = WS_R1 + 8 * MiB;
constexpr size_t WS_HG8 = WS_W + W_13 + 32 * MiB;
constexpr size_t WS_END = WS_R2 + 108 * MiB;

constexpr int CW_QUEUE = 64;
constexpr int CW_ECNT = 8192;
constexpr int CW_BAR = 4096;

constexpr int LDS_BYTES = 155648;
constexpr int LDSCTL_OFF = 153600;
constexpr int RING_OFF = 0;

#define RLX_AGENT __ATOMIC_RELAXED, __HIP_MEMORY_SCOPE_AGENT
#define LDS_WAIT() asm volatile("s_waitcnt lgkmcnt(0)" ::: "memory")
#define VM_WAIT() asm volatile("s_waitcnt vmcnt(0)" ::: "memory")
typedef __bf16 bf16x2_t __attribute__((ext_vector_type(2)));
__device__ __forceinline__ unsigned cvt_pk_bf16(float lo, float hi) { const f32x2 v = {lo, hi}; const bf16x2_t b = __builtin_convertvector(v, bf16x2_t); return __builtin_bit_cast(unsigned, b); }
__device__ __forceinline__ unsigned pk_fp8x4(float a, float b, float c, float d) {
    float mx = 448.f; asm volatile("" : "+v"(mx)); const float mn = -mx;
    a = __builtin_amdgcn_fmed3f(a, mn, mx); b = __builtin_amdgcn_fmed3f(b, mn, mx); c = __builtin_amdgcn_fmed3f(c, mn, mx); d = __builtin_amdgcn_fmed3f(d, mn, mx);
    unsigned w = __builtin_amdgcn_cvt_pk_fp8_f32(a, b, 0, false); return __builtin_amdgcn_cvt_pk_fp8_f32(c, d, w, true); }
__device__ __forceinline__ i32x8 cat8(bf16x8 a, bf16x8 b) { const i32x4 x = __builtin_bit_cast(i32x4, a), y = __builtin_bit_cast(i32x4, b); return __builtin_shufflevector(x, y, 0, 1, 2, 3, 4, 5, 6, 7); }
__device__ __forceinline__ float bf2f(unsigned h) { return __uint_as_float(h << 16); }
__device__ __forceinline__ float bflo(unsigned w) { return __uint_as_float(w << 16); }
__device__ __forceinline__ float bfhi(unsigned w) { return __uint_as_float(w & 0xffff0000u); }
__device__ __forceinline__ bf16 f2bf(float f) { return (bf16)(cvt_pk_bf16(f, 0.f) & 0xffffu); }
template <int CTRL> __device__ __forceinline__ float dpp_mov(float v) { return __int_as_float(__builtin_amdgcn_update_dpp(0, __float_as_int(v), CTRL, 0xf, 0xf, true)); }
__device__ __forceinline__ float swap16_add(float v) { auto r = __builtin_amdgcn_permlane16_swap(__float_as_uint(v), __float_as_uint(v), false, false); return __uint_as_float(r[0]) + __uint_as_float(r[1]); }
__device__ __forceinline__ float swap32_add(float v) { auto r = __builtin_amdgcn_permlane32_swap(__float_as_uint(v), __float_as_uint(v), false, false); return __uint_as_float(r[0]) + __uint_as_float(r[1]); }
__device__ __forceinline__ float row_sum(float v) { v += dpp_mov<0xB1>(v); v += dpp_mov<0x4E>(v); v += dpp_mov<0x141>(v); v += dpp_mov<0x140>(v); return v; }
__device__ __forceinline__ float wave_sum(float v) { v = row_sum(v); v = swap16_add(v); return swap32_add(v); }
__device__ __forceinline__ float sigmoidf_(float x) { return __builtin_amdgcn_rcpf(1.f + __builtin_amdgcn_exp2f(-1.4426950408889634f * x)); }
__device__ __forceinline__ float siluf_(float x) { return x * __builtin_amdgcn_rcpf(1.f + __builtin_amdgcn_exp2f(-1.4426950408889634f * x)); }
__device__ __forceinline__ float log_sigmoidf_(float x) { return fminf(x, 0.f) - log1pf(__expf(-fabsf(x))); }

__device__ __forceinline__ int fresh_lane() { int l; asm volatile("v_mbcnt_lo_u32_b32 %0, -1, 0\n\tv_mbcnt_hi_u32_b32 %0, -1, %0" : "=v"(l)); return l; }
namespace pg8 {
constexpr int BM = 256, BK = 64, HALF = 128, HTB = HALF * BK * 2, NXCD = 8, WGM = 8;
__host__ __device__ __forceinline__ int lds_byte(int r, int c) { const int st = (r >> 4) * 2 + (c >> 5), rr = r & 15, cc = c & 31, ob = rr * 64 + cc * 2; return st * 1024 + (ob ^ (((ob >> 9) & 1) << 5)); }
__host__ __device__ __forceinline__ void stage_rc(int b, int& R, int& C) { const int st = b / 1024, sb = b % 1024, swz = sb ^ (((sb >> 9) & 1) << 5); R = (st >> 1) * 16 + swz / 64; C = (st & 1) * 32 + (swz % 64) / 2; }
__host__ __device__ __forceinline__ int perm32(int rho) { const int n = rho >> 4, i = rho & 15; return 8 * (i >> 2) + 4 * n + (i & 3); }

struct Unit { int pm, pn, z; size_t aoff, boff; const int* rl; int rn; };
struct Gemm { const bf16* A; const bf16* Bt; int K, lda, ldb; };

struct StaticOrder {
    int nM, nN, nwg, G, c, nz, lat; size_t astride, bstride;
    __device__ void init(int M_, int N_, int G_, int c_, int nz_ = 1, size_t as_ = 0, size_t bs_ = 0, int lat_ = 0) { nM = M_ / BM; nN = N_ / BM; nwg = nM * nN; G = G_; c = c_; nz = nz_; astride = as_; bstride = bs_; lat = lat_; }
    __device__ bool next(int i, Unit& u) const {
        const long L0 = (long)i * G + c; if (L0 >= (long)nwg * nz) return false;
        const int z = (int)(L0 / nwg); const long L = L0 - (long)z * nwg; u.z = z; u.aoff = z * astride; u.boff = z * bstride; u.rl = nullptr; u.rn = 0;
        int wgid = (int)L; { const int q = nwg / NXCD, r = nwg % NXCD, xcd = wgid % NXCD, off = wgid / NXCD; wgid = (xcd < r ? xcd * (q + 1) : r * (q + 1) + (xcd - r) * q) + off; }
        const int nig = WGM * nN, gid = wgid / nig, fm = gid * WGM, gsz = (nM - fm) < WGM ? (nM - fm) : WGM;
        u.pm = fm + ((wgid % nig) % gsz); u.pn = (wgid % nig) / gsz; if (lat) u.pm = (u.pm >> 3) * 9 + 1 + (u.pm & 7); return true;
    }
};

template <class Epi, class Sched, bool SKIP11 = false, bool F8 = false>
__device__ __forceinline__ void gemm_phase(LAS unsigned char* lds, const int tid, const Gemm g, const Sched& S, const Epi& E) {
    const int wid = __builtin_amdgcn_readfirstlane(tid >> 6), lane = tid & 63, wr = wid >> 2, wc = wid & 3, fr = lane & 15, fq = lane >> 4;
    int K = g.K; asm volatile("" : "+s"(K)); const int nt = K / BK;
    unsigned voffA[2], voffB[2];
#pragma unroll
    for (int i = 0; i < 2; ++i) { int R, C; stage_rc(tid * 16 + i * 8192, R, C); const int Rb = ((R & ~31) + perm32(R & 31));
        voffA[i] = (unsigned)(R * g.lda + C) * 2u; voffB[i] = (unsigned)(Rb * g.ldb + C) * 2u; }
    const size_t kstep = (size_t)(BK * 2);
    const size_t hsA = (size_t)HALF * g.lda * 2, hsB = (size_t)HALF * g.ldb * 2;
    const size_t tsA = 2 * hsA, tsB = 2 * hsB;
    const unsigned ldsw = (unsigned)wid * 1024u;
    const int aoff = lds_byte(wr * 64 + fr, fq * 8), boff = lds_byte(wc * 32 + fr, fq * 8);
#define PG8_SA(b, h) (((b) * 2 + (h)) * HTB)
#define PG8_SB(b, h) ((4 + (b) * 2 + (h)) * HTB)
#define PG8_STAGE(bufoff, gbase, voff) do { const char* gb_ = (const char*)(gbase); asm volatile("" : "+s"(gb_)); _Pragma("unroll") for (int _i = 0; _i < 2; ++_i) { unsigned vo_ = (voff)[_i]; asm volatile("" : "+v"(vo_)); \
        __builtin_amdgcn_global_load_lds((const unsigned*)(gb_ + vo_), (LAS unsigned*)(lds + (bufoff) + ldsw + _i * 8192), 16, 0, 0); } } while (0)
#define PG8_LDA(dst, b, h) do { _Pragma("unroll") for (int m = 0; m < 4; ++m) _Pragma("unroll") for (int k = 0; k < 2; ++k) dst[m][k] = *(const LAS bf16x8*)(lds + PG8_SA(b, h) + aoff + m * 2048 + k * 1024); } while (0)
#define PG8_LDB(dst, b, h) do { _Pragma("unroll") for (int n = 0; n < 2; ++n) _Pragma("unroll") for (int k = 0; k < 2; ++k) dst[n][k] = *(const LAS bf16x8*)(lds + PG8_SB(b, h) + boff + n * 2048 + k * 1024); } while (0)
#define PG8_MMA(ai, bj, At, Bt) do { __builtin_amdgcn_s_setprio(1); _Pragma("unroll") for (int m = 0; m < 4; ++m) _Pragma("unroll") for (int n = 0; n < ((SKIP11 && (bj) == 1) ? 1 : 2); ++n) { \
        if constexpr (F8) acc[ai][bj][m][n] = __builtin_amdgcn_mfma_scale_f32_16x16x128_f8f6f4(cat8(Bt[n][0], Bt[n][1]), cat8(At[m][0], At[m][1]), acc[ai][bj][m][n], 0, 0, 0, 0x7f7f7f7f, 0, 0x7f7f7f7f); \
        else { _Pragma("unroll") for (int k = 0; k < 2; ++k) acc[ai][bj][m][n] = __builtin_amdgcn_mfma_f32_16x16x32_bf16(Bt[n][k], At[m][k], acc[ai][bj][m][n], 0, 0, 0); } } __builtin_amdgcn_s_setprio(0); } while (0)
#define PG8_WAIT_V(n) asm volatile("s_waitcnt vmcnt(" #n ")" ::: "memory")
#define PG8_WAIT_L(n) asm volatile("s_waitcnt lgkmcnt(" #n ")" ::: "memory")
#define PG8_BAR __builtin_amdgcn_s_barrier()
#define PG8_SCHED __builtin_amdgcn_sched_barrier(0)
    Unit cur, nxt; int ui = 0;
    if (!S.next(0, cur)) return;
    f32x4 acc[2][2][4][2];
#pragma unroll
    for (int a = 0; a < 2; ++a)
#pragma unroll
        for (int b = 0; b < 2; ++b)
#pragma unroll
            for (int m = 0; m < 4; ++m)
#pragma unroll
                for (int n = 0; n < 2; ++n) acc[a][b][m][n] = (f32x4){0.f, 0.f, 0.f, 0.f};
    bf16x8 At[4][2], B0[2][2], B1[2][2];
    const char* cA = (const char*)g.A + cur.aoff + (size_t)cur.pm * tsA; const char* cB = (const char*)g.Bt + cur.boff + (size_t)cur.pn * tsB;
    PG8_STAGE(PG8_SB(0, 0), cB, voffB); PG8_STAGE(PG8_SB(0, 1), cB + hsB, voffB); PG8_STAGE(PG8_SA(0, 0), cA, voffA); PG8_STAGE(PG8_SA(0, 1), cA + hsA, voffA);
    if (wr == 1) PG8_BAR;
    PG8_WAIT_V(2); PG8_BAR;
    PG8_STAGE(PG8_SB(1, 0), cB + kstep, voffB); PG8_STAGE(PG8_SA(1, 0), cA + kstep, voffA); PG8_STAGE(PG8_SB(1, 1), cB + hsB + kstep, voffB);
    PG8_WAIT_V(6); PG8_BAR;
    for (;;) {
        const bool has_next = S.next(ui + 1, nxt);
        const char* nA = has_next ? (const char*)g.A + nxt.aoff + (size_t)nxt.pm * tsA : cA; const char* nB = has_next ? (const char*)g.Bt + nxt.boff + (size_t)nxt.pn * tsB : cB;
        for (int t = 0; t < nt; t += 2) {
            const bool last = (t == nt - 2);
            const char* a1 = cA + (size_t)(t + 1) * kstep;
            const char* a2 = last ? nA : cA + (size_t)(t + 2) * kstep; const char* b2 = last ? nB : cB + (size_t)(t + 2) * kstep;
            const char* a3 = a2 + kstep; const char* b3 = b2 + kstep;
            PG8_LDB(B0, 0, 0); PG8_LDB(B1, 0, 1); PG8_SCHED; PG8_LDA(At, 0, 0); PG8_STAGE(PG8_SA(1, 1), a1 + hsA, voffA);
            PG8_WAIT_V(8); PG8_WAIT_L(0); PG8_BAR; PG8_MMA(0, 0, At, B0); PG8_MMA(0, 1, At, B1); PG8_BAR; PG8_SCHED;
            PG8_LDA(At, 0, 1); PG8_STAGE(PG8_SB(0, 0), b2, voffB); PG8_STAGE(PG8_SB(0, 1), b2 + hsB, voffB); PG8_STAGE(PG8_SA(0, 0), a2, voffA);
            PG8_WAIT_V(8); PG8_WAIT_L(0); PG8_BAR; PG8_MMA(1, 0, At, B0); PG8_MMA(1, 1, At, B1); PG8_BAR; PG8_SCHED;
            PG8_LDB(B0, 1, 0); PG8_LDB(B1, 1, 1); PG8_SCHED; PG8_LDA(At, 1, 0); PG8_STAGE(PG8_SA(0, 1), a2 + hsA, voffA);
            PG8_WAIT_V(8); PG8_WAIT_L(0); PG8_BAR; PG8_MMA(0, 0, At, B0); PG8_MMA(0, 1, At, B1); PG8_BAR; PG8_SCHED;
            PG8_LDA(At, 1, 1); PG8_STAGE(PG8_SB(1, 0), b3, voffB); PG8_STAGE(PG8_SB(1, 1), b3 + hsB, voffB); PG8_STAGE(PG8_SA(1, 0), a3, voffA);
            PG8_WAIT_V(8); PG8_WAIT_L(0); PG8_BAR; PG8_MMA(1, 0, At, B0); PG8_MMA(1, 1, At, B1); PG8_BAR; PG8_SCHED;
        }
        if (wr == 0) PG8_BAR;
        { const int l2_ = fresh_lane(); E(acc, cur, wr, wc, l2_ & 15, l2_ >> 4); }
        if (!has_next) break;
#pragma unroll
        for (int a = 0; a < 2; ++a)
#pragma unroll
            for (int b = 0; b < 2; ++b)
#pragma unroll
                for (int m = 0; m < 4; ++m)
#pragma unroll
                    for (int n = 0; n < 2; ++n) acc[a][b][m][n] = (f32x4){0.f, 0.f, 0.f, 0.f};
        cur = nxt; cA = nA; cB = nB; ++ui;
        if (wr == 1) PG8_BAR;
    }
    PG8_WAIT_V(0);
    PG8_BAR;
#undef PG8_SA
#undef PG8_SB
#undef PG8_STAGE
#undef PG8_LDA
#undef PG8_LDB
#undef PG8_MMA
#undef PG8_WAIT_V
#undef PG8_WAIT_L
#undef PG8_BAR
#undef PG8_SCHED
}
template <class Epi, class Sched, bool F8 = false>
__device__ __forceinline__ void gemm_phase_gather(LAS unsigned char* lds, const int tid, const Gemm g, const Sched& S, const Epi& E) {
    const int wid = __builtin_amdgcn_readfirstlane(tid >> 6), lane = tid & 63, wr = wid >> 2, wc = wid & 3, fr = lane & 15, fq = lane >> 4;
    int K = g.K; asm volatile("" : "+s"(K)); const int nt = K / BK;
    unsigned voffA[2], voffB[2];
#pragma unroll
    for (int i = 0; i < 2; ++i) { int R, C; stage_rc(tid * 16 + i * 8192, R, C); const int Rb = ((R & ~31) + perm32(R & 31));
        voffA[i] = (unsigned)(R * g.lda + C) * 2u; voffB[i] = (unsigned)(Rb * g.ldb + C) * 2u; }
    const size_t kstep = (size_t)(BK * 2);
    const size_t hsA = (size_t)HALF * g.lda * 2, hsB = (size_t)HALF * g.ldb * 2;
    const size_t tsA = 2 * hsA, tsB = 2 * hsB;
    const unsigned ldsw = (unsigned)wid * 1024u;
    unsigned vC[2][2], vN[2][2];
#define PG8_GOFF(dst, u) do { const int t_ = wid * 64 + fresh_lane(); _Pragma("unroll") for (int i_ = 0; i_ < 2; ++i_) { int gR_, gC_; stage_rc(t_ * 16 + i_ * 8192, gR_, gC_); \
        _Pragma("unroll") for (int h_ = 0; h_ < 2; ++h_) { const int q_ = h_ * HALF + gR_; \
        const int row_ = q_ < (u).rn ? (u).rl[q_] : 0; dst[h_][i_] = (unsigned)row_ * (unsigned)(g.lda * 2) + (unsigned)gC_ * 2u; } } } while (0)
#define PG8_STAGEG(bufoff, koff, v0, v1) do { unsigned v0_ = (v0), v1_ = (v1); asm volatile("" : "+v"(v0_), "+v"(v1_)); const char* b_ = (const char*)g.A + (koff); asm volatile("" : "+s"(b_)); \
        __builtin_amdgcn_global_load_lds((const unsigned*)(b_ + v0_), (LAS unsigned*)(lds + (bufoff) + ldsw), 16, 0, 0); \
        __builtin_amdgcn_global_load_lds((const unsigned*)(b_ + v1_), (LAS unsigned*)(lds + (bufoff) + ldsw + 8192), 16, 0, 0); } while (0)
    const int aoff = lds_byte(wr * 64 + fr, fq * 8), boff = lds_byte(wc * 32 + fr, fq * 8);
#define PG8_SA(b, h) (((b) * 2 + (h)) * HTB)
#define PG8_SB(b, h) ((4 + (b) * 2 + (h)) * HTB)
#define PG8_STAGE(bufoff, gbase, voff) do { const char* gb_ = (const char*)(gbase); asm volatile("" : "+s"(gb_)); _Pragma("unroll") for (int _i = 0; _i < 2; ++_i) { unsigned vo_ = (voff)[_i]; asm volatile("" : "+v"(vo_)); \
        __builtin_amdgcn_global_load_lds((const unsigned*)(gb_ + vo_), (LAS unsigned*)(lds + (bufoff) + ldsw + _i * 8192), 16, 0, 0); } } while (0)
#define PG8_LDA(dst, b, h) do { _Pragma("unroll") for (int m = 0; m < 4; ++m) _Pragma("unroll") for (int k = 0; k < 2; ++k) dst[m][k] = *(const LAS bf16x8*)(lds + PG8_SA(b, h) + aoff + m * 2048 + k * 1024); } while (0)
#define PG8_LDB(dst, b, h) do { _Pragma("unroll") for (int n = 0; n < 2; ++n) _Pragma("unroll") for (int k = 0; k < 2; ++k) dst[n][k] = *(const LAS bf16x8*)(lds + PG8_SB(b, h) + boff + n * 2048 + k * 1024); } while (0)
#define PG8_MMA(ai, bj, At, Bt) do { __builtin_amdgcn_s_setprio(1); _Pragma("unroll") for (int m = 0; m < 4; ++m) _Pragma("unroll") for (int n = 0; n < 2; ++n) { \
        if constexpr (F8) acc[ai][bj][m][n] = __builtin_amdgcn_mfma_scale_f32_16x16x128_f8f6f4(cat8(Bt[n][0], Bt[n][1]), cat8(At[m][0], At[m][1]), acc[ai][bj][m][n], 0, 0, 0, 0x7f7f7f7f, 0, 0x7f7f7f7f); \
        else { _Pragma("unroll") for (int k = 0; k < 2; ++k) acc[ai][bj][m][n] = __builtin_amdgcn_mfma_f32_16x16x32_bf16(Bt[n][k], At[m][k], acc[ai][bj][m][n], 0, 0, 0); } } __builtin_amdgcn_s_setprio(0); } while (0)
#define PG8_WAIT_V(n) asm volatile("s_waitcnt vmcnt(" #n ")" ::: "memory")
#define PG8_WAIT_L(n) asm volatile("s_waitcnt lgkmcnt(" #n ")" ::: "memory")
#define PG8_BAR __builtin_amdgcn_s_barrier()
#define PG8_SCHED __builtin_amdgcn_sched_barrier(0)
    Unit cur, nxt; int ui = 0;
    if (!S.next(0, cur)) return;
    f32x4 acc[2][2][4][2];
#pragma unroll
    for (int a = 0; a < 2; ++a)
#pragma unroll
        for (int b = 0; b < 2; ++b)
#pragma unroll
            for (int m = 0; m < 4; ++m)
#pragma unroll
                for (int n = 0; n < 2; ++n) acc[a][b][m][n] = (f32x4){0.f, 0.f, 0.f, 0.f};
    bf16x8 At[4][2], B0[2][2], B1[2][2];
    const char* cB = (const char*)g.Bt + cur.boff + (size_t)cur.pn * tsB;
    PG8_GOFF(vC, cur);
#pragma unroll
    for (int h_ = 0; h_ < 2; ++h_)
#pragma unroll
        for (int i_ = 0; i_ < 2; ++i_) vN[h_][i_] = vC[h_][i_];
    PG8_STAGE(PG8_SB(0, 0), cB, voffB); PG8_STAGE(PG8_SB(0, 1), cB + hsB, voffB); PG8_STAGEG(PG8_SA(0, 0), 0, vC[0][0], vC[0][1]); PG8_STAGEG(PG8_SA(0, 1), 0, vC[1][0], vC[1][1]);
    if (wr == 1) PG8_BAR;
    PG8_WAIT_V(2); PG8_BAR;
    PG8_STAGE(PG8_SB(1, 0), cB + kstep, voffB); PG8_STAGEG(PG8_SA(1, 0), kstep, vC[0][0], vC[0][1]); PG8_STAGE(PG8_SB(1, 1), cB + hsB + kstep, voffB);
    PG8_WAIT_V(6); PG8_BAR;
    for (;;) {
        const bool has_next = S.next(ui + 1, nxt);
        const char* nB = has_next ? (const char*)g.Bt + nxt.boff + (size_t)nxt.pn * tsB : cB;
        if (has_next) PG8_GOFF(vN, nxt);
        for (int t = 0; t < nt; t += 2) {
            const bool last = (t == nt - 2);
            const size_t k1 = (size_t)(t + 1) * kstep, k2 = last ? 0 : (size_t)(t + 2) * kstep, k3 = k2 + kstep;
            const char* b2 = last ? nB : cB + (size_t)(t + 2) * kstep; const char* b3 = b2 + kstep;
            PG8_LDB(B0, 0, 0); PG8_LDB(B1, 0, 1); PG8_SCHED; PG8_LDA(At, 0, 0); PG8_STAGEG(PG8_SA(1, 1), k1, vC[1][0], vC[1][1]);
            if (last) { _Pragma("unroll") for (int h_ = 0; h_ < 2; ++h_) _Pragma("unroll") for (int i_ = 0; i_ < 2; ++i_) vC[h_][i_] = vN[h_][i_]; }
            PG8_WAIT_V(8); PG8_WAIT_L(0); PG8_BAR; PG8_MMA(0, 0, At, B0); PG8_MMA(0, 1, At, B1); PG8_BAR; PG8_SCHED;
            PG8_LDA(At, 0, 1); PG8_STAGE(PG8_SB(0, 0), b2, voffB); PG8_STAGE(PG8_SB(0, 1), b2 + hsB, voffB); PG8_STAGEG(PG8_SA(0, 0), k2, vC[0][0], vC[0][1]);
            PG8_WAIT_V(8); PG8_WAIT_L(0); PG8_BAR; PG8_MMA(1, 0, At, B0); PG8_MMA(1, 1, At, B1); PG8_BAR; PG8_SCHED;
            PG8_LDB(B0, 1, 0); PG8_LDB(B1, 1, 1); PG8_SCHED; PG8_LDA(At, 1, 0); PG8_STAGEG(PG8_SA(0, 1), k2, vC[1][0], vC[1][1]);
            PG8_WAIT_V(8); PG8_WAIT_L(0); PG8_BAR; PG8_MMA(0, 0, At, B0); PG8_MMA(0, 1, At, B1); PG8_BAR; PG8_SCHED;
            PG8_LDA(At, 1, 1); PG8_STAGE(PG8_SB(1, 0), b3, voffB); PG8_STAGE(PG8_SB(1, 1), b3 + hsB, voffB); PG8_STAGEG(PG8_SA(1, 0), k3, vC[0][0], vC[0][1]);
            PG8_WAIT_V(8); PG8_WAIT_L(0); PG8_BAR; PG8_MMA(1, 0, At, B0); PG8_MMA(1, 1, At, B1); PG8_BAR; PG8_SCHED;
        }
        if (wr == 0) PG8_BAR;
        { const int l2_ = fresh_lane(); E(acc, cur, wr, wc, l2_ & 15, l2_ >> 4); }
        if (!has_next) break;
#pragma unroll
        for (int a = 0; a < 2; ++a)
#pragma unroll
            for (int b = 0; b < 2; ++b)
#pragma unroll
                for (int m = 0; m < 4; ++m)
#pragma unroll
                    for (int n = 0; n < 2; ++n) acc[a][b][m][n] = (f32x4){0.f, 0.f, 0.f, 0.f};
        cur = nxt; cB = nB; ++ui;
        if (wr == 1) PG8_BAR;
    }
    PG8_WAIT_V(0);
    PG8_BAR;
#undef PG8_GOFF
#undef PG8_STAGEG
#undef PG8_SA
#undef PG8_SB
#undef PG8_STAGE
#undef PG8_LDA
#undef PG8_LDB
#undef PG8_MMA
#undef PG8_WAIT_V
#undef PG8_WAIT_L
#undef PG8_BAR
#undef PG8_SCHED
}
}

#define XB_TMO      128
#define XB_XCNT(j)  (256  + 64 * (j))
#define XB_XSUB(j)  (1280 + 64 * (j))
#define XB_XGEN(j)  (2304 + 64 * (j))
#define XB_TOP      3328
#define XB_TOPGEN   3392
#define XCD_BAR_WORDS 3456
#define XB_SPIN_CAP (1u << 22)
__device__ __forceinline__ unsigned xb_ld(unsigned* p)              { return __hip_atomic_load(p, __ATOMIC_RELAXED, __HIP_MEMORY_SCOPE_AGENT); }
__device__ __forceinline__ unsigned xb_add(unsigned* p, unsigned v) { return __hip_atomic_fetch_add(p, v, __ATOMIC_RELAXED, __HIP_MEMORY_SCOPE_AGENT); }
__device__ __forceinline__ unsigned xb_xcc_id() { return (unsigned)__builtin_amdgcn_s_getreg((3 << 11) | 20) & 0xFu; }
#define XB_SPIN(cond, bar) do { unsigned _sp = 0; while (cond) { __builtin_amdgcn_s_sleep(1); \
    if ((++_sp & 255u) == 0u) { if (xb_ld(&(bar)[XB_TMO])) break; if (_sp > XB_SPIN_CAP) { atomicAdd(&(bar)[XB_TMO], 1u); break; } } } } while (0)
struct XcdBarrier { unsigned* bar; unsigned x; volatile LAS unsigned* st; };
__device__ __forceinline__ XcdBarrier xcd_barrier_post(unsigned* bar, volatile LAS unsigned* st) {
    XcdBarrier b; b.bar = bar; b.x = xb_xcc_id(); b.st = st;
    if (threadIdx.x == 0) (void)xb_add(&bar[XB_XCNT(b.x)], 1u);
    return b;
}
__device__ __forceinline__ void xcd_barrier_complete(unsigned* bar, unsigned x, unsigned& nloc, unsigned& nx) {
    const unsigned G = gridDim.x * gridDim.y * gridDim.z;
    unsigned sum, cnt, mine, sp = 0u;
    for (;;) {
        sum = 0u; cnt = 0u; mine = 0u;
#pragma unroll
        for (unsigned j = 0; j < 16; ++j) { const unsigned c = xb_ld(&bar[XB_XCNT(j)]); sum += c; cnt += (c > 0u) ? 1u : 0u; mine = (j == x) ? c : mine; }
        if (sum == G) break;
        __builtin_amdgcn_s_sleep(1);
        if ((++sp & 255u) == 0u) { if (xb_ld(&bar[XB_TMO])) break; if (sp > XB_SPIN_CAP) { atomicAdd(&bar[XB_TMO], 1u); break; } }
    }
    nloc = mine > 0u ? mine : 1u; nx = cnt > 0u ? cnt : 1u;
}
__device__ __forceinline__ void xcd_barrier(const XcdBarrier& b) {
    asm volatile("s_waitcnt vmcnt(0)" ::: "memory");
    __syncthreads();
    if (threadIdx.x == 0) {
        unsigned* bar = b.bar;
        __builtin_amdgcn_s_waitcnt(0);
        unsigned nloc = b.st[0], nx = b.st[1];
        if (nloc == 0u) { xcd_barrier_complete(bar, b.x, nloc, nx); b.st[0] = nloc; b.st[1] = nx; }
        const unsigned old = xb_add(&bar[XB_XSUB(b.x)], 1u);
        const unsigned gen = old / nloc;
        if (old + 1u == (gen + 1u) * nloc) {
            __builtin_amdgcn_fence(__ATOMIC_RELEASE, "agent");
            asm volatile("s_waitcnt vmcnt(0)" ::: "memory");
            const unsigned og = xb_add(&bar[XB_TOP], 1u);
            const unsigned tg = og / nx;
            if (og + 1u == (tg + 1u) * nx) xb_add(&bar[XB_TOPGEN], 1u);
            else XB_SPIN(xb_ld(&bar[XB_TOPGEN]) == tg, bar);
            __builtin_amdgcn_fence(__ATOMIC_ACQUIRE, "agent");
            xb_add(&bar[XB_XGEN(b.x)], 1u);
            asm volatile("s_waitcnt vmcnt(0)" ::: "memory");
        } else {
            XB_SPIN(xb_ld(&bar[XB_XGEN(b.x)]) == gen, bar);
            __builtin_amdgcn_fence(__ATOMIC_ACQUIRE, "agent");
            asm volatile("s_waitcnt vmcnt(0)" ::: "memory");
        }
    }
    __syncthreads();
}

typedef const float* cfp_t;
typedef __attribute__((address_space(4))) const cfp_t* KargIn;
struct Frame {
    LAS unsigned char* lds; unsigned char* lds_generic;
    unsigned char* ws;
    unsigned* ctl;
    int tid, lane, wave, G, bid;
    struct KIn { KargIn p; __device__ __forceinline__ const float* operator[](int i) const { return (const float*)(GAS const float*)p[i]; } } in;
    float* out;
};
__device__ __forceinline__ unsigned long long opaque_ptr(unsigned long long w) {
    unsigned lo = (unsigned)w, hi = (unsigned)(w >> 32); asm volatile("" : "+v"(lo), "+v"(hi));
    lo = __builtin_amdgcn_readfirstlane(lo); hi = __builtin_amdgcn_readfirstlane(hi); return ((unsigned long long)hi << 32) | lo;
}
__device__ __forceinline__ Frame fresh(const Frame& F0) {
    Frame F = F0; int t = F0.tid; asm volatile("" : "+v"(t)); F.tid = t; F.lane = t & 63; F.wave = __builtin_amdgcn_readfirstlane(t >> 6);
    F.ws = (unsigned char*)(GAS unsigned char*)opaque_ptr((unsigned long long)F0.ws); F.ctl = (unsigned*)(F.ws + WS_CTL);
    return F;
}
enum { I_X = 0, I_C, I_CTX, I_CCTX, I_ADAW, I_ADAB, I_N1G, I_N2G, I_WIN, I_CONVW, I_CONVB, I_GATEB, I_LBRAW, I_AG, I_BG, I_CG, I_LAM, I_WBR, I_WGATE, I_BGATE, I_WOUT,
       I_RGW, I_RGB, I_REW, I_REB, I_W1, I_W3, I_W2, I_FING };

__device__ __forceinline__ float* ws_mod(const Frame& F, int l, int mi) { return (float*)(F.ws + WS_MOD) + ((size_t)l * 9 + mi) * 6144; }
__device__ __forceinline__ int row_mi(int r) { const int b = r / RPB, s = r - b * RPB; return s < TC ? 8 : b; }

struct TrItem { const float* src; bf16* dst; int ldw, K, n0, kind, par, f8; };
__device__ __forceinline__ int tr_row(const TrItem& T, int n) {
    if (T.kind == 0) return n + T.par;
    if (T.kind == 1) return 256 * (n >> 6) + 128 * (T.par >> 1) + 32 * ((n >> 4) & 3) + 8 * ((n >> 2) & 3) + 4 * (T.par & 1) + (n & 3);
    return 256 * (n >> 7) + 128 * T.par + (n & 127);
}
__device__ __forceinline__ void tr_load(const TrItem& T, int lane, f32x4 (&v)[8]) {
#pragma unroll
    for (int i = 0; i < 8; ++i) v[i] = __builtin_nontemporal_load((const f32x4*)(T.src + (size_t)(8 * i + (lane >> 3)) * T.ldw + 4 * (lane & 7)));
}
__device__ __forceinline__ void tr_finish(const TrItem& T, int lane, const f32x4 (&v)[8], LAS float* scr) {
#pragma unroll
    for (int i = 0; i < 8; ++i) { LAS float* s = scr + (8 * i + (lane >> 3)) * 33 + 4 * (lane & 7); s[0] = v[i].x; s[1] = v[i].y; s[2] = v[i].z; s[3] = v[i].w; }
    LDS_WAIT(); asm volatile("" ::: "memory");
    const int c = lane & 7;
#pragma unroll
    for (int j = 0; j < 4; ++j) { const int n = (lane >> 3) + 8 * j; const LAS float* s = scr + (8 * c) * 33 + n;
        if (T.f8) {
            u32x2 o; o.x = pk_fp8x4(F8_SW * s[0 * 33], F8_SW * s[1 * 33], F8_SW * s[2 * 33], F8_SW * s[3 * 33]); o.y = pk_fp8x4(F8_SW * s[4 * 33], F8_SW * s[5 * 33], F8_SW * s[6 * 33], F8_SW * s[7 * 33]);
            *(u32x2*)((unsigned char*)T.dst + (size_t)tr_row(T, T.n0 + n) * T.K + 8 * c) = o;
        } else {
        u32x4 o; o.x = cvt_pk_bf16(s[0 * 33], s[1 * 33]); o.y = cvt_pk_bf16(s[2 * 33], s[3 * 33]); o.z = cvt_pk_bf16(s[4 * 33], s[5 * 33]); o.w = cvt_pk_bf16(s[6 * 33], s[7 * 33]);
        *(u32x4*)(T.dst + (size_t)tr_row(T, T.n0 + n) * T.K + 8 * c) = o; } }
    LDS_WAIT(); asm volatile("" ::: "memory");
}
struct RmGate { int br; __device__ int operator()(int o) const { return 256 * (o >> 6) + 128 * (br >> 1) + 32 * ((o >> 4) & 3) + 8 * ((o >> 2) & 3) + 4 * (br & 1) + (o & 3); } };

constexpr int CI_IN1 = 16 * 144, CI_IN2 = 16 * 48, CI_G = 16 * 96, CI_BR1 = 8 * 32, CI_O = 16 * 32, CI_E13 = 16 * 16, CI_E2 = 8 * 32;
constexpr int CI_N = CI_IN1 + CI_IN2 + CI_G + 3 * CI_BR1 + CI_O + NEXP * (2 * CI_E13 + CI_E2);
__device__ __forceinline__ TrItem tr_decode(const Frame& F, int l, int it) {
    bf16* Wb = (bf16*)(F.ws + WS_W); TrItem T; T.f8 = 0; int r = it;
    if (r < CI_IN1) { const int kb = r / 144, n0 = 32 * (r % 144); T.ldw = WIN_N; T.K = 1024; T.src = F.in[I_WIN] + (size_t)l * 1024 * WIN_N + (size_t)64 * kb * WIN_N + n0; T.dst = Wb + W_IN / 2 + 64 * kb; T.n0 = n0; T.kind = 0; T.par = 0; return T; } r -= CI_IN1;
    if (r < CI_IN2) { const int kb = r / 48, n0 = 32 * (r % 48); T.ldw = WIN_N; T.K = 1024; T.src = F.in[I_WIN] + (size_t)l * 1024 * WIN_N + 4624 + (size_t)64 * kb * WIN_N + n0; T.dst = Wb + W_IN / 2 + 64 * kb; T.n0 = n0; T.kind = 0; T.par = 4608; return T; } r -= CI_IN2;
    if (r < CI_G) { const int kb = r / 96, nb = r % 96, br = nb / 32, n0 = 32 * (nb % 32); T.ldw = 3072; T.K = 1024; T.src = F.in[I_WGATE] + (size_t)l * 1024 * 3072 + br * 1024 + (size_t)64 * kb * 3072 + n0; T.dst = Wb + W_GP / 2 + 64 * kb; T.n0 = n0; T.kind = 1; T.par = br;
        if ((F8GT >> l) & 1) { T.f8 = 1; T.dst = (bf16*)((unsigned char*)(Wb + W_GP / 2) + 64 * kb); } return T; } r -= CI_G;
    if (r < 3 * CI_BR1) { const int br = r / CI_BR1, q = r % CI_BR1, kb = q / 32, n0 = 32 * (q % 32); T.ldw = 1024; T.K = 512; T.src = F.in[I_WBR] + (size_t)l * 3 * 512 * 1024 + (size_t)br * 512 * 1024 + (size_t)64 * kb * 1024 + n0; T.dst = Wb + W_BR / 2 + (size_t)br * 1024 * 512 + 64 * kb; T.n0 = n0; T.kind = 0; T.par = 0; return T; } r -= 3 * CI_BR1;
    if (r < CI_O) { const int kb = r / 32, n0 = 32 * (r % 32); T.ldw = 1024; T.K = 1024; T.src = F.in[I_WOUT] + (size_t)l * 1024 * 1024 + (size_t)64 * kb * 1024 + n0; T.dst = Wb + W_OUT / 2 + 64 * kb; T.n0 = n0; T.kind = 0; T.par = 0; return T; } r -= CI_O;
    const int e = r / (2 * CI_E13 + CI_E2); int q = r % (2 * CI_E13 + CI_E2);
    if (q < 2 * CI_E13) { const int which = q / CI_E13; q %= CI_E13; const int kb = q / 16, n0 = 32 * (q % 16); T.ldw = 512; T.K = 1024;
        T.src = F.in[which ? I_W3 : I_W1] + (size_t)l * NEXP * 1024 * 512 + (size_t)e * 1024 * 512 + (size_t)64 * kb * 512 + n0; T.dst = Wb + W_13 / 2 + (size_t)e * 1024 * 1024 + 64 * kb; T.n0 = n0; T.kind = 2; T.par = which;
        if ((F8MOE >> l) & 1) { T.f8 = 1; T.dst = (bf16*)((unsigned char*)(Wb + W_13 / 2) + (size_t)e * 1024 * 1024 + 64 * kb); } return T; }
    q -= 2 * CI_E13; { const int kb = q / 32, n0 = 32 * (q % 32); T.ldw = 1024; T.K = 512; T.src = F.in[I_W2] + (size_t)l * NEXP * 512 * 1024 + (size_t)e * 512 * 1024 + (size_t)64 * kb * 1024 + n0; T.dst = Wb + W_2 / 2 + (size_t)e * 1024 * 512 + 64 * kb; T.n0 = n0; T.kind = 0; T.par = 0;
        if ((F8MOE >> l) & 1) { T.f8 = 1; T.dst = (bf16*)((unsigned char*)(Wb + W_2 / 2) + (size_t)e * 1024 * 512 + 64 * kb); } return T; }
}
__device__ __forceinline__ void phase_convert(Frame& F, int l) {
    LAS float* scr = (LAS float*)(F.lds + F.wave * 8448);
    const int gw = F.bid * NWAVES + F.wave, NGW = F.G * NWAVES;
    bf16* Wb = (bf16*)(F.ws + WS_W);
    int it = gw; TrItem T0, T1; f32x4 v0[8], v1[8];
    T0 = tr_decode(F, l, it < CI_N ? it : 0); T1 = T0;
    if (it < CI_N) tr_load(T0, F.lane, v0);
    if (it + NGW < CI_N) { T1 = tr_decode(F, l, it + NGW); tr_load(T1, F.lane, v1); }
    while (it < CI_N) {
        const int it2 = it + 2 * NGW; TrItem T2 = T0; f32x4 v2[8];
        if (it2 < CI_N) { T2 = tr_decode(F, l, it2); tr_load(T2, F.lane, v2); }
        tr_finish(T0, F.lane, v0, scr);
        T0 = T1; T1 = T2; it += NGW;
#pragma unroll
        for (int i = 0; i < 8; ++i) { v0[i] = v1[i]; v1[i] = v2[i]; }
    }
    {
        bf16* wrt = (bf16*)(F.ws + WS_WRT); const float* rgw = F.in[I_RGW] + (size_t)l * 1024 * 4; const float* rew = F.in[I_REW] + (size_t)l * 1024 * 32;
        for (int i = F.bid * NTHR + F.tid; i < 48 * 1024; i += F.G * NTHR) { const int n = i >> 10, k = i & 1023;
            const float wv = n < 4 ? rgw[k * 4 + n] : n < 36 ? rew[k * 32 + (n - 4)] : 0.f; const bf16 hi = f2bf(wv); wrt[i] = hi; wrt[48 * 1024 + i] = f2bf(wv - bf2f(hi)); }
    }
    for (int i = gw; i < 1024; i += NGW) {
        const int row = RmGate{3}(i);
        if ((F8GT >> l) & 1) { u32x4* p = (u32x4*)((unsigned char*)(Wb + W_GP / 2) + (size_t)row * 1024) + F.lane; p[0] = (u32x4){0, 0, 0, 0}; }
        else { u32x4* p = (u32x4*)(Wb + W_GP / 2 + (size_t)row * 1024) + F.lane; p[0] = (u32x4){0, 0, 0, 0}; p[64] = (u32x4){0, 0, 0, 0}; }
    }
}

__device__ __forceinline__ void phase_init(Frame& F) {
    const int gw = F.bid * NWAVES + F.wave, NGW = F.G * NWAVES;
    float* X = (float*)(F.ws + WS_X);
#ifdef DBG_IDENT
    for (int r = gw; r < M; r += NGW) {
        const int b = r / RPB, s = r - b * RPB;
        const float* src = s < TC ? F.in[I_CTX] + ((size_t)b * TC + s) * D : F.in[I_X] + ((size_t)b * TL + (s - TC)) * D;
        const f32x4* sp = (const f32x4*)src + F.lane; f32x4* dp = (f32x4*)(X + (size_t)r * D) + F.lane;
#pragma unroll
        for (int j = 0; j < 4; ++j) dp[64 * j] = sp[64 * j];
    }
#endif
    (void)X; (void)gw; (void)NGW;
#ifdef DBG_ZERO_R2
    { u32x4* z = (u32x4*)(F.ws + WS_R2); const size_t n16 = (108 * MiB) / 16;
      for (size_t i = (size_t)F.bid * NTHR + F.tid; i < n16; i += (size_t)F.G * NTHR) z[i] = (u32x4){0, 0, 0, 0}; }
#endif
    if (F.bid == F.G - 1) {
        float* rt = (float*)(F.ws + WS_ROPE);
        for (int i = F.tid; i < 64 * 16; i += NTHR) { const int pos = i >> 4, p = i & 15;
            const float inv = powf(10000.f, -(float)p / 16.f); const float ang = (float)pos * inv; rt[2 * i] = cosf(ang); rt[2 * i + 1] = sinf(ang); }
    }
    LAS float* sc = (LAS float*)(F.lds);
    LAS float* red = (LAS float*)(F.lds + 40960);
    if (F.bid < 192) {
        for (int i = F.tid; i < 9 * 1024; i += NTHR) { const int mi = i >> 10, k = i & 1023; const float v = mi < 8 ? F.in[I_C][mi * 1024 + k] : F.in[I_CCTX][k]; sc[i] = siluf_(v); }
        __syncthreads();
        const int it = F.bid, l = it / 96, n0 = (it % 96) * 64;
        const float* aw = F.in[I_ADAW] + (size_t)l * 1024 * 6144 + n0 + F.lane;
        float acc[9];
#pragma unroll
        for (int m = 0; m < 9; ++m) acc[m] = 0.f;
        const int kb = F.wave * 128;
#pragma unroll 8
        for (int k = 0; k < 128; ++k) { const float w = aw[(size_t)(kb + k) * 6144];
#pragma unroll
            for (int m = 0; m < 9; ++m) acc[m] += sc[m * 1024 + kb + k] * w; }
#pragma unroll
        for (int m = 0; m < 9; ++m) red[(F.wave * 9 + m) * 64 + F.lane] = acc[m];
        __syncthreads();
        for (int i = F.tid; i < 9 * 64; i += NTHR) { const int m = i >> 6, n = i & 63; float s = 0.f;
#pragma unroll
            for (int w = 0; w < 8; ++w) s += red[(w * 9 + m) * 64 + n];
            ws_mod(F, l, m)[n0 + n] = s + F.in[I_ADAB][l * 6144 + n0 + n]; }
        __syncthreads();
    }
}

__device__ __forceinline__ void stage_gate_w(Frame& F, int l) {
    LAS float* gw_ = (LAS float*)F.lds;
    const float* win = F.in[I_WIN] + (size_t)l * 1024 * WIN_N + WIN_GATE0;
    for (int i = F.tid; i < 1024 * 4; i += NTHR) { const int k = i >> 2, q = i & 3; *(LAS f32x4*)(gw_ + k * 16 + (k >> 2) * 4 + q * 4) = *(const f32x4*)(win + (size_t)k * WIN_N + q * 4); }
    __syncthreads();
}
__device__ __forceinline__ void norm1_row(Frame& F, int l, int r, const f32x4 (&xv)[4], const f32x4 (&gv)[4], const f32x4 (&shv)[4], const f32x4 (&scvv)[4], float gateb) {
    float ss = 0.f;
#pragma unroll
    for (int j = 0; j < 4; ++j) ss += (xv[j].x * xv[j].x + xv[j].y * xv[j].y) + (xv[j].z * xv[j].z + xv[j].w * xv[j].w);
    const float rstd = rsqrtf(wave_sum(ss) * (1.f / D) + EPS);
    LAS float* gw_ = (LAS float*)F.lds;
    bf16* H = (bf16*)(F.ws + WS_H);
    float ga[16];
#pragma unroll
    for (int q = 0; q < 16; ++q) ga[q] = 0.f;
#pragma unroll
    for (int j = 0; j < 4; ++j) {
        const int c0 = 4 * F.lane + 256 * j;
        const f32x4 g = gv[j], sh = shv[j], scv = scvv[j];
        f32x4 h; h.x = xv[j].x * rstd * g.x * (1.f + scv.x) + sh.x; h.y = xv[j].y * rstd * g.y * (1.f + scv.y) + sh.y;
        h.z = xv[j].z * rstd * g.z * (1.f + scv.z) + sh.z; h.w = xv[j].w * rstd * g.w * (1.f + scv.w) + sh.w;
        u32x2 o; o.x = cvt_pk_bf16(h.x, h.y); o.y = cvt_pk_bf16(h.z, h.w);
        *(u32x2*)(H + (size_t)r * D + c0) = o;
        if ((F8GT >> l) & 1) *(unsigned*)(F.ws + WS_HG8 + (size_t)r * D + c0) = pk_fp8x4(F8_SH * h.x, F8_SH * h.y, F8_SH * h.z, F8_SH * h.w);
#pragma unroll
        for (int e = 0; e < 4; ++e) { const float hv = h[e];
#pragma unroll
            for (int q4 = 0; q4 < 4; ++q4) { const f32x4 w = *(const LAS f32x4*)(gw_ + (c0 + e) * 16 + (c0 >> 2) * 4 + q4 * 4);
                ga[q4 * 4 + 0] += hv * w.x; ga[q4 * 4 + 1] += hv * w.y; ga[q4 * 4 + 2] += hv * w.z; ga[q4 * 4 + 3] += hv * w.w; } }
    }
#pragma unroll
    for (int q = 0; q < 16; ++q) ga[q] = wave_sum(ga[q]);
    float mine = 0.f;
#pragma unroll
    for (int q = 0; q < 16; ++q) mine = (F.lane == q) ? ga[q] : mine;
    if (F.lane < 16) { float v = mine + gateb; if (F.lane >= 8) v = log_sigmoidf_(v); ((float*)(F.ws + WS_GATES))[(size_t)r * 16 + F.lane] = v; }
}
__device__ __forceinline__ void phase_norm1(Frame& F, int l) {
    stage_gate_w(F, l);
    const int gw = F.bid * NWAVES + F.wave, NGW = F.G * NWAVES, lane = F.lane;
    f32x4 gv[4];
#pragma unroll
    for (int j = 0; j < 4; ++j) gv[j] = *(const f32x4*)(F.in[I_N1G] + l * 1024 + 4 * lane + 256 * j);
    const float gateb = F.in[I_GATEB][l * 16 + (lane & 15)];
#define N1_SRC(r_) ((((r_) % RPB) < TC) ? F.in[I_CTX] + ((size_t)((r_) / RPB) * TC + ((r_) % RPB)) * D : F.in[I_X] + ((size_t)((r_) / RPB) * TL + (((r_) % RPB) - TC)) * D)
    f32x4 xn[4];
    { const f32x4* xp = (const f32x4*)N1_SRC(gw) + lane;
#pragma unroll
      for (int j = 0; j < 4; ++j) xn[j] = xp[64 * j]; }
    for (int r = gw; r < M; r += NGW) {
        f32x4 xv[4], shv[4], scvv[4];
#pragma unroll
        for (int j = 0; j < 4; ++j) xv[j] = xn[j];
        const float* mod = ws_mod(F, l, row_mi(r));
#pragma unroll
        for (int j = 0; j < 4; ++j) { shv[j] = *(const f32x4*)(mod + 4 * lane + 256 * j); scvv[j] = *(const f32x4*)(mod + 1024 + 4 * lane + 256 * j); }
        if (r + NGW < M) { const f32x4* xp = (const f32x4*)N1_SRC(r + NGW) + lane;
#pragma unroll
            for (int j = 0; j < 4; ++j) xn[j] = xp[64 * j]; }
        norm1_row(F, l, r, xv, gv, shv, scvv, gateb);
    }
#undef N1_SRC
    __syncthreads();
}

struct EpiPlain {
    bf16* O; int ldc, coff, zoff;
    __device__ __forceinline__ void operator()(const f32x4 (&acc)[2][2][4][2], const pg8::Unit& u, int wr, int wc, int fr, int fq) const {
        const int row0 = u.pm * 256 + wr * 64 + fr, col0 = coff + u.z * zoff + u.pn * 256 + wc * 32 + 8 * fq;
#pragma unroll
        for (int ai = 0; ai < 2; ++ai)
#pragma unroll
            for (int m = 0; m < 4; ++m) { bf16* rowp = O + (size_t)(row0 + ai * 128 + m * 16) * ldc + col0;
#pragma unroll
                for (int bj = 0; bj < 2; ++bj) { const f32x4 v0 = acc[ai][bj][m][0], v1 = acc[ai][bj][m][1];
                    u32x4 w; w.x = cvt_pk_bf16(v0[0], v0[1]); w.y = cvt_pk_bf16(v0[2], v0[3]); w.z = cvt_pk_bf16(v1[0], v1[1]); w.w = cvt_pk_bf16(v1[2], v1[3]);
                    *(u32x4*)(rowp + bj * 128) = w; } }
    }
};
struct EpiScaled {
    bf16* O; int ldc; float sc;
    __device__ __forceinline__ void operator()(const f32x4 (&acc)[2][2][4][2], const pg8::Unit& u, int wr, int wc, int fr, int fq) const {
        const int row0 = u.pm * 256 + wr * 64 + fr, col0 = u.pn * 256 + wc * 32 + 8 * fq;
#pragma unroll
        for (int ai = 0; ai < 2; ++ai)
#pragma unroll
            for (int m = 0; m < 4; ++m) { bf16* rowp = O + (size_t)(row0 + ai * 128 + m * 16) * ldc + col0;
#pragma unroll
                for (int bj = 0; bj < 2; ++bj) { const f32x4 v0 = acc[ai][bj][m][0] * sc, v1 = acc[ai][bj][m][1] * sc;
                    u32x4 w; w.x = cvt_pk_bf16(v0[0], v0[1]); w.y = cvt_pk_bf16(v0[2], v0[3]); w.z = cvt_pk_bf16(v1[0], v1[1]); w.w = cvt_pk_bf16(v1[2], v1[3]);
                    *(u32x4*)(rowp + bj * 128) = w; } }
    }
};
struct EpiInProj {
    bf16* P; const float* rope;
    __device__ __forceinline__ void operator()(const f32x4 (&acc)[2][2][4][2], const pg8::Unit& u, int wr, int wc, int fr, int fq) const {
        const int pn = u.pn;
        const int mode = (pn == 4 || pn == 5) ? 1 : (pn == 16 || pn == 17) ? 2 : (pn >= 18 && pn < 22 && (u.pm % 9) != 0) ? 3 : 0;
        const int row0 = u.pm * 256 + wr * 64 + fr, col0 = pn * 256 + wc * 32 + 8 * fq;
#pragma unroll
        for (int ai = 0; ai < 2; ++ai)
#pragma unroll
            for (int m = 0; m < 4; ++m) { const int row = row0 + ai * 128 + m * 16; bf16* rowp = P + (size_t)row * NP + col0;
                f32x4 cs[4];
                if (mode == 3) { const int s = row % RPB - TC; const int pos = (wc & 1) ? (s & 63) : (s >> 6);
                    const f32x4* tp = (const f32x4*)(rope + (pos * 16 + 8 * (fq & 1)) * 2);
                    cs[0] = tp[0]; cs[1] = tp[1]; cs[2] = tp[2]; cs[3] = tp[3]; }
#pragma unroll
                for (int bj = 0; bj < 2; ++bj) { f32x4 v0 = acc[ai][bj][m][0], v1 = acc[ai][bj][m][1];
                    if (mode == 1) {
#pragma unroll
                        for (int e = 0; e < 4; ++e) { v0[e] = siluf_(v0[e]); v1[e] = siluf_(v1[e]); } }
                    else if (mode == 2) {
#pragma unroll
                        for (int e = 0; e < 4; ++e) { v0[e] = sigmoidf_(v0[e]); v1[e] = sigmoidf_(v1[e]); } }
                    else if (mode == 3) {
                        f32x4 p0, p1;
#pragma unroll
                        for (int e = 0; e < 4; ++e) { auto ra = __builtin_amdgcn_permlane32_swap(__float_as_uint(v0[e]), __float_as_uint(v0[e]), false, false); auto rb = __builtin_amdgcn_permlane32_swap(__float_as_uint(v1[e]), __float_as_uint(v1[e]), false, false);
                            p0[e] = __uint_as_float(fq < 2 ? ra[1] : ra[0]); p1[e] = __uint_as_float(fq < 2 ? rb[1] : rb[0]); }
                        const float sg = (fq < 2) ? -1.f : 1.f;
                        f32x4 r0, r1;
                        r0[0] = v0[0] * cs[0][0] + sg * p0[0] * cs[0][1]; r0[1] = v0[1] * cs[0][2] + sg * p0[1] * cs[0][3];
                        r0[2] = v0[2] * cs[1][0] + sg * p0[2] * cs[1][1]; r0[3] = v0[3] * cs[1][2] + sg * p0[3] * cs[1][3];
                        r1[0] = v1[0] * cs[2][0] + sg * p1[0] * cs[2][1]; r1[1] = v1[1] * cs[2][2] + sg * p1[1] * cs[2][3];
                        r1[2] = v1[2] * cs[3][0] + sg * p1[2] * cs[3][1]; r1[3] = v1[3] * cs[3][2] + sg * p1[3] * cs[3][3];
                        v0 = r0; v1 = r1; }
                    u32x4 w; w.x = cvt_pk_bf16(v0[0], v0[1]); w.y = cvt_pk_bf16(v0[2], v0[3]); w.z = cvt_pk_bf16(v1[0], v1[1]); w.w = cvt_pk_bf16(v1[2], v1[3]);
                    *(u32x4*)(rowp + bj * 128) = w; } }
    }
};
template <bool F8> struct EpiGates {
    const bf16* U; bf16* YB; const float* bgate;
    __device__ __forceinline__ void operator()(const f32x4 (&acc)[2][2][4][2], const pg8::Unit& u, int wr, int wc, int fr, int fq) const {
        const int row0 = u.pm * 256 + wr * 64 + fr, o0 = 64 * u.pn + 16 * wc + 4 * fq;
        const f32x4 b0 = *(const f32x4*)(bgate + o0), b1 = *(const f32x4*)(bgate + 1024 + o0), b2 = *(const f32x4*)(bgate + 2048 + o0);
#pragma unroll
        for (int ai = 0; ai < 2; ++ai)
#pragma unroll
            for (int m = 0; m < 4; ++m) { const int row = row0 + ai * 128 + m * 16; const bf16* up = U + (size_t)row * 3072 + o0;
                const u32x2 u0 = *(const u32x2*)(up), u1 = *(const u32x2*)(up + 1024), u2 = *(const u32x2*)(up + 2048);
                constexpr float gsc = F8 ? 1.f / (F8_SH * F8_SW) : 1.f;
                const f32x4 g0 = acc[ai][0][m][0] * gsc, g1 = acc[ai][0][m][1] * gsc, g2 = acc[ai][1][m][0] * gsc;
                float y[4];
                y[0] = sigmoidf_(g0[0] + b0[0]) * bflo(u0.x) + sigmoidf_(g1[0] + b1[0]) * bflo(u1.x) + sigmoidf_(g2[0] + b2[0]) * bflo(u2.x);
                y[1] = sigmoidf_(g0[1] + b0[1]) * bfhi(u0.x) + sigmoidf_(g1[1] + b1[1]) * bfhi(u1.x) + sigmoidf_(g2[1] + b2[1]) * bfhi(u2.x);
                y[2] = sigmoidf_(g0[2] + b0[2]) * bflo(u0.y) + sigmoidf_(g1[2] + b1[2]) * bflo(u1.y) + sigmoidf_(g2[2] + b2[2]) * bflo(u2.y);
                y[3] = sigmoidf_(g0[3] + b0[3]) * bfhi(u0.y) + sigmoidf_(g1[3] + b1[3]) * bfhi(u1.y) + sigmoidf_(g2[3] + b2[3]) * bfhi(u2.y);
                u32x2 w; w.x = cvt_pk_bf16(y[0], y[1]); w.y = cvt_pk_bf16(y[2], y[3]);
                *(u32x2*)(YB + (size_t)row * 1024 + o0) = w; }
    }
};
struct EpiOut {
    float* X; const float* modl; const float* xin; const float* cin;
    __device__ __forceinline__ void operator()(const f32x4 (&acc)[2][2][4][2], const pg8::Unit& u, int wr, int wc, int fr, int fq) const {
        const int row0 = u.pm * 256 + wr * 64 + fr, col0 = u.pn * 256 + wc * 32 + 8 * fq;
        const int mi = (u.pm % 9) == 0 ? 8 : u.pm / 9;
        const float* gp = modl + (size_t)mi * 6144 + 2048 + col0;
        f32x4 g[2][2];
#pragma unroll
        for (int bj = 0; bj < 2; ++bj) { g[bj][0] = *(const f32x4*)(gp + bj * 128); g[bj][1] = *(const f32x4*)(gp + bj * 128 + 4); }
#pragma unroll
        for (int ai = 0; ai < 2; ++ai)
#pragma unroll
            for (int m = 0; m < 4; ++m) { const int row = row0 + ai * 128 + m * 16; float* rowp = X + (size_t)row * D + col0;
                const float* srcp = rowp;
                if (xin) { const int b = u.pm / 9, sq = row - b * RPB; srcp = (mi == 8 ? cin + ((size_t)b * TC + sq) * D : xin + ((size_t)b * TL + (sq - TC)) * D) + col0; }
#pragma unroll
                for (int bj = 0; bj < 2; ++bj) { f32x4* xp = (f32x4*)(rowp + bj * 128); const f32x4* sp = (const f32x4*)(srcp + bj * 128); f32x4 x0 = sp[0], x1 = sp[1];
                    x0 = x0 + g[bj][0] * acc[ai][bj][m][0]; x1 = x1 + g[bj][1] * acc[ai][bj][m][1]; xp[0] = x0; xp[1] = x1; } }
    }
};
template <bool F8> struct EpiMoe1 {
    bf16* UM;
    __device__ __forceinline__ void operator()(const f32x4 (&acc)[2][2][4][2], const pg8::Unit& u, int wr, int wc, int fr, int fq) const {
        const int row0 = u.pm * 256 + wr * 64 + fr, col0 = u.pn * 128 + wc * 32 + 8 * fq;
#pragma unroll
        for (int ai = 0; ai < 2; ++ai)
#pragma unroll
            for (int m = 0; m < 4; ++m) { const size_t eoff = (size_t)(row0 + ai * 128 + m * 16) * DEXP + col0;
                float y[8];
                if constexpr (F8) { constexpr float inv = 1.f / (F8_SH * F8_SW), osc = F8_SU * inv;
#pragma unroll
                    for (int n = 0; n < 2; ++n)
#pragma unroll
                        for (int e = 0; e < 4; ++e) y[4 * n + e] = siluf_(acc[ai][0][m][n][e] * inv) * (acc[ai][1][m][n][e] * osc);
                    u32x2 w; w.x = pk_fp8x4(y[0], y[1], y[2], y[3]); w.y = pk_fp8x4(y[4], y[5], y[6], y[7]);
                    *(u32x2*)((unsigned char*)UM + eoff) = w;
                } else {
#pragma unroll
                for (int n = 0; n < 2; ++n)
#pragma unroll
                    for (int e = 0; e < 4; ++e) y[4 * n + e] = siluf_(acc[ai][0][m][n][e]) * acc[ai][1][m][n][e];
                u32x4 w; w.x = cvt_pk_bf16(y[0], y[1]); w.y = cvt_pk_bf16(y[2], y[3]); w.z = cvt_pk_bf16(y[4], y[5]); w.w = cvt_pk_bf16(y[6], y[7]);
                *(u32x4*)(UM + eoff) = w; } }
    }
};
struct GroupedOrder {
    const volatile LAS int* tile_e; const volatile LAS int* tpre; const volatile LAS int* ecnt; const int* rowof; int ntiles, G, c; size_t estride;
    __device__ bool next(int i, pg8::Unit& u) const {
        const long L = (long)i * G + c; if (L >= (long)ntiles * 4) return false;
        const int t = (int)(L >> 2), e = tile_e[t], ti = t - tpre[e]; u.pm = t; u.pn = (int)(L & 3); u.z = 0; u.aoff = 0; u.boff = (size_t)e * estride;
        u.rl = rowof + (size_t)e * ECAP + ti * 256; u.rn = ecnt[e] - ti * 256; return true;
    }
};

namespace att {
constexpr int NW = 8, QBLK = 32, KVBLK = 64;
constexpr float SCALE = 0.125f, THR = 8.f;
constexpr int SHM_V = KVBLK * 128 * 2, SHM_K = KVBLK * 64 * 2, SHM_ATTN = 2 * SHM_V + 2 * SHM_K + NW * 64 * 4;
#define KSWZ64(row, colB) ((row) * 128 + ((colB) ^ ((((row) >> 1) & 7) << 4)))
#define SBAR() __builtin_amdgcn_sched_barrier(0)
__device__ __forceinline__ int crow(int r, int hi) { return (r & 3) + 8 * (r >> 2) + 4 * hi; }
__device__ __forceinline__ unsigned cvtpk(float lo, float hi) { unsigned r; asm volatile("v_cvt_pk_bf16_f32 %0, %1, %2" : "=v"(r) : "v"(lo), "v"(hi)); return r; }
__device__ __forceinline__ void partialSM(f32x16& p0, f32x16& p1, float& m_reg, float& mn, float& alpha) {
  constexpr float C = SCALE * 1.4426950408889634f;
  float pmax = p0[0];
#pragma unroll
  for (int r = 1; r < 16; ++r) pmax = fmaxf(pmax, p0[r]);
#pragma unroll
  for (int r = 0; r < 16; ++r) pmax = fmaxf(pmax, p1[r]);
  { auto rr = __builtin_amdgcn_permlane32_swap(__float_as_uint(pmax), __float_as_uint(pmax), false, false);
    pmax = fmaxf(__uint_as_float(rr[0]), __uint_as_float(rr[1])); }
  if (__builtin_expect(__all(pmax - m_reg <= THR / SCALE), 1)) { mn = m_reg; alpha = 1.f; }
  else { mn = fmaxf(m_reg, pmax); alpha = __builtin_amdgcn_exp2f((m_reg - mn) * C); m_reg = mn; }
  float mnC = -mn * C;
#pragma unroll
  for (int r = 0; r < 16; ++r) p0[r] = fmaf(p0[r], C, mnC);
#pragma unroll
  for (int r = 0; r < 16; ++r) p1[r] = fmaf(p1[r], C, mnC);
#pragma unroll
  for (int r = 0; r < 16; ++r) p0[r] = __builtin_amdgcn_exp2f(p0[r]);
}
__device__ __forceinline__ void finishSM(f32x16& p0, f32x16& p1, float alpha, float& l_reg, bf16x8& pa0, bf16x8& pa1, bf16x8& pa2, bf16x8& pa3) {
#pragma unroll
  for (int r = 0; r < 16; ++r) p1[r] = __builtin_amdgcn_exp2f(p1[r]);
  float ps = 0;
#pragma unroll
  for (int r = 0; r < 16; ++r) ps += p0[r];
#pragma unroll
  for (int r = 0; r < 16; ++r) ps += p1[r];
  { auto rr = __builtin_amdgcn_permlane32_swap(__float_as_uint(ps), __float_as_uint(ps), false, false);
    ps = __uint_as_float(rr[0]) + __uint_as_float(rr[1]); }
  l_reg = l_reg * alpha + ps;
#define PK4(P, BASE, OUT) do { unsigned a0 = cvtpk(P[BASE + 0], P[BASE + 1]), a1 = cvtpk(P[BASE + 2], P[BASE + 3]);   \
    unsigned b0 = cvtpk(P[BASE + 4], P[BASE + 5]), b1 = cvtpk(P[BASE + 6], P[BASE + 7]);                              \
    auto r0 = __builtin_amdgcn_permlane32_swap(a0, b0, false, false); auto r1 = __builtin_amdgcn_permlane32_swap(a1, b1, false, false); \
    u32x4 w = {r0[0], r1[0], r0[1], r1[1]}; OUT = *reinterpret_cast<bf16x8*>(&w); } while (0)
  PK4(p0, 0, pa0); PK4(p0, 8, pa1); PK4(p1, 0, pa2); PK4(p1, 8, pa3);
#undef PK4
}
__device__ __forceinline__ void qkt(f32x16& p0, f32x16& p1, const char* Ks, const bf16x8* qr, int r32, int hi) {
  p0 = f32x16{}; p1 = f32x16{};
#pragma unroll
  for (int d0 = 0; d0 < 4; ++d0) { int cb = (d0 * 16 + hi * 8) * 2;
    bf16x8 b0 = *reinterpret_cast<const bf16x8*>(Ks + KSWZ64(r32, cb));
    bf16x8 b1 = *reinterpret_cast<const bf16x8*>(Ks + KSWZ64(32 + r32, cb));
    p0 = __builtin_amdgcn_mfma_f32_32x32x16_bf16(b0, qr[d0], p0, 0, 0, 0);
    p1 = __builtin_amdgcn_mfma_f32_32x32x16_bf16(b1, qr[d0], p1, 0, 0, 0); }
}
__device__ __forceinline__ int v_st(int k, int c) { const int kk = (k & ~0xC) | ((k & 4) << 1) | ((k & 8) >> 1); return ((kk >> 3) * 4 + (c >> 5)) * 512 + ((kk & 7) * 32 + (c & 31)) * 2; }
__device__ __forceinline__ int v_rd_base(int lane) { return ((lane & 3) << 3) | (((lane >> 2) & 3) << 6) | (((lane >> 4) & 1) << 5) | (((lane >> 5) & 1) << 8); }
constexpr int v_rd_off(int d0, int ks, int half) { return d0 * 512 + ks * 4096 + half * 2048; }
template <int OFF> __device__ __forceinline__ s16x4 tr_read(int vb) {
  s16x4 r; asm volatile("ds_read_b64_tr_b16 %0, %1 offset:%2" : "=&v"(r) : "v"(vb), "i"(OFF) : "memory"); return r;
}
template <int D0> __device__ __forceinline__ void pv_one(f32x16& od, int vb, bf16x8 pa0, bf16x8 pa1, bf16x8 pa2, bf16x8 pa3) {
  const s16x4 l0 = tr_read<v_rd_off(D0, 0, 0)>(vb), h0 = tr_read<v_rd_off(D0, 0, 1)>(vb), l1 = tr_read<v_rd_off(D0, 1, 0)>(vb), h1 = tr_read<v_rd_off(D0, 1, 1)>(vb);
  const s16x4 l2 = tr_read<v_rd_off(D0, 2, 0)>(vb), h2 = tr_read<v_rd_off(D0, 2, 1)>(vb), l3 = tr_read<v_rd_off(D0, 3, 0)>(vb), h3 = tr_read<v_rd_off(D0, 3, 1)>(vb);
  asm volatile("s_waitcnt lgkmcnt(0)" ::: "memory"); SBAR();
#define PK(L, H) (bf16x8){L[0], L[1], L[2], L[3], H[0], H[1], H[2], H[3]}
  od = __builtin_amdgcn_mfma_f32_32x32x16_bf16(pa0, PK(l0, h0), od, 0, 0, 0);
  od = __builtin_amdgcn_mfma_f32_32x32x16_bf16(pa1, PK(l1, h1), od, 0, 0, 0);
  od = __builtin_amdgcn_mfma_f32_32x32x16_bf16(pa2, PK(l2, h2), od, 0, 0, 0);
  od = __builtin_amdgcn_mfma_f32_32x32x16_bf16(pa3, PK(l3, h3), od, 0, 0, 0);
#undef PK
}
__device__ __forceinline__ void pv_d0(f32x16* o, int vb, bf16x8 pa0, bf16x8 pa1, bf16x8 pa2, bf16x8 pa3) {
  pv_one<0>(o[0], vb, pa0, pa1, pa2, pa3); pv_one<1>(o[1], vb, pa0, pa1, pa2, pa3); pv_one<2>(o[2], vb, pa0, pa1, pa2, pa3); pv_one<3>(o[3], vb, pa0, pa1, pa2, pa3);
}
__device__ __forceinline__ void attn_unit(const bf16* __restrict__ Qb, const bf16* __restrict__ Kh, const bf16* __restrict__ Vh, bf16* __restrict__ Ob, int seq, char* lds, const int tid) {
  const int wid = tid >> 6, lane = tid & 63, r32 = lane & 31, hi = lane >> 5;
  char* V_lds = lds; char* K_lds = lds + 2 * SHM_V;
  float* ws = (float*)(lds + 2 * SHM_V + 2 * SHM_K) + wid * 64; float* li_l = ws; float* al_l = ws + 32;
  float m_reg = -1e30f, l_reg = 0; f32x16 o[4] = {}; bf16x8 qr[4];
  const bf16* Qw = Qb + (long)(wid * QBLK + r32) * NP + hi * 8;
#pragma unroll
  for (int d0 = 0; d0 < 4; ++d0) qr[d0] = *reinterpret_cast<const bf16x8*>(Qw + d0 * 16);
  const int sr = tid >> 4, sc = (tid & 15) * 8, vst0 = v_st(sr, sc), vst1 = v_st(32 + sr, sc);
  const int ksr = tid >> 3, ksc = (tid & 7) * 8, kst = KSWZ64(ksr, ksc * 2);
  const int vb0 = (int)(uintptr_t)V_lds + v_rd_base(lane);
  struct { bf16x8 vs0, vs1, ks0; } sr_[2];
#define SLOAD(i, k0) do { sr_[i].vs0 = *reinterpret_cast<const bf16x8*>(&Vh[(long)((k0) + sr) * NP + sc]); sr_[i].vs1 = *reinterpret_cast<const bf16x8*>(&Vh[(long)((k0) + 32 + sr) * NP + sc]); \
    sr_[i].ks0 = *reinterpret_cast<const bf16x8*>(&Kh[(long)((k0) + ksr) * NP + ksc]); } while (0)
#define SWRITE(b, i) do { *(bf16x8*)(V_lds + (b) * SHM_V + vst0) = sr_[i].vs0; *(bf16x8*)(V_lds + (b) * SHM_V + vst1) = sr_[i].vs1; \
    *(bf16x8*)(K_lds + (b) * SHM_K + kst) = sr_[i].ks0; } while (0)
#define SWAIT() asm volatile("s_waitcnt vmcnt(3)" ::: "memory")
#define RESC(a) do { if (__any((a) < 1.f)) { if (hi == 0) al_l[r32] = (a); asm volatile("s_waitcnt lgkmcnt(0)" ::: "memory"); \
    _Pragma("unroll") for (int d = 0; d < 4; ++d) _Pragma("unroll") for (int r = 0; r < 16; ++r) o[d][r] *= al_l[crow(r, hi)]; } } while (0)
  f32x16 pA0, pA1, pB0, pB1; float mnA, mnB, alA, alB; bf16x8 pa0, pa1, pa2, pa3; const int NT = seq / KVBLK;
  constexpr int SE = 0, SO = 1;
  SLOAD(SE, 0); asm volatile("s_waitcnt vmcnt(0)" ::: "memory"); SWRITE(0, SE); __syncthreads();
  qkt(pA0, pA1, K_lds, qr, r32, hi); partialSM(pA0, pA1, m_reg, mnA, alA);
  SLOAD(SO, KVBLK); if (2 < NT) SLOAD(SE, 2 * KVBLK);
  SWAIT(); SWRITE(1, SO); __syncthreads();
  for (int j = 1; j + 1 < NT; j += 2) {
    SBAR(); qkt(pB0, pB1, K_lds + SHM_K, qr, r32, hi);
    finishSM(pA0, pA1, alA, l_reg, pa0, pa1, pa2, pa3); SBAR();
    SLOAD(SO, (j + 2) * KVBLK); SBAR();
    pv_d0(o, vb0, pa0, pa1, pa2, pa3); partialSM(pB0, pB1, m_reg, mnB, alB);
    __syncthreads(); SWAIT(); SWRITE(0, SE);
    RESC(alB); __syncthreads();
    SBAR(); qkt(pA0, pA1, K_lds, qr, r32, hi);
    finishSM(pB0, pB1, alB, l_reg, pa0, pa1, pa2, pa3); SBAR();
    if (j + 3 < NT) SLOAD(SE, (j + 3) * KVBLK); SBAR();
    pv_d0(o, vb0 + SHM_V, pa0, pa1, pa2, pa3); partialSM(pA0, pA1, m_reg, mnA, alA);
    __syncthreads(); SWAIT(); SWRITE(1, SO);
    RESC(alA); __syncthreads();
  }
  SBAR(); qkt(pB0, pB1, K_lds + SHM_K, qr, r32, hi);
  finishSM(pA0, pA1, alA, l_reg, pa0, pa1, pa2, pa3); SBAR();
  pv_d0(o, vb0, pa0, pa1, pa2, pa3); partialSM(pB0, pB1, m_reg, mnB, alB);
  __syncthreads(); RESC(alB);
  finishSM(pB0, pB1, alB, l_reg, pa0, pa1, pa2, pa3); SBAR();
  pv_d0(o, vb0 + SHM_V, pa0, pa1, pa2, pa3);
  if (hi == 0) li_l[r32] = l_reg; asm volatile("s_waitcnt lgkmcnt(0)" ::: "memory");
  float rli[16];
#pragma unroll
  for (int r = 0; r < 16; ++r) rli[r] = __builtin_amdgcn_rcpf(li_l[crow(r, hi)]);
  bf16* Ow = Ob + (long)(wid * QBLK) * D;
#pragma unroll
  for (int r = 0; r < 16; ++r) { int orow = crow(r, hi);
#pragma unroll
    for (int d0 = 0; d0 < 4; ++d0) Ow[(long)orow * D + d0 * 32 + r32] = f2bf(o[d0][r] * rli[r]); }
  __syncthreads();
#undef SLOAD
#undef SWRITE
#undef SWAIT
#undef RESC
}
}

__device__ __forceinline__ float ex2(float x) { return __builtin_amdgcn_exp2f(x); }
__device__ __forceinline__ float lg2(float x) { return __builtin_amdgcn_logf(x); }
constexpr float LOG2E = 1.4426950408889634f;
#define MFMA16(a, b, c) __builtin_amdgcn_mfma_f32_16x16x32_bf16((a), (b), (c), 0, 0, 0)
constexpr int CH_RS = 288, CH_GS = 1088;
constexpr int OFF_QT = 0, OFF_KT = 9216, OFF_QS = 18432, OFF_KST = 27648, OFF_VT = 39936, OFF_DEC = 52224, OFF_QSUM = 52736, CH_BUF = 55296;
constexpr int OFF_NV = 2 * CH_BUF;
__device__ __forceinline__ int chain_row(int b, int dir, int p) {
    if (p < TC) return b * RPB + (dir ? TC - 1 - p : p);
    const int q = p - TC; return b * RPB + TC + (dir ? TL - 1 - q : q);
}
__device__ __forceinline__ bf16x8 pack8(const f32x4 a, const f32x4 b) {
    u32x4 w; w.x = cvt_pk_bf16(a[0], a[1]); w.y = cvt_pk_bf16(a[2], a[3]); w.z = cvt_pk_bf16(b[0], b[1]); w.w = cvt_pk_bf16(b[2], b[3]); return __builtin_bit_cast(bf16x8, w);
}
__device__ __forceinline__ bf16x8 ld2x8(const LAS char* p0, const LAS char* p1) {
    const u32x2 a = *(const LAS u32x2*)p0, b = *(const LAS u32x2*)p1; u32x4 w = {a.x, a.y, b.x, b.y}; return __builtin_bit_cast(bf16x8, w);
}

constexpr int RAWA = 24576, A_OP = 2 * RAWA;
constexpr int OFFA_QSUM = 52736;
template <int dir> __device__ __forceinline__ void chain_a(Frame& F, int l, int item) {
    const int b = item >> 3, h = (item >> 1) & 3;
    const bf16* P = (const bf16*)(F.ws + WS_R1);
    bf16* OA = (bf16*)(F.ws + WS_R2 + 36 * MiB) + (size_t)dir * M * 512;
    const int tid = F.tid, lane = F.lane, w = F.wave, i16 = lane & 15, g = lane >> 4;
    const int cp = lane, tg = w;
    const int lt = tid >> 4, lc8 = (tid & 15) * 8;
    LAS char* L0 = (LAS char*)F.lds; LAS char* L = L0 + A_OP;
    float lb0 = 0.f, lb1 = 0.f;
    if (l == 1) { const float* lr = F.in[I_LBRAW] + dir * 512 + h * 128 + 2 * cp;
        lb0 = 1.f / (1.f + __expf(lr[0] - lr[1024])); lb1 = 1.f / (1.f + __expf(lr[1] - lr[1025])); }
    const float om0 = 1.f - lb0, om1 = 1.f - lb1;
    f32x4 S[8];
#pragma unroll
    for (int i = 0; i < 8; ++i) S[i] = (f32x4){0.f, 0.f, 0.f, 0.f};
    u32x4 rz[3], rq[3], rv[3];
#define CA_ROW0(ch) ((ch) < 8 ? b * RPB + (dir ? TC - 32 - (ch) * 32 : (ch) * 32) : b * RPB + TC + (dir ? TL - 32 - ((ch) - 8) * 32 : ((ch) - 8) * 32))
#define CA_LOAD(ch, k) do { const bf16* pr = P + (size_t)(CA_ROW0(ch) + lt) * NP + h * 128 + lc8; \
        rz[k] = *(const u32x4*)(pr + PA_F + dir * 512); rq[k] = *(const u32x4*)(pr + PA_Q); rv[k] = *(const u32x4*)(pr + PA_I); } while (0)
#define CA_WRITE(buf, k) do { LAS char* rw = L0 + (buf) * RAWA + lt * 256 + lc8 * 2; *(LAS u32x4*)rw = rz[k]; *(LAS u32x4*)(rw + 8192) = rq[k]; *(LAS u32x4*)(rw + 16384) = rv[k]; } while (0)
    CA_LOAD(0, 0); CA_WRITE(0, 0); CA_LOAD(1, 1); CA_LOAD(2, 2);
    __syncthreads();
    for (int ch0 = 0; ch0 < 72; ch0 += 3) {
#pragma unroll
    for (int kk = 0; kk < 3; ++kk) { const int ch = ch0 + kk;
        if (ch + 1 < 72) CA_WRITE((ch + 1) & 1, (kk + 1) % 3);
        if (ch + 3 < 72) CA_LOAD(ch + 3, kk);
        const LAS char* R = L0 + (ch & 1) * RAWA;
        float loc0[4], loc1[4], kk0[4], kk1[4], run0 = 0.f, run1 = 0.f;
#pragma unroll
        for (int i = 0; i < 4; ++i) { const int j = 4 * tg + i, m = dir ? 31 - j : j;
            const unsigned zz = *(const LAS unsigned*)(R + m * 256 + cp * 4);
            const float z0 = fmaxf(bflo(zz), -60.f), z1 = fmaxf(bfhi(zz), -60.f);
            const float e0 = ex2(-LOG2E * z0), e1 = ex2(-LOG2E * z1); const float s0 = __builtin_amdgcn_rcpf(1.f + e0), s1 = __builtin_amdgcn_rcpf(1.f + e1);
            run0 += lg2(lb0 + om0 * s0); run1 += lg2(lb1 + om1 * s1); loc0[i] = run0; loc1[i] = run1; kk0[i] = om0 * e0 * s0; kk1[i] = om1 * e1 * s1; }
        *(LAS f32x2*)(L + OFFA_QSUM + (tg * 128 + 2 * cp) * 4) = (f32x2){run0, run1};
        __syncthreads();
        float off0 = 0.f, off1 = 0.f, r0 = 0.f, r1 = 0.f, t0 = 0.f, t1 = 0.f;
#pragma unroll
        for (int q = 0; q < 8; ++q) { const f32x2 v = *(const LAS f32x2*)(L + OFFA_QSUM + (q * 128 + 2 * cp) * 4);
            if (q < tg) { off0 += v.x; off1 += v.y; } if (q < 4) { r0 += v.x; r1 += v.y; } t0 += v.x; t1 += v.y; }
        const float Er0 = ex2(r0), Er1 = ex2(r1), Ee0 = ex2(t0 - r0), Ee1 = ex2(t1 - r1);
        float ks0[4], ks1[4]; unsigned vv[4];
#pragma unroll
        for (int i = 0; i < 4; ++i) { const int j = 4 * tg + i, m = dir ? 31 - j : j;
            const unsigned qq = *(const LAS unsigned*)(R + 8192 + m * 256 + cp * 4); vv[i] = *(const LAS unsigned*)(R + 16384 + m * 256 + cp * 4);
            const float bb0 = off0 + loc0[i], bb1 = off1 + loc1[i];
            const float a0 = ex2(bb0 - r0), a1 = ex2(bb1 - r1), ia0 = ex2(r0 - bb0), ia1 = ex2(r1 - bb1);
            const float qt0 = bflo(qq) * a0, qt1 = bfhi(qq) * a1, kt0 = kk0[i] * ia0, kt1 = kk1[i] * ia1;
            *(LAS unsigned*)(L + OFF_QT + j * CH_RS + cp * 4) = cvt_pk_bf16(qt0, qt1);
            *(LAS unsigned*)(L + OFF_KT + j * CH_RS + cp * 4) = cvt_pk_bf16(kt0, kt1);
            *(LAS unsigned*)(L + OFF_QS + j * CH_RS + cp * 4) = cvt_pk_bf16(qt0 * Er0, qt1 * Er1);
            ks0[i] = kt0 * Ee0; ks1[i] = kt1 * Ee1; }
        *(LAS u32x4*)(L + OFF_KST + tg * CH_GS + cp * 16) = (u32x4){cvt_pk_bf16(ks0[0], ks0[1]), cvt_pk_bf16(ks0[2], ks0[3]), cvt_pk_bf16(ks1[0], ks1[1]), cvt_pk_bf16(ks1[2], ks1[3])};
        *(LAS u32x4*)(L + OFF_VT + tg * CH_GS + cp * 16) = (u32x4){(vv[0] & 0xffffu) | (vv[1] << 16), (vv[2] & 0xffffu) | (vv[3] << 16), (vv[0] >> 16) | (vv[1] & 0xffff0000u), (vv[2] >> 16) | (vv[3] & 0xffff0000u)};
        if (tg == 0) *(LAS f32x2*)(L + OFF_DEC + 2 * cp * 4) = (f32x2){ex2(t0), ex2(t1)};
        __syncthreads();
        f32x4 sc00 = {0.f, 0.f, 0.f, 0.f}, sc01 = sc00, sc11 = sc00;
#pragma unroll
        for (int ks_ = 0; ks_ < 4; ++ks_) { const int co = (32 * ks_ + 8 * g) * 2;
            const bf16x8 a0 = *(const LAS bf16x8*)(L + OFF_KT + i16 * CH_RS + co), a1 = *(const LAS bf16x8*)(L + OFF_KT + (16 + i16) * CH_RS + co);
            const bf16x8 b0 = *(const LAS bf16x8*)(L + OFF_QT + i16 * CH_RS + co), b1 = *(const LAS bf16x8*)(L + OFF_QT + (16 + i16) * CH_RS + co);
            sc00 = MFMA16(a0, b0, sc00); sc01 = MFMA16(a0, b1, sc01); sc11 = MFMA16(a1, b1, sc11); }
#pragma unroll
        for (int r = 0; r < 4; ++r) { const bool keep = (4 * g + r) <= i16; sc00[r] = keep ? sc00[r] : 0.f; sc11[r] = keep ? sc11[r] : 0.f; }
        const bf16x8 pb0 = pack8(sc00, (f32x4){0.f, 0.f, 0.f, 0.f}), pb1 = pack8(sc01, sc11);
        const LAS char* vrow = L + OFF_VT + (16 * w + i16) * 8;
        const bf16x8 av = ld2x8(vrow + g * CH_GS, vrow + (4 + g) * CH_GS);
        f32x4 o0 = MFMA16(av, pb0, ((f32x4){0.f, 0.f, 0.f, 0.f})), o1 = MFMA16(av, pb1, ((f32x4){0.f, 0.f, 0.f, 0.f}));
#pragma unroll
        for (int ks_ = 0; ks_ < 4; ++ks_) { const bf16x8 as = pack8(S[2 * ks_], S[2 * ks_ + 1]);
            const LAS char* q0p = L + OFF_QS + i16 * CH_RS + (32 * ks_ + 4 * g) * 2; const LAS char* q1p = q0p + 16 * CH_RS;
            o0 = MFMA16(as, ld2x8(q0p, q0p + 32), o0); o1 = MFMA16(as, ld2x8(q1p, q1p + 32), o1); }
        { const int row0 = CA_ROW0(ch); const int ra = row0 + (dir ? 31 - i16 : i16), rb = row0 + (dir ? 15 - i16 : 16 + i16);
          u32x2 w0 = {cvt_pk_bf16(o0[0], o0[1]), cvt_pk_bf16(o0[2], o0[3])}, w1 = {cvt_pk_bf16(o1[0], o1[1]), cvt_pk_bf16(o1[2], o1[3])};
          *(u32x2*)(OA + (size_t)ra * 512 + h * 128 + 16 * w + 4 * g) = w0; *(u32x2*)(OA + (size_t)rb * 512 + h * 128 + 16 * w + 4 * g) = w1; }
        const bf16x8 bvt = ld2x8(vrow + 2 * g * CH_GS, vrow + (2 * g + 1) * CH_GS);
#pragma unroll
        for (int cb = 0; cb < 8; ++cb) { const f32x4 d4 = *(const LAS f32x4*)(L + OFF_DEC + (16 * cb + 4 * g) * 4);
            const LAS char* kp = L + OFF_KST + (16 * cb + i16) * 8 + 2 * g * CH_GS; const bf16x8 a = ld2x8(kp, kp + CH_GS);
            S[cb] = MFMA16(a, bvt, S[cb] * d4); }
    } }
    __syncthreads();
#undef CA_LOAD
#undef CA_WRITE
}

#undef CA_ROW0
constexpr int OPA2 = 47616, A2_OP = 2 * RAWA, A2_QT = 0, A2_KT = 9216, A2_QS = 18432, A2_KST = 27648, A2_VT = 36352, A2_DEC = 45056, OFFA2_QSUM = 45568;
template <int dir> __device__ __forceinline__ void chain_a2(Frame& F, int l, int item) {
    const int b = item >> 3, h = (item >> 1) & 3;
    const bf16* P = (const bf16*)(F.ws + WS_R1);
    bf16* OA = (bf16*)(F.ws + WS_R2 + 36 * MiB) + (size_t)dir * M * 512;
    const int tid = F.tid, lane = F.lane, w = F.wave, i16 = lane & 15, g = lane >> 4;
    const bool isP = w < 4;
    const int cp = lane, tg = w & 3;
    const int cw = w & 3;
    LAS char* L0 = (LAS char*)F.lds;
    float lb0 = 0.f, lb1 = 0.f;
    if (l == 1) { const float* lr = F.in[I_LBRAW] + dir * 512 + h * 128 + 2 * cp;
        lb0 = 1.f / (1.f + __expf(lr[0] - lr[1024])); lb1 = 1.f / (1.f + __expf(lr[1] - lr[1025])); }
    const float om0 = 1.f - lb0, om1 = 1.f - lb1;
    f32x4 S[2][8];
#pragma unroll
    for (int v = 0; v < 2; ++v)
#pragma unroll
        for (int i = 0; i < 8; ++i) S[v][i] = (f32x4){0.f, 0.f, 0.f, 0.f};
#define CA_ROW0(ch) ((ch) < 8 ? b * RPB + (dir ? TC - 32 - (ch) * 32 : (ch) * 32) : b * RPB + TC + (dir ? TL - 32 - ((ch) - 8) * 32 : ((ch) - 8) * 32))
    u32x4 rz[2], rq[2], rv[2];
#define CA2_LOAD(ch, idx, k) do { const bf16* pr = P + (size_t)(CA_ROW0(ch) + ((idx) >> 4)) * NP + h * 128 + ((idx) & 15) * 8; \
        rz[k] = *(const u32x4*)(pr + PA_F + dir * 512); rq[k] = *(const u32x4*)(pr + PA_Q); rv[k] = *(const u32x4*)(pr + PA_I); } while (0)
#define CA2_WRITE(buf, idx, k) do { LAS char* rw = L0 + (buf) * RAWA + ((idx) >> 4) * 256 + ((idx) & 15) * 16; *(LAS u32x4*)rw = rz[k]; *(LAS u32x4*)(rw + 8192) = rq[k]; *(LAS u32x4*)(rw + 16384) = rv[k]; } while (0)
    CA2_LOAD(0, tid, 0); CA2_LOAD(1, tid, 1); CA2_WRITE(0, tid, 0); CA2_WRITE(1, tid, 1);
    const int ci = tid & 255;
    if (!isP) { CA2_LOAD(2, ci, 0); CA2_LOAD(2, ci + 256, 1); }
    __syncthreads();
    float loc0[8], loc1[8], kk0[8], kk1[8];
#define PREP1(ch) do { const LAS char* R = L0 + ((ch) & 1) * RAWA; LAS char* L = L0 + A2_OP + ((ch) & 1) * OPA2; float run0 = 0.f, run1 = 0.f; \
        _Pragma("unroll") for (int i = 0; i < 8; ++i) { const int j = 8 * tg + i, m = dir ? 31 - j : j; \
            const unsigned zz = *(const LAS unsigned*)(R + m * 256 + cp * 4); \
            const float z0 = fmaxf(bflo(zz), -60.f), z1 = fmaxf(bfhi(zz), -60.f); \
            const float e0 = ex2(-LOG2E * z0), e1 = ex2(-LOG2E * z1); const float s0 = __builtin_amdgcn_rcpf(1.f + e0), s1 = __builtin_amdgcn_rcpf(1.f + e1); \
            run0 += lg2(lb0 + om0 * s0); run1 += lg2(lb1 + om1 * s1); loc0[i] = run0; loc1[i] = run1; kk0[i] = om0 * e0 * s0; kk1[i] = om1 * e1 * s1; } \
        *(LAS f32x2*)(L + OFFA2_QSUM + (tg * 128 + 2 * cp) * 4) = (f32x2){run0, run1}; } while (0)
#define PREP2(ch) do { const LAS char* R = L0 + ((ch) & 1) * RAWA; LAS char* L = L0 + A2_OP + ((ch) & 1) * OPA2; \
        float off0 = 0.f, off1 = 0.f, r0 = 0.f, r1 = 0.f, t0 = 0.f, t1 = 0.f; \
        _Pragma("unroll") for (int q = 0; q < 4; ++q) { const f32x2 v = *(const LAS f32x2*)(L + OFFA2_QSUM + (q * 128 + 2 * cp) * 4); \
            if (q < tg) { off0 += v.x; off1 += v.y; } if (q < 2) { r0 += v.x; r1 += v.y; } t0 += v.x; t1 += v.y; } \
        const float Er0 = ex2(r0), Er1 = ex2(r1), Ee0 = ex2(t0 - r0), Ee1 = ex2(t1 - r1); \
        float ks0[8], ks1[8]; unsigned vv[8]; \
        _Pragma("unroll") for (int i = 0; i < 8; ++i) { const int j = 8 * tg + i, m = dir ? 31 - j : j; \
            const unsigned qq = *(const LAS unsigned*)(R + 8192 + m * 256 + cp * 4); vv[i] = *(const LAS unsigned*)(R + 16384 + m * 256 + cp * 4); \
            const float bb0 = off0 + loc0[i], bb1 = off1 + loc1[i]; \
            const float a0 = ex2(bb0 - r0), a1 = ex2(bb1 - r1), ia0 = ex2(r0 - bb0), ia1 = ex2(r1 - bb1); \
            const float qt0 = bflo(qq) * a0, qt1 = bfhi(qq) * a1, kt0 = kk0[i] * ia0, kt1 = kk1[i] * ia1; \
            *(LAS unsigned*)(L + A2_QT + j * CH_RS + cp * 4) = cvt_pk_bf16(qt0, qt1); \
            *(LAS unsigned*)(L + A2_KT + j * CH_RS + cp * 4) = cvt_pk_bf16(kt0, kt1); \
            *(LAS unsigned*)(L + A2_QS + j * CH_RS + cp * 4) = cvt_pk_bf16(qt0 * Er0, qt1 * Er1); \
            ks0[i] = kt0 * Ee0; ks1[i] = kt1 * Ee1; } \
        _Pragma("unroll") for (int hh = 0; hh < 2; ++hh) { \
            *(LAS u32x4*)(L + A2_KST + (2 * tg + hh) * CH_GS + cp * 16) = (u32x4){cvt_pk_bf16(ks0[4 * hh], ks0[4 * hh + 1]), cvt_pk_bf16(ks0[4 * hh + 2], ks0[4 * hh + 3]), cvt_pk_bf16(ks1[4 * hh], ks1[4 * hh + 1]), cvt_pk_bf16(ks1[4 * hh + 2], ks1[4 * hh + 3])}; \
            *(LAS u32x4*)(L + A2_VT + (2 * tg + hh) * CH_GS + cp * 16) = (u32x4){(vv[4 * hh] & 0xffffu) | (vv[4 * hh + 1] << 16), (vv[4 * hh + 2] & 0xffffu) | (vv[4 * hh + 3] << 16), (vv[4 * hh] >> 16) | (vv[4 * hh + 1] & 0xffff0000u), (vv[4 * hh + 2] >> 16) | (vv[4 * hh + 3] & 0xffff0000u)}; } \
        if (tg == 0) *(LAS f32x2*)(L + A2_DEC + 2 * cp * 4) = (f32x2){ex2(t0), ex2(t1)}; } while (0)
    if (isP) {
        PREP1(0);
        __syncthreads();
        PREP2(0);
        __syncthreads();
        for (int ch = 0; ch < 72; ++ch) {
            if (ch + 1 < 72) PREP1(ch + 1);
            __syncthreads();
            if (ch + 1 < 72) PREP2(ch + 1);
            __syncthreads();
        }
    } else {
        __builtin_amdgcn_s_setprio(1);
        __syncthreads();
        __syncthreads();
        for (int ch = 0; ch < 72; ++ch) {
            const LAS char* L = L0 + A2_OP + (ch & 1) * OPA2;
            bf16x8 pb0, pb1; f32x4 o[2][2];
            {
                f32x4 sc00 = {0.f, 0.f, 0.f, 0.f}, sc01 = sc00, sc11 = sc00;
#pragma unroll
                for (int ks_ = 0; ks_ < 4; ++ks_) { const int co = (32 * ks_ + 8 * g) * 2;
                    const bf16x8 a0 = *(const LAS bf16x8*)(L + A2_KT + i16 * CH_RS + co), a1 = *(const LAS bf16x8*)(L + A2_KT + (16 + i16) * CH_RS + co);
                    const bf16x8 b0 = *(const LAS bf16x8*)(L + A2_QT + i16 * CH_RS + co), b1 = *(const LAS bf16x8*)(L + A2_QT + (16 + i16) * CH_RS + co);
                    sc00 = MFMA16(a0, b0, sc00); sc01 = MFMA16(a0, b1, sc01); sc11 = MFMA16(a1, b1, sc11); }
#pragma unroll
                for (int r = 0; r < 4; ++r) { const bool keep = (4 * g + r) <= i16; sc00[r] = keep ? sc00[r] : 0.f; sc11[r] = keep ? sc11[r] : 0.f; }
                pb0 = pack8(sc00, (f32x4){0.f, 0.f, 0.f, 0.f}); pb1 = pack8(sc01, sc11);
#pragma unroll
                for (int v = 0; v < 2; ++v) { const LAS char* vrow = L + A2_VT + (32 * cw + 16 * v + i16) * 8;
                    const bf16x8 av = ld2x8(vrow + g * CH_GS, vrow + (4 + g) * CH_GS);
                    o[v][0] = MFMA16(av, pb0, ((f32x4){0.f, 0.f, 0.f, 0.f})); o[v][1] = MFMA16(av, pb1, ((f32x4){0.f, 0.f, 0.f, 0.f})); }
            }
            __syncthreads();
#pragma unroll
            for (int ks_ = 0; ks_ < 4; ++ks_) { const LAS char* q0p = L + A2_QS + i16 * CH_RS + (32 * ks_ + 4 * g) * 2;
                const bf16x8 qs0 = ld2x8(q0p, q0p + 32), qs1 = ld2x8(q0p + 16 * CH_RS, q0p + 16 * CH_RS + 32);
#pragma unroll
                for (int v = 0; v < 2; ++v) { const bf16x8 as = pack8(S[v][2 * ks_], S[v][2 * ks_ + 1]); o[v][0] = MFMA16(as, qs0, o[v][0]); o[v][1] = MFMA16(as, qs1, o[v][1]); } }
            { const int row0 = CA_ROW0(ch); const int ra = row0 + (dir ? 31 - i16 : i16), rb = row0 + (dir ? 15 - i16 : 16 + i16);
#pragma unroll
              for (int v = 0; v < 2; ++v) { const int col = h * 128 + 32 * cw + 16 * v + 4 * g;
                  u32x2 w0 = {cvt_pk_bf16(o[v][0][0], o[v][0][1]), cvt_pk_bf16(o[v][0][2], o[v][0][3])}, w1 = {cvt_pk_bf16(o[v][1][0], o[v][1][1]), cvt_pk_bf16(o[v][1][2], o[v][1][3])};
                  *(u32x2*)(OA + (size_t)ra * 512 + col) = w0; *(u32x2*)(OA + (size_t)rb * 512 + col) = w1; } }
            bf16x8 bvt[2];
#pragma unroll
            for (int v = 0; v < 2; ++v) { const LAS char* vrow = L + A2_VT + (32 * cw + 16 * v + i16) * 8; bvt[v] = ld2x8(vrow + 2 * g * CH_GS, vrow + (2 * g + 1) * CH_GS); }
#pragma unroll
            for (int cb = 0; cb < 8; ++cb) { const f32x4 d4 = *(const LAS f32x4*)(L + A2_DEC + (16 * cb + 4 * g) * 4);
                const LAS char* kp = L + A2_KST + (16 * cb + i16) * 8 + 2 * g * CH_GS; const bf16x8 a = ld2x8(kp, kp + CH_GS);
                S[0][cb] = MFMA16(a, bvt[0], S[0][cb] * d4); S[1][cb] = MFMA16(a, bvt[1], S[1][cb] * d4); }
            if (ch + 2 < 72) { CA2_WRITE(ch & 1, ci, 0); CA2_WRITE(ch & 1, ci + 256, 1); }
            if (ch + 3 < 72) { CA2_LOAD(ch + 3, ci, 0); CA2_LOAD(ch + 3, ci + 256, 1); }
            __syncthreads();
        }
        __builtin_amdgcn_s_setprio(0);
    }
#undef PREP1
#undef PREP2
#undef CA2_LOAD
#undef CA2_WRITE
#undef CA_ROW0
}

constexpr int RAWB = 25856, B_OP = 2 * RAWB, OPB = 43264, OFFB_Q = 0, OFFB_K = 9216, OFFB_KWT = 18432, OFFB_VT = 30720, OFFB_BB = 43008, OFFB_NV = B_OP + 2 * OPB;
template <int dir, int VAR = 0> __device__ __forceinline__ void chain_b(Frame& F, int l, int item) {
    const int b = item >> 3, h = (item >> 1) & 3;
    const bf16* P = (const bf16*)(F.ws + WS_R1);
    const float* GT = (const float*)(F.ws + WS_GATES);
    bf16* OB = (VAR ? (bf16*)F.out : (bf16*)(F.ws + WS_R2 + 72 * MiB)) + (size_t)dir * M * 512;
    const int tid = F.tid, lane = F.lane, w = F.wave, i16 = lane & 15, g = lane >> 4;
    const int cp = lane, tg = w;
    const int lt = tid >> 4, lc8 = (tid & 15) * 8;
    LAS char* L0 = (LAS char*)F.lds;
    float wq[2][4], wk[2][4];
    { const float* cw = F.in[I_CONVW] + l * 3 * 1024; const float* cbp = F.in[I_CONVB] + l * 1024;
#pragma unroll
      for (int e = 0; e < 2; ++e) { const int qc = h * 128 + 2 * cp + e, kc = 512 + qc;
          wq[e][0] = cw[qc]; wq[e][1] = cw[1024 + qc]; wq[e][2] = cw[2048 + qc]; wq[e][3] = cbp[qc];
          wk[e][0] = cw[kc]; wk[e][1] = cw[1024 + kc]; wk[e][2] = cw[2048 + kc]; wk[e][3] = cbp[kc]; } }
    f32x4 S[8];
#pragma unroll
    for (int i = 0; i < 8; ++i) S[i] = (f32x4){0.f, 0.f, 0.f, 0.f};
    if (tid < 128) { ((LAS float*)(L0 + OFFB_NV))[tid] = 0.f; ((LAS bf16*)(L0 + OFFB_NV + 1024))[tid] = 0; }
    u32x4 rxq[3], rxk[3], rv[3]; unsigned rh[3]; float rli[3], rlf[3];
#define CB_SEG(ch, len, rbase, nlo) const int len = (ch) < 8 ? TC : TL, rbase = b * RPB + ((ch) < 8 ? 0 : TC), nlo = dir ? len - 32 - ((ch) < 8 ? (ch) : (ch) - 8) * 32 : ((ch) < 8 ? (ch) : (ch) - 8) * 32
#define CB_LOAD(ch, k) do { CB_SEG(ch, len_, rb_, nlo_); const bf16* pr = P + (size_t)(rb_ + nlo_ + lt) * NP + h * 128 + lc8; \
        rxq[k] = *(const u32x4*)(pr + PB_Q); rxk[k] = *(const u32x4*)(pr + PB_K); rv[k] = *(const u32x4*)(pr + PB_V); \
        const int hs_ = (tid >> 6) & 1, hn_ = hs_ ? nlo_ + 32 : nlo_ - 1; const bool hok_ = (hn_ >= 0) && (hn_ < len_); \
        rh[k] = *(const unsigned*)(P + (size_t)(rb_ + (hok_ ? hn_ : nlo_)) * NP + ((tid >> 7) & 1) * 512 + PB_Q + h * 128 + 2 * (tid & 63)); rh[k] &= 0u - (unsigned)hok_; \
        { const float* gp = GT + (size_t)(rb_ + nlo_ + (tid & 31)) * 16 + dir * 4 + h; rli[k] = gp[0]; rlf[k] = gp[8]; } } while (0)
#define CB_WRITE(buf, k) do { LAS char* rw = L0 + (buf) * RAWB; *(LAS u32x4*)(rw + (lt + 1) * 256 + lc8 * 2) = rxq[k]; *(LAS u32x4*)(rw + 8704 + (lt + 1) * 256 + lc8 * 2) = rxk[k]; \
        *(LAS u32x4*)(rw + 17408 + lt * 256 + lc8 * 2) = rv[k]; \
        if (tid < 256) *(LAS unsigned*)(rw + ((tid >> 7) & 1) * 8704 + (((tid >> 6) & 1) ? 33 : 0) * 256 + (tid & 63) * 4) = rh[k]; \
        if (tid < 32) { ((LAS float*)(rw + 25600))[tid] = rli[k]; ((LAS float*)(rw + 25600))[32 + tid] = rlf[k]; } } while (0)
    CB_LOAD(0, 0); CB_WRITE(0, 0); CB_LOAD(1, 1); CB_LOAD(2, 2);
    __syncthreads();
    for (int ch0 = 0; ch0 < 72; ch0 += 3) {
#pragma unroll
    for (int kk = 0; kk < 3; ++kk) { const int ch = ch0 + kk;
        if (ch + 1 < 72) CB_WRITE((ch + 1) & 1, (kk + 1) % 3);
        if (VAR != 3) { if (ch + 3 < 72) CB_LOAD(ch + 3, kk); }
        const LAS char* R = L0 + (ch & 1) * RAWB; LAS char* L = L0 + B_OP + (ch & 1) * OPB;
#ifdef EXP_DUP_PREP
        _Pragma("unroll 1") for (int rep_ = 0; rep_ < EXP_DUP_PREP; ++rep_) { asm volatile("" ::: "memory");
#endif
        if (VAR != 2) {
        const int jm = dir ? 31 - (lane & 31) : (lane & 31);
        const float li_j = ((const LAS float*)(R + 25600))[jm] * LOG2E; float bval = ((const LAS float*)(R + 25600))[32 + jm] * LOG2E;
        bval += dpp_mov<0x111>(bval); bval += dpp_mov<0x112>(bval); bval += dpp_mov<0x114>(bval); bval += dpp_mov<0x118>(bval);
        { const float tot0 = __int_as_float(__builtin_amdgcn_readlane(__float_as_int(bval), 15)); if (lane & 16) bval += tot0; }
        const float eb_j = ex2(bval), el_j = ex2(li_j - bval);
        const float e_end = __int_as_float(__builtin_amdgcn_readlane(__float_as_int(eb_j), 31));
        if (w == 0 && lane < 32) { ((LAS float*)(L + OFFB_BB))[lane] = eb_j; ((LAS float*)(L + OFFB_BB))[32 + lane] = el_j; }
        const int mlo = dir ? 28 - 4 * tg : 4 * tg;
        unsigned xq[6], xk[6], vv[4];
#pragma unroll
        for (int k = 0; k < 6; ++k) { xq[k] = *(const LAS unsigned*)(R + (mlo + k) * 256 + cp * 4); xk[k] = *(const LAS unsigned*)(R + 8704 + (mlo + k) * 256 + cp * 4); }
#pragma unroll
        for (int k = 0; k < 4; ++k) vv[k] = *(const LAS unsigned*)(R + 17408 + (mlo + k) * 256 + cp * 4);
        float kw0[4], kw1[4]; unsigned vc[4];
#pragma unroll
        for (int i = 0; i < 4; ++i) { const int k = dir ? 3 - i : i, j = 4 * tg + i;
            float q0 = wq[0][3] + wq[0][0] * bflo(xq[k]) + wq[0][1] * bflo(xq[k + 1]) + wq[0][2] * bflo(xq[k + 2]);
            float q1 = wq[1][3] + wq[1][0] * bfhi(xq[k]) + wq[1][1] * bfhi(xq[k + 1]) + wq[1][2] * bfhi(xq[k + 2]);
            float k0 = wk[0][3] + wk[0][0] * bflo(xk[k]) + wk[0][1] * bflo(xk[k + 1]) + wk[0][2] * bflo(xk[k + 2]);
            float k1 = wk[1][3] + wk[1][0] * bfhi(xk[k]) + wk[1][1] * bfhi(xk[k + 1]) + wk[1][2] * bfhi(xk[k + 2]);
            q0 = q0 * __builtin_amdgcn_rcpf(1.f + ex2(-LOG2E * q0)) * 0.088388347648318440f; q1 = q1 * __builtin_amdgcn_rcpf(1.f + ex2(-LOG2E * q1)) * 0.088388347648318440f;
            k0 = k0 * __builtin_amdgcn_rcpf(1.f + ex2(-LOG2E * k0)); k1 = k1 * __builtin_amdgcn_rcpf(1.f + ex2(-LOG2E * k1));
            const float wgt = e_end * __int_as_float(__builtin_amdgcn_readlane(__float_as_int(el_j), j));
            *(LAS unsigned*)(L + OFFB_Q + j * CH_RS + cp * 4) = cvt_pk_bf16(q0, q1); *(LAS unsigned*)(L + OFFB_K + j * CH_RS + cp * 4) = cvt_pk_bf16(k0, k1);
            kw0[i] = k0 * wgt; kw1[i] = k1 * wgt; vc[i] = vv[k]; }
        *(LAS u32x4*)(L + OFFB_KWT + tg * CH_GS + cp * 16) = (u32x4){cvt_pk_bf16(kw0[0], kw0[1]), cvt_pk_bf16(kw0[2], kw0[3]), cvt_pk_bf16(kw1[0], kw1[1]), cvt_pk_bf16(kw1[2], kw1[3])};
        *(LAS u32x4*)(L + OFFB_VT + tg * CH_GS + cp * 16) = (u32x4){(vc[0] & 0xffffu) | (vc[1] << 16), (vc[2] & 0xffffu) | (vc[3] << 16), (vc[0] >> 16) | (vc[1] & 0xffff0000u), (vc[2] >> 16) | (vc[3] & 0xffff0000u)};
        }
#ifdef EXP_DUP_PREP
        }
#endif
        __syncthreads();
        if (VAR != 1) {
        const LAS float* BB = (const LAS float*)(L + OFFB_BB); const LAS float* LI = BB + 32;
        const LAS float* NVc = (const LAS float*)(L0 + OFFB_NV) + (ch & 1) * 128; LAS float* NVn = (LAS float*)(L0 + OFFB_NV) + ((ch + 1) & 1) * 128;
        const LAS char* NVb = L0 + OFFB_NV + 1024 + (ch & 1) * 256;
        f32x4 sc00 = {0.f, 0.f, 0.f, 0.f}, sc01 = sc00, sc11 = sc00, qa0 = sc00, qa1 = sc00;
#pragma unroll
        for (int ks_ = 0; ks_ < 4; ++ks_) { const int co = (32 * ks_ + 8 * g) * 2;
            const bf16x8 a0 = *(const LAS bf16x8*)(L + OFFB_K + i16 * CH_RS + co), a1 = *(const LAS bf16x8*)(L + OFFB_K + (16 + i16) * CH_RS + co);
            const bf16x8 b0 = *(const LAS bf16x8*)(L + OFFB_Q + i16 * CH_RS + co), b1 = *(const LAS bf16x8*)(L + OFFB_Q + (16 + i16) * CH_RS + co);
            const bf16x8 nf = *(const LAS bf16x8*)(NVb + co);
            sc00 = MFMA16(a0, b0, sc00); sc01 = MFMA16(a0, b1, sc01); sc11 = MFMA16(a1, b1, sc11); qa0 = MFMA16(nf, b0, qa0); qa1 = MFMA16(nf, b1, qa1); }
        const float bt0 = BB[i16], bt1 = BB[16 + i16], dec = BB[31];
        const f32x4 ls0 = *(const LAS f32x4*)(LI + 4 * g), ls1 = *(const LAS f32x4*)(LI + 16 + 4 * g);
#pragma unroll
        for (int r = 0; r < 4; ++r) { const bool keep = (4 * g + r) <= i16;
            sc00[r] = keep ? sc00[r] * (bt0 * ls0[r]) : 0.f;
            sc01[r] = sc01[r] * (bt1 * ls0[r]);
            sc11[r] = keep ? sc11[r] * (bt1 * ls1[r]) : 0.f; }
        const bf16x8 pb0 = pack8(sc00, (f32x4){0.f, 0.f, 0.f, 0.f}), pb1 = pack8(sc01, sc11);
        const bf16x8 ones = {0x3F80, 0x3F80, 0x3F80, 0x3F80, 0x3F80, 0x3F80, 0x3F80, 0x3F80};
        const f32x4 zz4 = {0.f, 0.f, 0.f, 0.f};
        const float dsum0 = MFMA16(ones, pb0, zz4)[0], dsum1 = MFMA16(ones, pb1, zz4)[0], qn0 = qa0[0], qn1 = qa1[0];
        const LAS char* vrow = L + OFFB_VT + (16 * w + i16) * 8;
        const bf16x8 av = ld2x8(vrow + g * CH_GS, vrow + (4 + g) * CH_GS);
        const f32x4 z4 = {0.f, 0.f, 0.f, 0.f};
        f32x4 o0 = MFMA16(av, pb0, z4), o1 = MFMA16(av, pb1, z4), i0 = z4, i1 = z4;
#pragma unroll
        for (int ks_ = 0; ks_ < 4; ++ks_) { const bf16x8 as = pack8(S[2 * ks_], S[2 * ks_ + 1]);
            const LAS char* q0p = L + OFFB_Q + i16 * CH_RS + (32 * ks_ + 4 * g) * 2; const LAS char* q1p = q0p + 16 * CH_RS;
            i0 = MFMA16(as, ld2x8(q0p, q0p + 32), i0); i1 = MFMA16(as, ld2x8(q1p, q1p + 32), i1); }
        { const float e0 = bt0, e1 = bt1;
          const float den0 = dsum0 + e0 * qn0, den1 = dsum1 + e1 * qn1;
          const float s0 = __builtin_amdgcn_rcpf(fmaxf(fabsf(den0), 1.f)), s1 = __builtin_amdgcn_rcpf(fmaxf(fabsf(den1), 1.f));
          o0 = (o0 + i0 * e0) * s0; o1 = (o1 + i1 * e1) * s1;
          CB_SEG(ch, len_, rb_, nlo_); (void)len_;
          const int ra = rb_ + nlo_ + (dir ? 31 - i16 : i16), rbw = rb_ + nlo_ + (dir ? 15 - i16 : 16 + i16);
          u32x2 w0 = {cvt_pk_bf16(o0[0], o0[1]), cvt_pk_bf16(o0[2], o0[3])}, w1 = {cvt_pk_bf16(o1[0], o1[1]), cvt_pk_bf16(o1[2], o1[3])};
          *(u32x2*)(OB + (size_t)ra * 512 + h * 128 + 16 * w + 4 * g) = w0; *(u32x2*)(OB + (size_t)rbw * 512 + h * 128 + 16 * w + 4 * g) = w1; }
        const bf16x8 bvt = ld2x8(vrow + 2 * g * CH_GS, vrow + (2 * g + 1) * CH_GS);
#pragma unroll
        for (int cb = 0; cb < 8; ++cb) { const LAS char* kp = L + OFFB_KWT + (16 * cb + i16) * 8 + 2 * g * CH_GS; const bf16x8 a = ld2x8(kp, kp + CH_GS);
            S[cb] = MFMA16(a, bvt, S[cb] * dec); }
        { const LAS char* kp = L + OFFB_KWT + (16 * w + i16) * 8 + 2 * g * CH_GS; const f32x4 ns = MFMA16(ld2x8(kp, kp + CH_GS), ones, zz4);
          if (i16 == 0) { const int c4 = 16 * w + 4 * g; const f32x4 nn = ns + *(const LAS f32x4*)(NVc + c4) * dec; *(LAS f32x4*)(NVn + c4) = nn;
              *(LAS u32x2*)(L0 + OFFB_NV + 1024 + ((ch + 1) & 1) * 256 + c4 * 2) = (u32x2){cvt_pk_bf16(nn[0], nn[1]), cvt_pk_bf16(nn[2], nn[3])}; } }
        }
    } }
    __syncthreads();
#undef CB_LOAD
#undef CB_WRITE
#undef CB_SEG
}

template <int dir> __device__ __forceinline__ void chain_b2(Frame& F, int l, int item) {
    const int b = item >> 3, h = (item >> 1) & 3;
    const bf16* P = (const bf16*)(F.ws + WS_R1);
    const float* GT = (const float*)(F.ws + WS_GATES);
    bf16* OB = (bf16*)(F.ws + WS_R2 + 72 * MiB) + (size_t)dir * M * 512;
    const int tid = F.tid, lane = F.lane, w = F.wave, i16 = lane & 15, g = lane >> 4;
    const bool isP = w < 4;
    const int cp = lane, tg = w & 3, cw = w & 3;
    LAS char* L0 = (LAS char*)F.lds;
    if (tid < 128) { ((LAS float*)(L0 + OFFB_NV))[tid] = 0.f; ((LAS bf16*)(L0 + OFFB_NV + 1024))[tid] = 0; }
    u32x4 rxq[2], rxk[2], rv[2]; unsigned rh[2]; float rli[2], rlf[2];
#define CB_SEG(ch, len, rbase, nlo) const int len = (ch) < 8 ? TC : TL, rbase = b * RPB + ((ch) < 8 ? 0 : TC), nlo = dir ? len - 32 - ((ch) < 8 ? (ch) : (ch) - 8) * 32 : ((ch) < 8 ? (ch) : (ch) - 8) * 32
#define CB2_MAIN(ch, idx, k) do { CB_SEG(ch, len_, rb_, nlo_); (void)len_; const bf16* pr = P + (size_t)(rb_ + nlo_ + ((idx) >> 4)) * NP + h * 128 + ((idx) & 15) * 8; \
        rxq[k] = *(const u32x4*)(pr + PB_Q); rxk[k] = *(const u32x4*)(pr + PB_K); rv[k] = *(const u32x4*)(pr + PB_V); } while (0)
#define CB2_MAINW(buf, idx, k) do { LAS char* rw = L0 + (buf) * RAWB; *(LAS u32x4*)(rw + (((idx) >> 4) + 1) * 256 + ((idx) & 15) * 16) = rxq[k]; *(LAS u32x4*)(rw + 8704 + (((idx) >> 4) + 1) * 256 + ((idx) & 15) * 16) = rxk[k]; \
        *(LAS u32x4*)(rw + 17408 + ((idx) >> 4) * 256 + ((idx) & 15) * 16) = rv[k]; } while (0)
#define CB2_HALO(ch, hi, k) do { CB_SEG(ch, len_, rb_, nlo_); const int hn_ = (((hi) >> 6) & 1) ? nlo_ + 32 : nlo_ - 1; const bool hok_ = (hn_ >= 0) && (hn_ < len_); \
        rh[k] = *(const unsigned*)(P + (size_t)(rb_ + (hok_ ? hn_ : nlo_)) * NP + (((hi) >> 7) & 1) * 512 + PB_Q + h * 128 + 2 * ((hi) & 63)); rh[k] &= 0u - (unsigned)hok_; \
        const float* gp = GT + (size_t)(rb_ + nlo_ + ((hi) & 31)) * 16 + dir * 4 + h; rli[k] = gp[0]; rlf[k] = gp[8]; } while (0)
#define CB2_HALOW(buf, hi, k) do { LAS char* rw = L0 + (buf) * RAWB; *(LAS unsigned*)(rw + (((hi) >> 7) & 1) * 8704 + ((((hi) >> 6) & 1) ? 33 : 0) * 256 + ((hi) & 63) * 4) = rh[k]; \
        if ((hi) < 32) { ((LAS float*)(rw + 25600))[hi] = rli[k]; ((LAS float*)(rw + 25600))[32 + (hi)] = rlf[k]; } } while (0)
    CB2_MAIN(0, tid, 0); CB2_MAIN(1, tid, 1);
    if (tid < 256) { CB2_HALO(0, tid, 0); CB2_HALO(1, tid, 1); }
    CB2_MAINW(0, tid, 0); CB2_MAINW(1, tid, 1);
    if (tid < 256) { CB2_HALOW(0, tid, 0); CB2_HALOW(1, tid, 1); }
    const int ci = tid & 255;
    if (!isP) { CB2_MAIN(2, ci, 0); CB2_MAIN(2, ci + 256, 1); CB2_HALO(2, ci, 0); }
    __syncthreads();
    if (isP) {
        float wq[2][4], wk[2][4];
        { const float* cwp = F.in[I_CONVW] + l * 3 * 1024; const float* cbp = F.in[I_CONVB] + l * 1024;
#pragma unroll
          for (int e = 0; e < 2; ++e) { const int qc = h * 128 + 2 * cp + e, kc = 512 + qc;
              wq[e][0] = cwp[qc]; wq[e][1] = cwp[1024 + qc]; wq[e][2] = cwp[2048 + qc]; wq[e][3] = cbp[qc];
              wk[e][0] = cwp[kc]; wk[e][1] = cwp[1024 + kc]; wk[e][2] = cwp[2048 + kc]; wk[e][3] = cbp[kc]; } }
        for (int ch = 0; ch < 73; ++ch) {
            if (ch < 72) {
#ifdef EXP_DUP_PB2
                _Pragma("unroll 1") for (int rep_ = 0; rep_ < EXP_DUP_PB2; ++rep_) { asm volatile("" ::: "memory");
#endif
                const LAS char* R = L0 + (ch & 1) * RAWB; LAS char* L = L0 + B_OP + (ch & 1) * OPB;
                const int jm = dir ? 31 - (lane & 31) : (lane & 31);
                const float li_j = ((const LAS float*)(R + 25600))[jm] * LOG2E; float bval = ((const LAS float*)(R + 25600))[32 + jm] * LOG2E;
                bval += dpp_mov<0x111>(bval); bval += dpp_mov<0x112>(bval); bval += dpp_mov<0x114>(bval); bval += dpp_mov<0x118>(bval);
                { const float tot0 = __int_as_float(__builtin_amdgcn_readlane(__float_as_int(bval), 15)); if (lane & 16) bval += tot0; }
                const float eb_j = ex2(bval), el_j = ex2(li_j - bval);
                const float e_end = __int_as_float(__builtin_amdgcn_readlane(__float_as_int(eb_j), 31));
                if (w == 0 && lane < 32) { ((LAS float*)(L + OFFB_BB))[lane] = eb_j; ((LAS float*)(L + OFFB_BB))[32 + lane] = el_j; }
                const int mlo = dir ? 24 - 8 * tg : 8 * tg;
                unsigned xq[10], xk[10], vv[8];
#pragma unroll
                for (int k = 0; k < 10; ++k) { xq[k] = *(const LAS unsigned*)(R + (mlo + k) * 256 + cp * 4); xk[k] = *(const LAS unsigned*)(R + 8704 + (mlo + k) * 256 + cp * 4); }
#pragma unroll
                for (int k = 0; k < 8; ++k) vv[k] = *(const LAS unsigned*)(R + 17408 + (mlo + k) * 256 + cp * 4);
                float kw0[8], kw1[8]; unsigned vc[8];
#pragma unroll
                for (int i = 0; i < 8; ++i) { const int k = dir ? 7 - i : i, j = 8 * tg + i;
                    float q0 = wq[0][3] + wq[0][0] * bflo(xq[k]) + wq[0][1] * bflo(xq[k + 1]) + wq[0][2] * bflo(xq[k + 2]);
                    float q1 = wq[1][3] + wq[1][0] * bfhi(xq[k]) + wq[1][1] * bfhi(xq[k + 1]) + wq[1][2] * bfhi(xq[k + 2]);
                    float k0 = wk[0][3] + wk[0][0] * bflo(xk[k]) + wk[0][1] * bflo(xk[k + 1]) + wk[0][2] * bflo(xk[k + 2]);
                    float k1 = wk[1][3] + wk[1][0] * bfhi(xk[k]) + wk[1][1] * bfhi(xk[k + 1]) + wk[1][2] * bfhi(xk[k + 2]);
                    q0 = q0 * __builtin_amdgcn_rcpf(1.f + ex2(-LOG2E * q0)) * 0.088388347648318440f; q1 = q1 * __builtin_amdgcn_rcpf(1.f + ex2(-LOG2E * q1)) * 0.088388347648318440f;
                    k0 = k0 * __builtin_amdgcn_rcpf(1.f + ex2(-LOG2E * k0)); k1 = k1 * __builtin_amdgcn_rcpf(1.f + ex2(-LOG2E * k1));
                    const float wgt = e_end * __int_as_float(__builtin_amdgcn_readlane(__float_as_int(el_j), j));
                    *(LAS unsigned*)(L + OFFB_Q + j * CH_RS + cp * 4) = cvt_pk_bf16(q0, q1); *(LAS unsigned*)(L + OFFB_K + j * CH_RS + cp * 4) = cvt_pk_bf16(k0, k1);
                    kw0[i] = k0 * wgt; kw1[i] = k1 * wgt; vc[i] = vv[k]; }
#pragma unroll
                for (int hh = 0; hh < 2; ++hh) {
                    *(LAS u32x4*)(L + OFFB_KWT + (2 * tg + hh) * CH_GS + cp * 16) = (u32x4){cvt_pk_bf16(kw0[4 * hh], kw0[4 * hh + 1]), cvt_pk_bf16(kw0[4 * hh + 2], kw0[4 * hh + 3]), cvt_pk_bf16(kw1[4 * hh], kw1[4 * hh + 1]), cvt_pk_bf16(kw1[4 * hh + 2], kw1[4 * hh + 3])};
                    *(LAS u32x4*)(L + OFFB_VT + (2 * tg + hh) * CH_GS + cp * 16) = (u32x4){(vc[4 * hh] & 0xffffu) | (vc[4 * hh + 1] << 16), (vc[4 * hh + 2] & 0xffffu) | (vc[4 * hh + 3] << 16), (vc[4 * hh] >> 16) | (vc[4 * hh + 1] & 0xffff0000u), (vc[4 * hh + 2] >> 16) | (vc[4 * hh + 3] & 0xffff0000u)}; }
#ifdef EXP_DUP_PB2
                }
#endif
            }
            __syncthreads();
        }
    } else {
        f32x4 S[2][8];
#pragma unroll
        for (int v = 0; v < 2; ++v)
#pragma unroll
            for (int i = 0; i < 8; ++i) S[v][i] = (f32x4){0.f, 0.f, 0.f, 0.f};
        __builtin_amdgcn_s_setprio(1);
        __syncthreads();
        for (int ch = 0; ch < 72; ++ch) {
            const LAS char* L = L0 + B_OP + (ch & 1) * OPB;
            const LAS float* BB = (const LAS float*)(L + OFFB_BB); const LAS float* LI = BB + 32;
            const LAS float* NVc = (const LAS float*)(L0 + OFFB_NV) + (ch & 1) * 128; LAS float* NVn = (LAS float*)(L0 + OFFB_NV) + ((ch + 1) & 1) * 128;
            const LAS char* NVb = L0 + OFFB_NV + 1024 + (ch & 1) * 256;
            const f32x4 z4 = {0.f, 0.f, 0.f, 0.f};
            f32x4 o[2][2], in_[2][2];
#pragma unroll
            for (int v = 0; v < 2; ++v) { in_[v][0] = z4; in_[v][1] = z4; }
#pragma unroll
            for (int ks_ = 0; ks_ < 4; ++ks_) { const LAS char* q0p = L + OFFB_Q + i16 * CH_RS + (32 * ks_ + 4 * g) * 2;
                const bf16x8 qf0 = ld2x8(q0p, q0p + 32), qf1 = ld2x8(q0p + 16 * CH_RS, q0p + 16 * CH_RS + 32);
#pragma unroll
                for (int v = 0; v < 2; ++v) { const bf16x8 as = pack8(S[v][2 * ks_], S[v][2 * ks_ + 1]); in_[v][0] = MFMA16(as, qf0, in_[v][0]); in_[v][1] = MFMA16(as, qf1, in_[v][1]); } }
            f32x4 sc00 = {0.f, 0.f, 0.f, 0.f}, sc01 = sc00, sc11 = sc00, qa0 = sc00, qa1 = sc00;
#pragma unroll
            for (int ks_ = 0; ks_ < 4; ++ks_) { const int co = (32 * ks_ + 8 * g) * 2;
                const bf16x8 a0 = *(const LAS bf16x8*)(L + OFFB_K + i16 * CH_RS + co), a1 = *(const LAS bf16x8*)(L + OFFB_K + (16 + i16) * CH_RS + co);
                const bf16x8 b0 = *(const LAS bf16x8*)(L + OFFB_Q + i16 * CH_RS + co), b1 = *(const LAS bf16x8*)(L + OFFB_Q + (16 + i16) * CH_RS + co);
                const bf16x8 nf = *(const LAS bf16x8*)(NVb + co);
                sc00 = MFMA16(a0, b0, sc00); sc01 = MFMA16(a0, b1, sc01); sc11 = MFMA16(a1, b1, sc11); qa0 = MFMA16(nf, b0, qa0); qa1 = MFMA16(nf, b1, qa1); }
            const float bt0 = BB[i16], bt1 = BB[16 + i16], dec = BB[31];
            const f32x4 ls0 = *(const LAS f32x4*)(LI + 4 * g), ls1 = *(const LAS f32x4*)(LI + 16 + 4 * g);
#pragma unroll
            for (int r = 0; r < 4; ++r) { const bool keep = (4 * g + r) <= i16;
                sc00[r] = keep ? sc00[r] * (bt0 * ls0[r]) : 0.f;
                sc01[r] = sc01[r] * (bt1 * ls0[r]);
                sc11[r] = keep ? sc11[r] * (bt1 * ls1[r]) : 0.f; }
            const bf16x8 pb0 = pack8(sc00, (f32x4){0.f, 0.f, 0.f, 0.f}), pb1 = pack8(sc01, sc11);
            const bf16x8 ones = {0x3F80, 0x3F80, 0x3F80, 0x3F80, 0x3F80, 0x3F80, 0x3F80, 0x3F80};
            const float dsum0 = MFMA16(ones, pb0, z4)[0], dsum1 = MFMA16(ones, pb1, z4)[0], qn0 = qa0[0], qn1 = qa1[0];
            const float den0 = dsum0 + bt0 * qn0, den1 = dsum1 + bt1 * qn1;
            const float s0 = __builtin_amdgcn_rcpf(fmaxf(fabsf(den0), 1.f)), s1 = __builtin_amdgcn_rcpf(fmaxf(fabsf(den1), 1.f));
#pragma unroll
            for (int v = 0; v < 2; ++v) { const LAS char* vrow = L + OFFB_VT + (32 * cw + 16 * v + i16) * 8;
                const bf16x8 av = ld2x8(vrow + g * CH_GS, vrow + (4 + g) * CH_GS);
                o[v][0] = MFMA16(av, pb0, z4); o[v][1] = MFMA16(av, pb1, z4); }
            { CB_SEG(ch, len_, rb_, nlo_); (void)len_;
              const int ra = rb_ + nlo_ + (dir ? 31 - i16 : i16), rbw = rb_ + nlo_ + (dir ? 15 - i16 : 16 + i16);
#pragma unroll
              for (int v = 0; v < 2; ++v) { const int col = h * 128 + 32 * cw + 16 * v + 4 * g;
                  const f32x4 x0 = (o[v][0] + in_[v][0] * bt0) * s0, x1 = (o[v][1] + in_[v][1] * bt1) * s1;
                  u32x2 w0 = {cvt_pk_bf16(x0[0], x0[1]), cvt_pk_bf16(x0[2], x0[3])}, w1 = {cvt_pk_bf16(x1[0], x1[1]), cvt_pk_bf16(x1[2], x1[3])};
                  *(u32x2*)(OB + (size_t)ra * 512 + col) = w0; *(u32x2*)(OB + (size_t)rbw * 512 + col) = w1; } }
            bf16x8 bvt[2];
#pragma unroll
            for (int v = 0; v < 2; ++v) { const LAS char* vrow = L + OFFB_VT + (32 * cw + 16 * v + i16) * 8; bvt[v] = ld2x8(vrow + 2 * g * CH_GS, vrow + (2 * g + 1) * CH_GS); }
#pragma unroll
            for (int cb = 0; cb < 8; ++cb) { const LAS char* kp = L + OFFB_KWT + (16 * cb + i16) * 8 + 2 * g * CH_GS; const bf16x8 a = ld2x8(kp, kp + CH_GS);
                S[0][cb] = MFMA16(a, bvt[0], S[0][cb] * dec); S[1][cb] = MFMA16(a, bvt[1], S[1][cb] * dec); }
#pragma unroll
            for (int q = 0; q < 2; ++q) { const int cbn = 2 * cw + q; const LAS char* kp = L + OFFB_KWT + (16 * cbn + i16) * 8 + 2 * g * CH_GS; const f32x4 ns = MFMA16(ld2x8(kp, kp + CH_GS), ones, z4);
                if (i16 == 0) { const int c4 = 16 * cbn + 4 * g; const f32x4 nn = ns + *(const LAS f32x4*)(NVc + c4) * dec; *(LAS f32x4*)(NVn + c4) = nn;
                    *(LAS u32x2*)(L0 + OFFB_NV + 1024 + ((ch + 1) & 1) * 256 + c4 * 2) = (u32x2){cvt_pk_bf16(nn[0], nn[1]), cvt_pk_bf16(nn[2], nn[3])}; } }
            if (ch + 2 < 72) { CB2_MAINW(ch & 1, ci, 0); CB2_MAINW(ch & 1, ci + 256, 1); CB2_HALOW(ch & 1, ci, 0); }
            if (ch + 3 < 72) { CB2_MAIN(ch + 3, ci, 0); CB2_MAIN(ch + 3, ci + 256, 1); CB2_HALO(ch + 3, ci, 0); }
            __syncthreads();
        }
        __builtin_amdgcn_s_setprio(0);
    }
#undef CB_SEG
#undef CB2_MAIN
#undef CB2_MAINW
#undef CB2_HALO
#undef CB2_HALOW
}

__device__ __forceinline__ void phase_mix(Frame& F, int l) {
    volatile LAS unsigned* MISC = (volatile LAS unsigned*)(F.lds + LDSCTL_OFF);
    for (;;) {
        if (F.tid == 0) MISC[16] = __hip_atomic_fetch_add(F.ctl + CW_QUEUE + 64 * l, 1u, RLX_AGENT);
        __syncthreads();
        const int idx = (int)MISC[16];
        __syncthreads();
#if defined(TSEL) && TSEL >= 30
        if (idx >= 705) break;
        if (idx == 704) { if (l == 0) { Frame Fi = fresh(F); unsigned t0d = 0; if (F.tid == 0) t0d = (unsigned)__builtin_amdgcn_s_memrealtime();
            chain_b<0, TSEL - 30>(Fi, l, 0);
            if (F.tid == 0) MISC[224 + (TSEL % 32)] = (unsigned)__builtin_amdgcn_s_memrealtime() - t0d; } continue; }
#else
        if (idx >= 704) break;
#endif
#if defined(TSEL) && TSEL >= 20 && TSEL < 30
        const bool timed_ = (l == 0) && (idx == (TSEL == 20 ? 0 : TSEL == 21 ? 64 : TSEL == 22 ? 128 : 300));
        unsigned t0_ = 0; if (timed_ && F.tid == 0) t0_ = (unsigned)__builtin_amdgcn_s_memrealtime();
#endif
#ifndef MIXMASK
#define MIXMASK 7
#endif
        if (idx < 64) { if (MIXMASK & 1) { Frame Fi = fresh(F); if (idx & 1) chain_a2<1>(Fi, l, idx); else chain_a2<0>(Fi, l, idx); } }
        else if (idx < 128) { if (MIXMASK & 2) { Frame Fi = fresh(F); if (idx & 1) chain_b2<1>(Fi, l, idx - 64); else chain_b2<0>(Fi, l, idx - 64); } }
        else if (!(MIXMASK & 4)) {}
        else if (idx < 640) { Frame Fi = fresh(F); const bf16* P = (const bf16*)(Fi.ws + WS_R1); bf16* OC = (bf16*)(Fi.ws + WS_R2); const int u = idx - 128, qb = u & 7, cm = (u >> 3) & 1, h = (u >> 4) & 3, b = u >> 6;
            const size_t r0 = (size_t)b * RPB + TC + qb * 256, k0 = (size_t)b * RPB;
            att::attn_unit(P + r0 * NP + PC_Q + h * 128 + cm * 64, P + k0 * NP + PC_K + h * 128 + cm * 64, P + k0 * NP + PC_V + h * 128, OC + r0 * D + (h * 2 + cm) * 128, RPB, (char*)Fi.lds_generic, Fi.tid); }
        else { Frame Fi = fresh(F); const bf16* P = (const bf16*)(Fi.ws + WS_R1); bf16* OC = (bf16*)(Fi.ws + WS_R2); const int u = idx - 640, cm = u & 1, h = (u >> 1) & 3, b = u >> 3; const size_t r0 = (size_t)b * RPB;
            att::attn_unit(P + r0 * NP + PC_Q + h * 128 + cm * 64, P + r0 * NP + PC_K + h * 128 + cm * 64, P + r0 * NP + PC_V + h * 128, OC + r0 * D + (h * 2 + cm) * 128, TC, (char*)Fi.lds_generic, Fi.tid); }
#if defined(TSEL) && TSEL >= 20 && TSEL < 30
        if (timed_ && F.tid == 0) MISC[224 + (TSEL % 32)] = (unsigned)__builtin_amdgcn_s_memrealtime() - t0_;
#endif
    }
}

__device__ __forceinline__ float head_rstd(float ss) {
    return rsqrtf(row_sum(ss) * (1.f / 128.f) + EPS);
}
__device__ __forceinline__ void unpack8(const u32x4 w, float (&v)[8]) { v[0] = bflo(w.x); v[1] = bfhi(w.x); v[2] = bflo(w.y); v[3] = bfhi(w.y); v[4] = bflo(w.z); v[5] = bfhi(w.z); v[6] = bflo(w.w); v[7] = bfhi(w.w); }
__device__ __forceinline__ u32x4 pack8f(const float (&v)[8]) { u32x4 w; w.x = cvt_pk_bf16(v[0], v[1]); w.y = cvt_pk_bf16(v[2], v[3]); w.z = cvt_pk_bf16(v[4], v[5]); w.w = cvt_pk_bf16(v[6], v[7]); return w; }
__device__ __forceinline__ void phase_prep(Frame& F, int l) {
    const int gw = F.bid * NWAVES + F.wave, lane = F.lane, c8 = 8 * lane, head = lane >> 4;
    bf16* P = (bf16*)(F.ws + WS_R1);
    const bf16* OC = (const bf16*)(F.ws + WS_R2); const bf16* OA = (const bf16*)(F.ws + WS_R2 + 36 * MiB); const bf16* OB = (const bf16*)(F.ws + WS_R2 + 72 * MiB);
    const float lam_init = 0.8f - 0.6f * expf(-0.3f * (float)l);
    const float* lv = F.in[I_LAM] + l * 256;
    const float lam = expf(wave_sum(lv[lane] * lv[64 + lane])) - expf(wave_sum(lv[128 + lane] * lv[192 + lane])) + lam_init;
    float ag[8], bg[8], cg[8];
#pragma unroll
    for (int e = 0; e < 8; ++e) { ag[e] = F.in[I_AG][l * 512 + c8 + e]; bg[e] = F.in[I_BG][l * 512 + c8 + e]; cg[e] = F.in[I_CG][l * 512 + c8 + e] * (1.f - lam_init); }
    const int nrows = l == 0 ? 9 : 8;
#define PREP_ROW(j_) (l == 0 ? gw * 9 + (j_) : ((gw * 8 + (j_)) >> 11) * RPB + TC + ((gw * 8 + (j_)) & 2047))
    u32x4 ld[8], ln[8];
#define PREP_LOAD(dst, r_) do { const size_t rr_ = (size_t)(r_); const bf16* pq_ = P + rr_ * NP; \
        dst[0] = *(const u32x4*)(OA + rr_ * 512 + c8); dst[1] = *(const u32x4*)(OA + (size_t)M * 512 + rr_ * 512 + c8); dst[2] = *(const u32x4*)(pq_ + PA_G + c8); \
        dst[3] = *(const u32x4*)(OB + rr_ * 512 + c8); dst[4] = *(const u32x4*)(OB + (size_t)M * 512 + rr_ * 512 + c8); dst[5] = *(const u32x4*)(pq_ + PB_O + c8); \
        dst[6] = *(const u32x4*)(OC + rr_ * D + (head * 2) * 128 + (c8 & 127)); dst[7] = *(const u32x4*)(OC + rr_ * D + (head * 2 + 1) * 128 + (c8 & 127)); } while (0)
    PREP_LOAD(ln, PREP_ROW(0));
    for (int jr = 0; jr < nrows; ++jr) { const int r = PREP_ROW(jr);
#pragma unroll
        for (int q = 0; q < 8; ++q) ld[q] = ln[q];
        if (jr + 1 < nrows) PREP_LOAD(ln, PREP_ROW(jr + 1));
        bf16* pr = P + (size_t)r * NP;
        float a0[8], a1[8], gt[8], y[8];
        unpack8(ld[0], a0); unpack8(ld[1], a1); unpack8(ld[2], gt);
        float ss = 0.f;
#pragma unroll
        for (int e = 0; e < 8; ++e) { a0[e] += a1[e]; ss += a0[e] * a0[e]; }
        float rs = head_rstd(ss);
#pragma unroll
        for (int e = 0; e < 8; ++e) y[e] = a0[e] * rs * ag[e] * gt[e];
        const u32x4 ya = pack8f(y);
        unpack8(ld[3], a0); unpack8(ld[4], a1); unpack8(ld[5], gt);
        ss = 0.f;
#pragma unroll
        for (int e = 0; e < 8; ++e) { a0[e] += a1[e]; ss += a0[e] * a0[e]; }
        rs = head_rstd(ss);
#pragma unroll
        for (int e = 0; e < 8; ++e) y[e] = a0[e] * rs * bg[e] * gt[e];
        const u32x4 yb = pack8f(y);
        unpack8(ld[6], a0); unpack8(ld[7], a1);
        ss = 0.f;
#pragma unroll
        for (int e = 0; e < 8; ++e) { a0[e] -= lam * a1[e]; ss += a0[e] * a0[e]; }
        rs = head_rstd(ss);
#pragma unroll
        for (int e = 0; e < 8; ++e) y[e] = a0[e] * rs * cg[e];
        const u32x4 yc = pack8f(y);
        *(u32x4*)(pr + c8) = ya; *(u32x4*)(pr + 512 + c8) = yb; *(u32x4*)(pr + 1024 + c8) = yc;
    }
#undef PREP_ROW
#undef PREP_LOAD
}

constexpr int N2_WCH = 32768, N2_WROW = 272, N2_WBUF = 2 * 48 * N2_WROW;
__device__ __forceinline__ void phase_norm2(Frame& F, int l) {
    const int gw = F.bid * NWAVES + F.wave, NGW = F.G * NWAVES, lane = F.lane, i16 = lane & 15, g = lane >> 4, tid = F.tid;
    const float* X = (const float*)(F.ws + WS_X); bf16* H = (bf16*)(F.ws + WS_H); bf16* LO = (bf16*)(F.ws + WS_R2);
    const float* ng = F.in[I_N2G] + l * 1024;
    const bf16* wrt = (const bf16*)(F.ws + WS_WRT);
    unsigned* cnt = F.ctl + CW_ECNT + 2048 * l;
    LAS unsigned* lcnt = (LAS unsigned*)(F.lds + 147456); LAS unsigned* gbase = lcnt + 32; LAS unsigned* lrank = lcnt + 64;
    LAS float* LG = (LAS float*)F.lds + F.wave * (16 * 48);
    LAS char* WL = (LAS char*)F.lds + N2_WCH;
    if (tid < 32) lcnt[tid] = 0u;
    u32x4 wreg[3];
#define N2_WLOAD(kc) do { _Pragma("unroll") for (int j = 0; j < 3; ++j) { const int idx = tid + 512 * j, which = idx / 768, rem = idx % 768, row = rem >> 4, seg = rem & 15; \
        wreg[j] = *(const u32x4*)(wrt + (size_t)which * 48 * 1024 + (size_t)row * 1024 + (kc) * 128 + seg * 8); } } while (0)
#define N2_WWRITE(buf) do { _Pragma("unroll") for (int j = 0; j < 3; ++j) { const int idx = tid + 512 * j, which = idx / 768, rem = idx % 768, row = rem >> 4, seg = rem & 15; \
        *(LAS u32x4*)(WL + (buf) * N2_WBUF + (which * 48 + row) * N2_WROW + seg * 16) = wreg[j]; } } while (0)
    N2_WLOAD(0);
    {
        f32x4 gnv[4];
#pragma unroll
        for (int q = 0; q < 4; ++q) gnv[q] = *(const f32x4*)(ng + 4 * lane + 256 * q);
        f32x4 xn[4];
        { const int r0 = gw; if (!(l == 1 && (r0 % RPB) < TC)) { const f32x4* xp = (const f32x4*)(X + (size_t)r0 * D) + lane;
#pragma unroll
            for (int q = 0; q < 4; ++q) xn[q] = xp[64 * q]; } }
        for (int j = 0; j < 9; ++j) { const int r = gw + j * NGW, rn = r + NGW;
            const bool ok = !(l == 1 && (r % RPB) < TC), okn = (j + 1 < 9) && !(l == 1 && (rn % RPB) < TC);
            f32x4 xv[4];
#pragma unroll
            for (int q = 0; q < 4; ++q) xv[q] = xn[q];
            const float* mod = ws_mod(F, l, row_mi(r));
            f32x4 shv[4], scv[4];
            if (ok) {
#pragma unroll
                for (int q = 0; q < 4; ++q) { const int c0 = 4 * lane + 256 * q; shv[q] = *(const f32x4*)(mod + 3072 + c0); scv[q] = *(const f32x4*)(mod + 4096 + c0); } }
            if (okn) { const f32x4* xp = (const f32x4*)(X + (size_t)rn * D) + lane;
#pragma unroll
                for (int q = 0; q < 4; ++q) xn[q] = xp[64 * q]; }
            if (!ok) continue;
            float ss = 0.f;
#pragma unroll
            for (int q = 0; q < 4; ++q) ss += (xv[q].x * xv[q].x + xv[q].y * xv[q].y) + (xv[q].z * xv[q].z + xv[q].w * xv[q].w);
            const float rstd = rsqrtf(wave_sum(ss) * (1.f / D) + EPS);
#pragma unroll
            for (int q = 0; q < 4; ++q) { const int c0 = 4 * lane + 256 * q;
                float h[4];
#pragma unroll
                for (int e = 0; e < 4; ++e) h[e] = xv[q][e] * rstd * gnv[q][e] * (1.f + scv[q][e]) + shv[q][e];
                u32x2 hi; hi.x = cvt_pk_bf16(h[0], h[1]); hi.y = cvt_pk_bf16(h[2], h[3]);
                u32x2 lo; lo.x = cvt_pk_bf16(h[0] - bflo(hi.x), h[1] - bfhi(hi.x)); lo.y = cvt_pk_bf16(h[2] - bflo(hi.y), h[3] - bfhi(hi.y));
                *(u32x2*)(H + (size_t)r * D + c0) = hi; *(u32x2*)(LO + (size_t)r * D + c0) = lo;
                if ((F8MOE >> l) & 1) *(unsigned*)(F.ws + WS_H8 + (size_t)r * D + c0) = pk_fp8x4(F8_SH * h[0], F8_SH * h[1], F8_SH * h[2], F8_SH * h[3]); }
        }
    }
    asm volatile("s_waitcnt vmcnt(0)" ::: "memory");
    N2_WWRITE(0);
    __syncthreads();
    const int rsel = i16 < 9 ? i16 : i16 - 9;
    const int r = gw + rsel * NGW;
    const bool rowok = !(l == 1 && (r % RPB) < TC);
    const bf16* hrow = H + (size_t)r * D + 8 * g; const bf16* lrow = LO + (size_t)r * D + 8 * g;
    f32x4 acc[3];
#pragma unroll
    for (int ct = 0; ct < 3; ++ct) acc[ct] = (f32x4){0.f, 0.f, 0.f, 0.f};
    bf16x8 ahn[4], aln[4];
#define N2_ALOAD(kc) do { _Pragma("unroll") for (int k4 = 0; k4 < 4; ++k4) { const int c0 = 128 * (kc) + 32 * k4; \
        ahn[k4] = rowok ? *(const bf16x8*)(hrow + c0) : (bf16x8){0, 0, 0, 0, 0, 0, 0, 0}; aln[k4] = rowok ? *(const bf16x8*)(lrow + c0) : (bf16x8){0, 0, 0, 0, 0, 0, 0, 0}; } } while (0)
    N2_ALOAD(0);
    for (int kc = 0; kc < 8; ++kc) {
        if (kc + 1 < 8) N2_WLOAD(kc + 1);
        const LAS char* wb = WL + (kc & 1) * N2_WBUF;
        bf16x8 ah[4], al[4];
#pragma unroll
        for (int k4 = 0; k4 < 4; ++k4) { ah[k4] = ahn[k4]; al[k4] = aln[k4]; }
        if (kc + 1 < 8) N2_ALOAD(kc + 1);
#pragma unroll
        for (int k4 = 0; k4 < 4; ++k4)
#pragma unroll
            for (int ct = 0; ct < 3; ++ct) { const LAS char* wp = wb + (16 * ct + i16) * N2_WROW + (32 * k4 + 8 * g) * 2;
                const bf16x8 bh = *(const LAS bf16x8*)wp, bl = *(const LAS bf16x8*)(wp + 48 * N2_WROW);
                acc[ct] = MFMA16(ah[k4], bh, acc[ct]); acc[ct] = MFMA16(ah[k4], bl, acc[ct]); acc[ct] = MFMA16(al[k4], bh, acc[ct]); }
        if (kc + 1 < 8) N2_WWRITE((kc + 1) & 1);
        __syncthreads();
    }
#undef N2_WLOAD
#undef N2_ALOAD
#undef N2_WWRITE
#pragma unroll
    for (int ct = 0; ct < 3; ++ct)
#pragma unroll
        for (int e = 0; e < 4; ++e) LG[(4 * g + e) * 48 + 16 * ct + i16] = acc[ct][e];
    LDS_WAIT(); asm volatile("" ::: "memory");
    if (lane < 9) { const int rr = gw + lane * NGW;
        if (!(l == 1 && (rr % RPB) < TC)) {
            const LAS float* lgp = LG + lane * 48;
            float gl[4];
#pragma unroll
            for (int q = 0; q < 4; ++q) gl[q] = lgp[q] + F.in[I_RGB][l * 4 + q];
            int gi = 0; float gm = gl[0];
#pragma unroll
            for (int q = 1; q < 4; ++q) if (gl[q] > gm) { gm = gl[q]; gi = q; }
            float gs = 0.f;
#pragma unroll
            for (int q = 0; q < 4; ++q) gs += expf(gl[q] - gm);
            const float pg = 1.f / gs;
            float el[8];
#pragma unroll
            for (int q = 0; q < 8; ++q) el[q] = lgp[4 + gi * 8 + q] + F.in[I_REB][l * 32 + gi * 8 + q];
            int i0 = 0; float m0 = el[0];
#pragma unroll
            for (int q = 1; q < 8; ++q) if (el[q] > m0) { m0 = el[q]; i0 = q; }
            int i1 = -1; float m1 = -3.0e38f;
#pragma unroll
            for (int q = 0; q < 8; ++q) if (q != i0 && el[q] > m1) { m1 = el[q]; i1 = q; }
            const float t = expf(m1 - m0);
            const float w0 = pg / (1.f + t), w1 = pg * t / (1.f + t);
            const int e0 = gi * 8 + i0, e1 = gi * 8 + i1;
            const unsigned p0 = __hip_atomic_fetch_add(lcnt + e0, 1u, __ATOMIC_RELAXED, __HIP_MEMORY_SCOPE_WORKGROUP), p1 = __hip_atomic_fetch_add(lcnt + e1, 1u, __ATOMIC_RELAXED, __HIP_MEMORY_SCOPE_WORKGROUP);
            LAS unsigned* lr = lrank + (F.wave * 9 + lane) * 4; lr[0] = p0; lr[1] = p1; lr[2] = (unsigned)e0; lr[3] = (unsigned)e1;
            int* rt = (int*)(F.ws + WS_ROUTE) + (size_t)rr * 8; rt[0] = e0; rt[1] = e1; ((float*)rt)[4] = w0; ((float*)rt)[5] = w1; }
    }
    __syncthreads();
    if (tid < 32) gbase[tid] = __hip_atomic_fetch_add(cnt + 64 * tid, lcnt[tid], RLX_AGENT);
    __syncthreads();
    if (lane < 9) { const int rr = gw + lane * NGW;
        if (!(l == 1 && (rr % RPB) < TC)) { int* rt = (int*)(F.ws + WS_ROUTE) + (size_t)rr * 8; const LAS unsigned* lr = lrank + (F.wave * 9 + lane) * 4;
            const int p0 = (int)(gbase[lr[2]] + lr[0]), p1 = (int)(gbase[lr[3]] + lr[1]); rt[2] = p0; rt[3] = p1;
            int* rowof = (int*)(F.ws + WS_R1); rowof[(size_t)lr[2] * ECAP + p0] = rr; rowof[(size_t)lr[3] * ECAP + p1] = rr; } }
    __syncthreads();
}

__device__ __forceinline__ int expert_pstart(const unsigned* cnt, int e) {
    int s = 0;
    for (int q = 0; q < e; ++q) s += (int)((cnt[64 * q] + 255u) & ~255u);
    return s;
}
__device__ __forceinline__ void phase_dispatch(Frame& F, int l) {
    const int gw = F.bid * NWAVES + F.wave, NGW = F.G * NWAVES, lane = F.lane;
    const unsigned* cnt = F.ctl + CW_ECNT + 2048 * l;
    LAS int* pst = (LAS int*)F.lds;
    if (F.tid < 32) pst[32 + F.tid] = (int)((cnt[64 * F.tid] + 255u) & ~255u);
    __syncthreads();
    if (F.tid == 0) { int s = 0; for (int e = 0; e < NEXP; ++e) { pst[e] = s; s += pst[32 + e]; } }
    __syncthreads();
    const bf16* H = (const bf16*)(F.ws + WS_H); bf16* XD = (bf16*)(F.ws + WS_R1);
    for (int r = gw; r < M; r += NGW) {
        if (l == 1 && (r % RPB) < TC) continue;
        int* rt = (int*)(F.ws + WS_ROUTE) + (size_t)r * 8;
        const int e0 = rt[0], e1 = rt[1], p0 = rt[2], p1 = rt[3];
        const int s0 = pst[e0] + p0, s1 = pst[e1] + p1;
        const u32x4* hp = (const u32x4*)(H + (size_t)r * D) + lane; const u32x4 v0 = hp[0], v1 = hp[64];
        u32x4* d0 = (u32x4*)(XD + (size_t)s0 * D) + lane; d0[0] = v0; d0[64] = v1;
        u32x4* d1 = (u32x4*)(XD + (size_t)s1 * D) + lane; d1[0] = v0; d1[64] = v1;
        if (lane == 0) { rt[6] = s0; rt[7] = s1; }
    }
    __syncthreads();
}
__device__ __forceinline__ int build_tile_table(Frame& F, int l) {
    volatile LAS unsigned* MISC = (volatile LAS unsigned*)(F.lds + LDSCTL_OFF);
    const unsigned* cnt = F.ctl + CW_ECNT + 2048 * l;
    if (F.tid < 32) MISC[288 + F.tid] = cnt[64 * F.tid];
    __syncthreads();
    if (F.tid == 0) { int t = 0; for (int e = 0; e < NEXP; ++e) { MISC[256 + e] = (unsigned)t; const int nt = (int)((MISC[288 + e] + 255u) >> 8); for (int k = 0; k < nt && t < 176; ++k) MISC[32 + t++] = (unsigned)e; } MISC[17] = (unsigned)t; }
    __syncthreads();
    return (int)MISC[17];
}

__device__ __forceinline__ void phase_combine(Frame& F, int l) {
    const int gw = F.bid * NWAVES + F.wave, lane = F.lane;
    float* X = (float*)(F.ws + WS_X); const bf16* YM = (const bf16*)(F.ws + WS_R2);
    (void)build_tile_table(F, l);
    volatile LAS unsigned* MISCc = (volatile LAS unsigned*)(F.lds + LDSCTL_OFF);
    if (l == 0) stage_gate_w(F, 1);
    const int nrows = l == 0 ? 9 : 8;
#define CMB_ROW(j_) (l == 0 ? gw * 9 + (j_) : ((gw * 8 + (j_)) >> 11) * RPB + TC + ((gw * 8 + (j_)) & 2047))
    f32x4 gv[4];
#pragma unroll
    for (int j = 0; j < 4; ++j) gv[j] = *(const f32x4*)((l == 0 ? F.in[I_N1G] + 1024 : F.in[I_FING]) + 4 * lane + 256 * j);
    const float gateb = F.in[I_GATEB][16 + (lane & 15)];
    int mi_cur = -1; f32x4 g2v[4], shv[4], scvv[4];
    u32x2 ya[4], yb[4], yan[4], ybn[4]; f32x4 xc[4], xn[4]; float w0 = 0.f, w1 = 0.f, w0n = 0.f, w1n = 0.f;
    int e0n, e1n, p0n, p1n; float wan, wbn;
#define CMB_RT(r_) do { const int* rt_ = (const int*)(F.ws + WS_ROUTE) + (size_t)(r_) * 8; e0n = rt_[0]; e1n = rt_[1]; p0n = rt_[2]; p1n = rt_[3]; wan = ((const float*)rt_)[4]; wbn = ((const float*)rt_)[5]; } while (0)
#define CMB_ISSUE(r_) do { const int s0_ = ((int)MISCc[256 + e0n] + (p0n >> 8)) * 256 + (p0n & 255), s1_ = ((int)MISCc[256 + e1n] + (p1n >> 8)) * 256 + (p1n & 255); w0n = wan; w1n = wbn; \
        _Pragma("unroll") for (int j = 0; j < 4; ++j) { const int c0 = 4 * lane + 256 * j; yan[j] = *(const u32x2*)(YM + (size_t)s0_ * D + c0); ybn[j] = *(const u32x2*)(YM + (size_t)s1_ * D + c0); \
            xn[j] = *((const f32x4*)(X + (size_t)(r_) * D) + lane + 64 * j); } } while (0)
    CMB_RT(CMB_ROW(0)); CMB_ISSUE(CMB_ROW(0));
    if (nrows > 1) CMB_RT(CMB_ROW(1));
    for (int jr = 0; jr < nrows; ++jr) { const int r = CMB_ROW(jr);
#pragma unroll
        for (int j = 0; j < 4; ++j) { ya[j] = yan[j]; yb[j] = ybn[j]; xc[j] = xn[j]; }
        w0 = w0n; w1 = w1n;
        if (jr + 1 < nrows) CMB_ISSUE(CMB_ROW(jr + 1));
        if (jr + 2 < nrows) CMB_RT(CMB_ROW(jr + 2));
        const int mi = row_mi(r);
        if (mi != mi_cur) { mi_cur = mi; const float* modl = ws_mod(F, l, mi); const float* mod1 = ws_mod(F, 1, mi);
#pragma unroll
            for (int j = 0; j < 4; ++j) { const int c0 = 4 * lane + 256 * j; g2v[j] = *(const f32x4*)(modl + 5120 + c0);
                if (l == 0) { shv[j] = *(const f32x4*)(mod1 + c0); scvv[j] = *(const f32x4*)(mod1 + 1024 + c0); } } }
        f32x4 xv[4];
#pragma unroll
        for (int j = 0; j < 4; ++j) { const u32x2 a = ya[j], b = yb[j]; const f32x4 g = g2v[j]; f32x4 x = xc[j];
            x.x += g.x * (w0 * bflo(a.x) + w1 * bflo(b.x)); x.y += g.y * (w0 * bfhi(a.x) + w1 * bfhi(b.x));
            x.z += g.z * (w0 * bflo(a.y) + w1 * bflo(b.y)); x.w += g.w * (w0 * bfhi(a.y) + w1 * bfhi(b.y));
            xv[j] = x; }
        if (l == 0) {
            f32x4* xp = (f32x4*)(X + (size_t)r * D) + lane;
#pragma unroll
            for (int j = 0; j < 4; ++j) xp[64 * j] = xv[j];
            norm1_row(F, 1, r, xv, gv, shv, scvv, gateb);
        } else {
            const int b = r / RPB, s = r - b * RPB;
            float ss = 0.f;
#pragma unroll
            for (int j = 0; j < 4; ++j) ss += (xv[j].x * xv[j].x + xv[j].y * xv[j].y) + (xv[j].z * xv[j].z + xv[j].w * xv[j].w);
            const float rstd = rsqrtf(wave_sum(ss) * (1.f / D) + EPS);
            f32x4* op = (f32x4*)(F.out + ((size_t)b * TL + (s - TC)) * D) + lane;
#pragma unroll
            for (int j = 0; j < 4; ++j) op[64 * j] = xv[j] * rstd * gv[j];
        }
    }
#undef CMB_ROW
#undef CMB_RT
#undef CMB_ISSUE
    __syncthreads();
}

__device__ __forceinline__ void dbg_final(Frame& Fp) {
    const int gw = Fp.bid * NWAVES + Fp.wave, NGW = Fp.G * NWAVES;
    const float* X = (const float*)(Fp.ws + WS_X);
    for (int r = gw; r < M; r += NGW) { const int b = r / RPB, s = r - b * RPB; if (s < TC) continue;
        f32x4 xv[4]; const f32x4* xp = (const f32x4*)(X + (size_t)r * D) + Fp.lane; float ss = 0.f;
#pragma unroll
        for (int j = 0; j < 4; ++j) { xv[j] = xp[64 * j]; ss += (xv[j].x * xv[j].x + xv[j].y * xv[j].y) + (xv[j].z * xv[j].z + xv[j].w * xv[j].w); }
        const float rstd = rsqrtf(wave_sum(ss) * (1.f / D) + EPS);
        f32x4* op = (f32x4*)(Fp.out + ((size_t)b * TL + (s - TC)) * D) + Fp.lane;
#pragma unroll
        for (int j = 0; j < 4; ++j) { const f32x4 g = *(const f32x4*)(Fp.in[I_FING] + 4 * Fp.lane + 256 * j); op[64 * j] = xv[j] * rstd * g; } }
}
#ifdef TSEL
#define TSTAMP(cat) do { if (F.tid == 0) { const unsigned now_ = (unsigned)__builtin_amdgcn_s_memrealtime(); MISC[224 + (cat)] += now_ - MISC[223]; MISC[223] = now_; } } while (0)
#else
#define TSTAMP(cat) do { } while (0)
#endif
#define GRID_BAR() do { XcdBarrier bb_; bb_.bar = (unsigned*)((unsigned char*)(GAS unsigned char*)opaque_ptr((unsigned long long)F.ws) + WS_CTL) + CW_BAR; bb_.x = xb_xcc_id(); bb_.st = MISC + 8; xcd_barrier(bb_); } while (0)
#ifndef PHMASK
#define PHMASK 0xffff
#endif
#define ON(k) ((PHMASK >> (k)) & 1)
template <int l> __device__ __forceinline__ void layer_body(Frame& F, volatile LAS unsigned* MISC) {
        if (ON(2)) {
            Frame Fp = fresh(F); bf16* Wb = (bf16*)(Fp.ws + WS_W);
            pg8::Gemm g{(bf16*)(Fp.ws + WS_H), Wb + W_IN / 2, 1024, 1024, 1024}; pg8::StaticOrder S; S.init(M, NP, Fp.G, Fp.bid);
            EpiInProj E{(bf16*)(Fp.ws + WS_R1), (const float*)(Fp.ws + WS_ROPE)};
            pg8::gemm_phase(Fp.lds, Fp.tid, g, S, E);
        }
        GRID_BAR(); TSTAMP(1);
        if (ON(3)) { Frame Fp = fresh(F); phase_mix(Fp, l); }
        GRID_BAR(); TSTAMP(2);
        if (ON(4)) { Frame Fp = fresh(F); phase_prep(Fp, l); }
        GRID_BAR(); TSTAMP(11);
        if (ON(5)) {
            Frame Fp = fresh(F); bf16* Wb = (bf16*)(Fp.ws + WS_W);
            pg8::Gemm g{(bf16*)(Fp.ws + WS_R1), Wb + W_BR / 2, 512, NP, 512}; pg8::StaticOrder S; S.init(l == 1 ? NB * TL : M, 1024, Fp.G, Fp.bid, 3, (size_t)512 * 2, (size_t)1024 * 512 * 2, l == 1);
            EpiPlain E{(bf16*)(Fp.ws + WS_R2), 3072, 0, 1024};
            pg8::gemm_phase(Fp.lds, Fp.tid, g, S, E);
        }
        GRID_BAR(); TSTAMP(3);
        if (ON(6)) {
            Frame Fp = fresh(F); bf16* Wb = (bf16*)(Fp.ws + WS_W);
            constexpr bool f8 = (F8GT >> l) & 1;
            pg8::Gemm g{(bf16*)(Fp.ws + (f8 ? WS_HG8 : WS_H)), Wb + W_GP / 2, f8 ? 512 : 1024, f8 ? 512 : 1024, f8 ? 512 : 1024}; pg8::StaticOrder S; S.init(l == 1 ? NB * TL : M, 4096, Fp.G, Fp.bid, 1, 0, 0, l == 1);
            EpiGates<f8> E{(bf16*)(Fp.ws + WS_R2), (bf16*)(Fp.ws + WS_R1), Fp.in[I_BGATE] + l * 3072};
            pg8::gemm_phase<EpiGates<f8>, pg8::StaticOrder, true, f8>(Fp.lds, Fp.tid, g, S, E);
        }
        GRID_BAR(); TSTAMP(3);
        if (ON(7)) {
            Frame Fp = fresh(F); bf16* Wb = (bf16*)(Fp.ws + WS_W);
            pg8::Gemm g{(bf16*)(Fp.ws + WS_R1), Wb + W_OUT / 2, 1024, 1024, 1024}; pg8::StaticOrder S; S.init(l == 1 ? NB * TL : M, 1024, Fp.G, Fp.bid, 1, 0, 0, l == 1);
            EpiOut E{(float*)(Fp.ws + WS_X), ws_mod(Fp, l, 0), l == 0 ? Fp.in[I_X] : nullptr, l == 0 ? Fp.in[I_CTX] : nullptr};
            pg8::gemm_phase(Fp.lds, Fp.tid, g, S, E);
        }
        GRID_BAR(); TSTAMP(3);
#if defined(DBG_STOP) && DBG_STOP == 7
        { Frame Fp = fresh(F); dbg_final(Fp); return; }
#endif
        if (ON(8)) { Frame Fp = fresh(F); phase_norm2(Fp, l); }
        GRID_BAR(); TSTAMP(7);
        if (ON(10)) {
            Frame Fp = fresh(F); bf16* Wb = (bf16*)(Fp.ws + WS_W);
            const int ntiles = build_tile_table(Fp, l);
            constexpr bool f8 = (F8MOE >> l) & 1;
            pg8::Gemm g{(bf16*)(Fp.ws + (f8 ? WS_H8 : WS_H)), Wb + W_13 / 2, f8 ? 512 : 1024, f8 ? 512 : 1024, f8 ? 512 : 1024};
            GroupedOrder S{(const volatile LAS int*)(MISC + 32), (const volatile LAS int*)(MISC + 256), (const volatile LAS int*)(MISC + 288), (const int*)(Fp.ws + WS_R1), ntiles, Fp.G, Fp.bid, (size_t)1024 * 1024 * (f8 ? 1 : 2)};
            EpiMoe1<f8> E{(bf16*)(Fp.ws + WS_R1 + 88 * MiB)};
            pg8::gemm_phase_gather<EpiMoe1<f8>, GroupedOrder, f8>(Fp.lds, Fp.tid, g, S, E);
        }
        GRID_BAR(); TSTAMP(9);
        if (ON(11)) {
            Frame Fp = fresh(F); bf16* Wb = (bf16*)(Fp.ws + WS_W);
            const int ntiles = build_tile_table(Fp, l);
            constexpr bool f8 = (F8MOE >> l) & 1;
            pg8::Gemm g{(bf16*)(Fp.ws + WS_R1 + 88 * MiB), Wb + W_2 / 2, f8 ? 256 : 512, f8 ? 256 : 512, f8 ? 256 : 512};
            GroupedOrder S{(const volatile LAS int*)(MISC + 32), (const volatile LAS int*)(MISC + 256), (const volatile LAS int*)(MISC + 288), (const int*)(Fp.ws + WS_R1), ntiles, Fp.G, Fp.bid, (size_t)1024 * 512 * (f8 ? 1 : 2)};
            if constexpr (f8) { EpiScaled E{(bf16*)(Fp.ws + WS_R2), 1024, 1.f / (F8_SU * F8_SW)}; pg8::gemm_phase<EpiScaled, GroupedOrder, false, true>(Fp.lds, Fp.tid, g, S, E); }
            else { EpiPlain E{(bf16*)(Fp.ws + WS_R2), 1024, 0, 0}; pg8::gemm_phase(Fp.lds, Fp.tid, g, S, E); }
        }
        GRID_BAR(); TSTAMP(10);
        if (ON(12)) { Frame Fp = fresh(F); if (l == 0) { phase_convert(Fp, 1); __syncthreads(); } phase_combine(Fp, l); }
        if (l == 0) GRID_BAR();
        TSTAMP(6);
#if defined(DBG_STOP) && DBG_STOP == 12
        { Frame Fp = fresh(F); dbg_final(Fp); return; }
#endif
}

struct Args { const float* in[29]; float* out; unsigned char* ws; int pad[2]; };
__global__ void __launch_bounds__(NTHR, 2) fwd_kernel(Args args) {
    extern __shared__ __attribute__((aligned(16))) unsigned char lds[];
    Frame F;
    F.lds = (LAS unsigned char*)lds; F.lds_generic = lds;
    F.ws = args.ws; F.ctl = (unsigned*)(args.ws + WS_CTL);
    F.tid = threadIdx.x; F.lane = F.tid & 63; F.wave = __builtin_amdgcn_readfirstlane(F.tid >> 6); F.G = gridDim.x; F.bid = blockIdx.x;
    F.in.p = (KargIn)__builtin_amdgcn_kernarg_segment_ptr(); F.out = args.out;
    volatile LAS unsigned* MISC = (volatile LAS unsigned*)(F.lds + LDSCTL_OFF);
    for (int u = F.tid; u < 512; u += NTHR) MISC[u] = 0u;
    __syncthreads();
    (void)xcd_barrier_post(F.ctl + CW_BAR, MISC + 8);
#ifdef TSEL
    if (F.tid == 0) MISC[223] = (unsigned)__builtin_amdgcn_s_memrealtime();
#endif
#ifdef DBG_IDENT
    { { Frame Fp = fresh(F); phase_init(Fp); } GRID_BAR(); GRID_BAR(); Frame Fp = fresh(F); dbg_final(Fp); return; }
#endif
    if (ON(0)) { Frame Fp = fresh(F); phase_convert(Fp, 0); __syncthreads(); phase_init(Fp); }
    GRID_BAR(); TSTAMP(0);
    if (ON(1)) { Frame Fp = fresh(F); phase_norm1(Fp, 0); }
    GRID_BAR(); TSTAMP(5);
    layer_body<0>(F, MISC);
    layer_body<1>(F, MISC);
#ifdef TSEL
    if ((F.bid == 0 || TSEL >= 20) && F.tid == 0 && MISC[224 + (TSEL % 32)] != 0u) { const unsigned long long target = __builtin_amdgcn_s_memrealtime() + 8ull * MISC[224 + (TSEL % 32)];
        while (__builtin_amdgcn_s_memrealtime() < target) __builtin_amdgcn_s_sleep(8); }
#endif
}

extern "C" void kernel_launch(void* const* d_in, const int* in_sizes, int n_in, void* d_out, int out_size, void* d_ws, size_t ws_size, hipStream_t stream) {
    static int grid = 0;
    if (grid == 0) {
        if (n_in != 29 || out_size != NB * TL * D || ws_size < WS_END) { fprintf(stderr, "kernel_launch: unexpected shapes: n_in %d out %d ws %zu (need %zu)\n", n_in, out_size, ws_size, (size_t)WS_END); grid = -1; return; }
        int dev = 0, cus = 0, per_cu = 0;
        if (hipGetDevice(&dev) != hipSuccess || hipDeviceGetAttribute(&cus, hipDeviceAttributeMultiprocessorCount, dev) != hipSuccess) { grid = -1; return; }
        if (hipFuncSetAttribute((const void*)fwd_kernel, hipFuncAttributeMaxDynamicSharedMemorySize, LDS_BYTES) != hipSuccess) { fprintf(stderr, "kernel_launch: hipFuncSetAttribute failed\n"); grid = -1; return; }
        if (hipOccupancyMaxActiveBlocksPerMultiprocessor(&per_cu, (const void*)fwd_kernel, NTHR, LDS_BYTES) != hipSuccess || per_cu < 1) { fprintf(stderr, "kernel_launch: occupancy query says %d blocks per CU\n", per_cu); }
        (void)hipGetLastError();
        if (cus != 256) { fprintf(stderr, "kernel_launch: built for a 256-CU device (row partition of 9 rows per wave), found %d CUs; nothing launched\n", cus); grid = -1; return; }
        grid = cus;
    }
    if (grid < 0) return;
    if (hipMemsetAsync((char*)d_ws + WS_CTL, 0, CTL_ZERO_BYTES, stream) != hipSuccess) return;
    Args a{};
    for (int i = 0; i < 29; ++i) a.in[i] = (const float*)d_in[i];
    a.out = (float*)d_out; a.ws = (unsigned char*)d_ws;
    hipLaunchKernelGGL(fwd_kernel, dim3(grid), dim3(NTHR), LDS_BYTES, stream, a);
}
```

```cpp
#include <hip/hip_runtime.h>
#include <cstdio>
#include <cstdint>

#define GAS __attribute__((address_space(1)))
#define LAS __attribute__((address_space(3)))
typedef unsigned short bf16;
typedef short bf16x8 __attribute__((ext_vector_type(8)));
typedef short s16x4 __attribute__((ext_vector_type(4)));
typedef float f32x2 __attribute__((ext_vector_type(2)));
typedef float f32x4 __attribute__((ext_vector_type(4)));
typedef float f32x16 __attribute__((ext_vector_type(16)));
typedef unsigned u32x2 __attribute__((ext_vector_type(2)));
typedef unsigned u32x4 __attribute__((ext_vector_type(4)));
typedef GAS unsigned gu32;
typedef int i32x4 __attribute__((ext_vector_type(4)));
typedef int i32x8 __attribute__((ext_vector_type(8)));
#ifndef F8MOE
#define F8MOE 3
#endif
#ifndef F8GT
#define F8GT 3
#endif
static_assert(F8GT == 0 || F8MOE == 3, "the fp8 copy of the norm1 output lives in the half of the expert-weight region that fp8 expert weights leave free");
#ifndef F8BR
#define F8BR 3
#endif
constexpr float F8_SY = 16.f;
constexpr float F8_SH = 8.f, F8_SW = 256.f, F8_SU = 4.f;

constexpr int NB = 8, TL = 2048, TC = 256, RPB = TL + TC  , M = NB * RPB  , D = 1024;
constexpr int NP = 6144;
constexpr int NWAVES = 8, NTHR = 512;
constexpr int PA_Q = 0, PA_I = 512, PA_G = 1024, PA_F = 1536, PB_Q = 2560, PB_K = 3072, PB_V = 3584, PB_O = 4096, PC_Q = 4608, PC_K = 5120, PC_V = 5632;
constexpr int WIN_N = 6160, WIN_GATE0 = 4608;
constexpr int NEXP = 32, DEXP = 512;
constexpr int ECAP = NB * RPB;
constexpr int MAXSLOT = 45056;
constexpr float EPS = 1e-6f;

constexpr size_t MiB = 1u << 20;
constexpr size_t WS_CTL = 0, CTL_ZERO_BYTES = 1 * MiB;
constexpr size_t WS_MOD = 1 * MiB;
constexpr size_t WS_ROPE = 2 * MiB;
constexpr size_t WS_GATES = 3 * MiB;
constexpr size_t WS_ROUTE = 5 * MiB;
constexpr size_t WS_WRT = 7 * MiB;
constexpr size_t WS_W = 8 * MiB;
constexpr size_t W_IN = 0, W_GP = 12 * MiB, W_BR = 20 * MiB, W_OUT = 23 * MiB, W_13 = 25 * MiB, W_2 = 89 * MiB, W_END = 121 * MiB;
constexpr size_t WS_X = WS_W + W_END;
constexpr size_t WS_H = WS_X + 72 * MiB;
constexpr size_t WS_R1 = WS_H + 36 * MiB;
constexpr size_t WS_R2 = WS_R1 + 216 * MiB;
constexpr size_t WS_H8 = WS_R1 + 8 * MiB;
constexpr size_t WS_HG8 = WS_W + W_13 + 32 * MiB;
constexpr size_t WS_END = WS_R2 + 108 * MiB;

constexpr int CW_QUEUE = 64;
constexpr int CW_ECNT = 8192;
constexpr int CW_BAR = 4096;

constexpr int LDS_BYTES = 155648;
constexpr int LDSCTL_OFF = 153600;
constexpr int RING_OFF = 0;

#define RLX_AGENT __ATOMIC_RELAXED, __HIP_MEMORY_SCOPE_AGENT
#define LDS_WAIT() asm volatile("s_waitcnt lgkmcnt(0)" ::: "memory")
#define VM_WAIT() asm volatile("s_waitcnt vmcnt(0)" ::: "memory")
typedef __bf16 bf16x2_t __attribute__((ext_vector_type(2)));
__device__ __forceinline__ unsigned cvt_pk_bf16(float lo, float hi) { const f32x2 v = {lo, hi}; const bf16x2_t b = __builtin_convertvector(v, bf16x2_t); return __builtin_bit_cast(unsigned, b); }
__device__ __forceinline__ unsigned pk_fp8x4(float a, float b, float c, float d) {
    float mx = 448.f; asm volatile("" : "+v"(mx)); const float mn = -mx;
    a = __builtin_amdgcn_fmed3f(a, mn, mx); b = __builtin_amdgcn_fmed3f(b, mn, mx); c = __builtin_amdgcn_fmed3f(c, mn, mx); d = __builtin_amdgcn_fmed3f(d, mn, mx);
    unsigned w = __builtin_amdgcn_cvt_pk_fp8_f32(a, b, 0, false); return __builtin_amdgcn_cvt_pk_fp8_f32(c, d, w, true); }
__device__ __forceinline__ i32x8 cat8(bf16x8 a, bf16x8 b) { const i32x4 x = __builtin_bit_cast(i32x4, a), y = __builtin_bit_cast(i32x4, b); return __builtin_shufflevector(x, y, 0, 1, 2, 3, 4, 5, 6, 7); }
__device__ __forceinline__ float bf2f(unsigned h) { return __uint_as_float(h << 16); }
__device__ __forceinline__ float bflo(unsigned w) { return __uint_as_float(w << 16); }
__device__ __forceinline__ float bfhi(unsigned w) { return __uint_as_float(w & 0xffff0000u); }
__device__ __forceinline__ bf16 f2bf(float f) { return (bf16)(cvt_pk_bf16(f, 0.f) & 0xffffu); }
template <int CTRL> __device__ __forceinline__ float dpp_mov(float v) { return __int_as_float(__builtin_amdgcn_update_dpp(0, __float_as_int(v), CTRL, 0xf, 0xf, true)); }
__device__ __forceinline__ float swap16_add(float v) { auto r = __builtin_amdgcn_permlane16_swap(__float_as_uint(v), __float_as_uint(v), false, false); return __uint_as_float(r[0]) + __uint_as_float(r[1]); }
__device__ __forceinline__ float swap32_add(float v) { auto r = __builtin_amdgcn_permlane32_swap(__float_as_uint(v), __float_as_uint(v), false, false); return __uint_as_float(r[0]) + __uint_as_float(r[1]); }
__device__ __forceinline__ float row_sum(float v) { v += dpp_mov<0xB1>(v); v += dpp_mov<0x4E>(v); v += dpp_mov<0x141>(v); v += dpp_mov<0x140>(v); return v; }
__device__ __forceinline__ float wave_sum(float v) { v = row_sum(v); v = swap16_add(v); return swap32_add(v); }
__device__ __forceinline__ float sigmoidf_(float x) { return __builtin_amdgcn_rcpf(1.f + __builtin_amdgcn_exp2f(-1.4426950408889634f * x)); }
__device__ __forceinline__ float siluf_(float x) { return x * __builtin_amdgcn_rcpf(1.f + __builtin_amdgcn_exp2f(-1.4426950408889634f * x)); }
__device__ __forceinline__ float log_sigmoidf_(float x) { return fminf(x, 0.f) - log1pf(__expf(-fabsf(x))); }

__device__ __forceinline__ int fresh_lane() { int l; asm volatile("v_mbcnt_lo_u32_b32 %0, -1, 0\n\tv_mbcnt_hi_u32_b32 %0, -1, %0" : "=v"(l)); return l; }
namespace pg8 {
constexpr int BM = 256, BK = 64, HALF = 128, HTB = HALF * BK * 2, NXCD = 8, WGM = 8;
__host__ __device__ __forceinline__ int lds_byte(int r, int c) { const int st = (r >> 4) * 2 + (c >> 5), rr = r & 15, cc = c & 31, ob = rr * 64 + cc * 2; return st * 1024 + (ob ^ (((ob >> 9) & 1) << 5)); }
__host__ __device__ __forceinline__ void stage_rc(int b, int& R, int& C) { const int st = b / 1024, sb = b % 1024, swz = sb ^ (((sb >> 9) & 1) << 5); R = (st >> 1) * 16 + swz / 64; C = (st & 1) * 32 + (swz % 64) / 2; }
__host__ __device__ __forceinline__ int perm32(int rho) { const int n = rho >> 4, i = rho & 15; return 8 * (i >> 2) + 4 * n + (i & 3); }

struct Unit { int pm, pn, z; size_t aoff, boff; const int* rl; int rn; };
struct Gemm { const bf16* A; const bf16* Bt; int K, lda, ldb; };

struct StaticOrder {
    int nM, nN, nwg, G, c, nz, lat; size_t astride, bstride;
    __device__ void init(int M_, int N_, int G_, int c_, int nz_ = 1, size_t as_ = 0, size_t bs_ = 0, int lat_ = 0) { nM = M_ / BM; nN = N_ / BM; nwg = nM * nN; G = G_; c = c_; nz = nz_; astride = as_; bstride = bs_; lat = lat_; }
    __device__ bool next(int i, Unit& u) const {
        const long L0 = (long)i * G + c; if (L0 >= (long)nwg * nz) return false;
        const int z = (int)(L0 / nwg); const long L = L0 - (long)z * nwg; u.z = z; u.aoff = z * astride; u.boff = z * bstride; u.rl = nullptr; u.rn = 0;
        int wgid = (int)L; { const int q = nwg / NXCD, r = nwg % NXCD, xcd = wgid % NXCD, off = wgid / NXCD; wgid = (xcd < r ? xcd * (q + 1) : r * (q + 1) + (xcd - r) * q) + off; }
        const int nig = WGM * nN, gid = wgid / nig, fm = gid * WGM, gsz = (nM - fm) < WGM ? (nM - fm) : WGM;
        u.pm = fm + ((wgid % nig) % gsz); u.pn = (wgid % nig) / gsz; if (lat) u.pm = (u.pm >> 3) * 9 + 1 + (u.pm & 7); return true;
    }
};

template <class Epi, class Sched, bool SKIP11 = false, bool F8 = false>
__device__ __forceinline__ void gemm_phase(LAS unsigned char* lds, const int tid, const Gemm g, const Sched& S, const Epi& E) {
    const int wid = __builtin_amdgcn_readfirstlane(tid >> 6), lane = tid & 63, wr = wid >> 2, wc = wid & 3, fr = lane & 15, fq = lane >> 4;
    int K = g.K; asm volatile("" : "+s"(K)); const int nt = K / BK;
    unsigned voffA[2], voffB[2];
#pragma unroll
    for (int i = 0; i < 2; ++i) { int R, C; stage_rc(tid * 16 + i * 8192, R, C); const int Rb = ((R & ~31) + perm32(R & 31));
        voffA[i] = (unsigned)(R * g.lda + C) * 2u; voffB[i] = (unsigned)(Rb * g.ldb + C) * 2u; }
    const size_t kstep = (size_t)(BK * 2);
    const size_t hsA = (size_t)HALF * g.lda * 2, hsB = (size_t)HALF * g.ldb * 2;
    const size_t tsA = 2 * hsA, tsB = 2 * hsB;
    const unsigned ldsw = (unsigned)wid * 1024u;
    const int aoff = lds_byte(wr * 64 + fr, fq * 8), boff = lds_byte(wc * 32 + fr, fq * 8);
#define PG8_SA(b, h) (((b) * 2 + (h)) * HTB)
#define PG8_SB(b, h) ((4 + (b) * 2 + (h)) * HTB)
#define PG8_STAGE(bufoff, gbase, voff) do { const char* gb_ = (const char*)(gbase); asm volatile("" : "+s"(gb_)); _Pragma("unroll") for (int _i = 0; _i < 2; ++_i) { unsigned vo_ = (voff)[_i]; asm volatile("" : "+v"(vo_)); \
        __builtin_amdgcn_global_load_lds((const unsigned*)(gb_ + vo_), (LAS unsigned*)(lds + (bufoff) + ldsw + _i * 8192), 16, 0, 0); } } while (0)
#define PG8_LDA(dst, b, h) do { _Pragma("unroll") for (int m = 0; m < 4; ++m) _Pragma("unroll") for (int k = 0; k < 2; ++k) dst[m][k] = *(const LAS bf16x8*)(lds + PG8_SA(b, h) + aoff + m * 2048 + k * 1024); } while (0)
#define PG8_LDB(dst, b, h) do { _Pragma("unroll") for (int n = 0; n < 2; ++n) _Pragma("unroll") for (int k = 0; k < 2; ++k) dst[n][k] = *(const LAS bf16x8*)(lds + PG8_SB(b, h) + boff + n * 2048 + k * 1024); } while (0)
#define PG8_MMA(ai, bj, At, Bt) do { __builtin_amdgcn_s_setprio(1); _Pragma("unroll") for (int m = 0; m < 4; ++m) _Pragma("unroll") for (int n = 0; n < ((SKIP11 && (bj) == 1) ? 1 : 2); ++n) { \
        if constexpr (F8) acc[ai][bj][m][n] = __builtin_amdgcn_mfma_scale_f32_16x16x128_f8f6f4(cat8(Bt[n][0], Bt[n][1]), cat8(At[m][0], At[m][1]), acc[ai][bj][m][n], 0, 0, 0, 0x7f7f7f7f, 0, 0x7f7f7f7f); \
        else { _Pragma("unroll") for (int k = 0; k < 2; ++k) acc[ai][bj][m][n] = __builtin_amdgcn_mfma_f32_16x16x32_bf16(Bt[n][k], At[m][k], acc[ai][bj][m][n], 0, 0, 0); } } __builtin_amdgcn_s_setprio(0); } while (0)
#define PG8_WAIT_V(n) asm volatile("s_waitcnt vmcnt(" #n ")" ::: "memory")
#define PG8_WAIT_L(n) asm volatile("s_waitcnt lgkmcnt(" #n ")" ::: "memory")
#define PG8_BAR __builtin_amdgcn_s_barrier()
#define PG8_SCHED __builtin_amdgcn_sched_barrier(0)
    Unit cur, nxt; int ui = 0;
    if (!S.next(0, cur)) return;
    f32x4 acc[2][2][4][2];
#pragma unroll
    for (int a = 0; a < 2; ++a)
#pragma unroll
        for (int b = 0; b < 2; ++b)
#pragma unroll
            for (int m = 0; m < 4; ++m)
#pragma unroll
                for (int n = 0; n < 2; ++n) acc[a][b][m][n] = (f32x4){0.f, 0.f, 0.f, 0.f};
    bf16x8 At[4][2], B0[2][2], B1[2][2];
    const char* cA = (const char*)g.A + cur.aoff + (size_t)cur.pm * tsA; const char* cB = (const char*)g.Bt + cur.boff + (size_t)cur.pn * tsB;
    PG8_STAGE(PG8_SB(0, 0), cB, voffB); PG8_STAGE(PG8_SB(0, 1), cB + hsB, voffB); PG8_STAGE(PG8_SA(0, 0), cA, voffA); PG8_STAGE(PG8_SA(0, 1), cA + hsA, voffA);
    if (wr == 1) PG8_BAR;
    PG8_WAIT_V(2); PG8_BAR;
    PG8_STAGE(PG8_SB(1, 0), cB + kstep, voffB); PG8_STAGE(PG8_SA(1, 0), cA + kstep, voffA); PG8_STAGE(PG8_SB(1, 1), cB + hsB + kstep, voffB);
    PG8_WAIT_V(6); PG8_BAR;
    for (;;) {
        const bool has_next = S.next(ui + 1, nxt);
        const char* nA = has_next ? (const char*)g.A + nxt.aoff + (size_t)nxt.pm * tsA : cA; const char* nB = has_next ? (const char*)g.Bt + nxt.boff + (size_t)nxt.pn * tsB : cB;
        for (int t = 0; t < nt; t += 2) {
            const bool last = (t == nt - 2);
            const char* a1 = cA + (size_t)(t + 1) * kstep;
            const char* a2 = last ? nA : cA + (size_t)(t + 2) * kstep; const char* b2 = last ? nB : cB + (size_t)(t + 2) * kstep;
            const char* a3 = a2 + kstep; const char* b3 = b2 + kstep;
            PG8_LDB(B0, 0, 0); PG8_LDB(B1, 0, 1); PG8_SCHED; PG8_LDA(At, 0, 0); PG8_STAGE(PG8_SA(1, 1), a1 + hsA, voffA);
            PG8_WAIT_V(8); PG8_WAIT_L(0); PG8_BAR; PG8_MMA(0, 0, At, B0); PG8_MMA(0, 1, At, B1); PG8_BAR; PG8_SCHED;
            PG8_LDA(At, 0, 1); PG8_STAGE(PG8_SB(0, 0), b2, voffB); PG8_STAGE(PG8_SB(0, 1), b2 + hsB, voffB); PG8_STAGE(PG8_SA(0, 0), a2, voffA);
            PG8_WAIT_V(8); PG8_WAIT_L(0); PG8_BAR; PG8_MMA(1, 0, At, B0); PG8_MMA(1, 1, At, B1); PG8_BAR; PG8_SCHED;
            PG8_LDB(B0, 1, 0); PG8_LDB(B1, 1, 1); PG8_SCHED; PG8_LDA(At, 1, 0); PG8_STAGE(PG8_SA(0, 1), a2 + hsA, voffA);
            PG8_WAIT_V(8); PG8_WAIT_L(0); PG8_BAR; PG8_MMA(0, 0, At, B0); PG8_MMA(0, 1, At, B1); PG8_BAR; PG8_SCHED;
            PG8_LDA(At, 1, 1); PG8_STAGE(PG8_SB(1, 0), b3, voffB); PG8_STAGE(PG8_SB(1, 1), b3 + hsB, voffB); PG8_STAGE(PG8_SA(1, 0), a3, voffA);
            PG8_WAIT_V(8); PG8_WAIT_L(0); PG8_BAR; PG8_MMA(1, 0, At, B0); PG8_MMA(1, 1, At, B1); PG8_BAR; PG8_SCHED;
        }
        if (wr == 0) PG8_BAR;
        { const int l2_ = fresh_lane(); E(acc, cur, wr, wc, l2_ & 15, l2_ >> 4); }
        if (!has_next) break;
#pragma unroll
        for (int a = 0; a < 2; ++a)
#pragma unroll
            for (int b = 0; b < 2; ++b)
#pragma unroll
                for (int m = 0; m < 4; ++m)
#pragma unroll
                    for (int n = 0; n < 2; ++n) acc[a][b][m][n] = (f32x4){0.f, 0.f, 0.f, 0.f};
        cur = nxt; cA = nA; cB = nB; ++ui;
        if (wr == 1) PG8_BAR;
    }
    PG8_WAIT_V(0);
    PG8_BAR;
#undef PG8_SA
#undef PG8_SB
#undef PG8_STAGE
#undef PG8_LDA
#undef PG8_LDB
#undef PG8_MMA
#undef PG8_WAIT_V
#undef PG8_WAIT_L
#undef PG8_BAR
#undef PG8_SCHED
}
template <class Epi, class Sched, bool F8 = false>
__device__ __forceinline__ void gemm_phase_gather(LAS unsigned char* lds, const int tid, const Gemm g, const Sched& S, const Epi& E) {
    const int wid = __builtin_amdgcn_readfirstlane(tid >> 6), lane = tid & 63, wr = wid >> 2, wc = wid & 3, fr = lane & 15, fq = lane >> 4;
    int K = g.K; asm volatile("" : "+s"(K)); const int nt = K / BK;
    unsigned voffA[2], voffB[2];
#pragma unroll
    for (int i = 0; i < 2; ++i) { int R, C; stage_rc(tid * 16 + i * 8192, R, C); const int Rb = ((R & ~31) + perm32(R & 31));
        voffA[i] = (unsigned)(R * g.lda + C) * 2u; voffB[i] = (unsigned)(Rb * g.ldb + C) * 2u; }
    const size_t kstep = (size_t)(BK * 2);
    const size_t hsA = (size_t)HALF * g.lda * 2, hsB = (size_t)HALF * g.ldb * 2;
    const size_t tsA = 2 * hsA, tsB = 2 * hsB;
    const unsigned ldsw = (unsigned)wid * 1024u;
    unsigned vC[2][2], vN[2][2];
#define PG8_GOFF(dst, u) do { const int t_ = wid * 64 + fresh_lane(); _Pragma("unroll") for (int i_ = 0; i_ < 2; ++i_) { int gR_, gC_; stage_rc(t_ * 16 + i_ * 8192, gR_, gC_); \
        _Pragma("unroll") for (int h_ = 0; h_ < 2; ++h_) { const int q_ = h_ * HALF + gR_; \
        const int row_ = q_ < (u).rn ? (u).rl[q_] : 0; dst[h_][i_] = (unsigned)row_ * (unsigned)(g.lda * 2) + (unsigned)gC_ * 2u; } } } while (0)
#define PG8_STAGEG(bufoff, koff, v0, v1) do { unsigned v0_ = (v0), v1_ = (v1); asm volatile("" : "+v"(v0_), "+v"(v1_)); const char* b_ = (const char*)g.A + (koff); asm volatile("" : "+s"(b_)); \
        __builtin_amdgcn_global_load_lds((const unsigned*)(b_ + v0_), (LAS unsigned*)(lds + (bufoff) + ldsw), 16, 0, 0); \
        __builtin_amdgcn_global_load_lds((const unsigned*)(b_ + v1_), (LAS unsigned*)(lds + (bufoff) + ldsw + 8192), 16, 0, 0); } while (0)
    const int aoff = lds_byte(wr * 64 + fr, fq * 8), boff = lds_byte(wc * 32 + fr, fq * 8);
#define PG8_SA(b, h) (((b) * 2 + (h)) * HTB)
#define PG8_SB(b, h) ((4 + (b) * 2 + (h)) * HTB)
#define PG8_STAGE(bufoff, gbase, voff) do { const char* gb_ = (const char*)(gbase); asm volatile("" : "+s"(gb_)); _Pragma("unroll") for (int _i = 0; _i < 2; ++_i) { unsigned vo_ = (voff)[_i]; asm volatile("" : "+v"(vo_)); \
        __builtin_amdgcn_global_load_lds((const unsigned*)(gb_ + vo_), (LAS unsigned*)(lds + (bufoff) + ldsw + _i * 8192), 16, 0, 0); } } while (0)
#define PG8_LDA(dst, b, h) do { _Pragma("unroll") for (int m = 0; m < 4; ++m) _Pragma("unroll") for (int k = 0; k < 2; ++k) dst[m][k] = *(const LAS bf16x8*)(lds + PG8_SA(b, h) + aoff + m * 2048 + k * 1024); } while (0)
#define PG8_LDB(dst, b, h) do { _Pragma("unroll") for (int n = 0; n < 2; ++n) _Pragma("unroll") for (int k = 0; k < 2; ++k) dst[n][k] = *(const LAS bf16x8*)(lds + PG8_SB(b, h) + boff + n * 2048 + k * 1024); } while (0)
#define PG8_MMA(ai, bj, At, Bt) do { __builtin_amdgcn_s_setprio(1); _Pragma("unroll") for (int m = 0; m < 4; ++m) _Pragma("unroll") for (int n = 0; n < 2; ++n) { \
        if constexpr (F8) acc[ai][bj][m][n] = __builtin_amdgcn_mfma_scale_f32_16x16x128_f8f6f4(cat8(Bt[n][0], Bt[n][1]), cat8(At[m][0], At[m][1]), acc[ai][bj][m][n], 0, 0, 0, 0x7f7f7f7f, 0, 0x7f7f7f7f); \
        else { _Pragma("unroll") for (int k = 0; k < 2; ++k) acc[ai][bj][m][n] = __builtin_amdgcn_mfma_f32_16x16x32_bf16(Bt[n][k], At[m][k], acc[ai][bj][m][n], 0, 0, 0); } } __builtin_amdgcn_s_setprio(0); } while (0)
#define PG8_WAIT_V(n) asm volatile("s_waitcnt vmcnt(" #n ")" ::: "memory")
#define PG8_WAIT_L(n) asm volatile("s_waitcnt lgkmcnt(" #n ")" ::: "memory")
#define PG8_BAR __builtin_amdgcn_s_barrier()
#define PG8_SCHED __builtin_amdgcn_sched_barrier(0)
    Unit cur, nxt; int ui = 0;
    if (!S.next(0, cur)) return;
    f32x4 acc[2][2][4][2];
#pragma unroll
    for (int a = 0; a < 2; ++a)
#pragma unroll
        for (int b = 0; b < 2; ++b)
#pragma unroll
            for (int m = 0; m < 4; ++m)
#pragma unroll
                for (int n = 0; n < 2; ++n) acc[a][b][m][n] = (f32x4){0.f, 0.f, 0.f, 0.f};
    bf16x8 At[4][2], B0[2][2], B1[2][2];
    const char* cB = (const char*)g.Bt + cur.boff + (size_t)cur.pn * tsB;
    PG8_GOFF(vC, cur);
#pragma unroll
    for (int h_ = 0; h_ < 2; ++h_)
#pragma unroll
        for (int i_ = 0; i_ < 2; ++i_) vN[h_][i_] = vC[h_][i_];
    PG8_STAGE(PG8_SB(0, 0), cB, voffB); PG8_STAGE(PG8_SB(0, 1), cB + hsB, voffB); PG8_STAGEG(PG8_SA(0, 0), 0, vC[0][0], vC[0][1]); PG8_STAGEG(PG8_SA(0, 1), 0, vC[1][0], vC[1][1]);
    if (wr == 1) PG8_BAR;
    PG8_WAIT_V(2); PG8_BAR;
    PG8_STAGE(PG8_SB(1, 0), cB + kstep, voffB); PG8_STAGEG(PG8_SA(1, 0), kstep, vC[0][0], vC[0][1]); PG8_STAGE(PG8_SB(1, 1), cB + hsB + kstep, voffB);
    PG8_WAIT_V(6); PG8_BAR;
    for (;;) {
        const bool has_next = S.next(ui + 1, nxt);
        const char* nB = has_next ? (const char*)g.Bt + nxt.boff + (size_t)nxt.pn * tsB : cB;
        if (has_next) PG8_GOFF(vN, nxt);
        for (int t = 0; t < nt; t += 2) {
            const bool last = (t == nt - 2);
            const size_t k1 = (size_t)(t + 1) * kstep, k2 = last ? 0 : (size_t)(t + 2) * kstep, k3 = k2 + kstep;
            const char* b2 = last ? nB : cB + (size_t)(t + 2) * kstep; const char* b3 = b2 + kstep;
            PG8_LDB(B0, 0, 0); PG8_LDB(B1, 0, 1); PG8_SCHED; PG8_LDA(At, 0, 0); PG8_STAGEG(PG8_SA(1, 1), k1, vC[1][0], vC[1][1]);
            if (last) { _Pragma("unroll") for (int h_ = 0; h_ < 2; ++h_) _Pragma("unroll") for (int i_ = 0; i_ < 2; ++i_) vC[h_][i_] = vN[h_][i_]; }
            PG8_WAIT_V(8); PG8_WAIT_L(0); PG8_BAR; PG8_MMA(0, 0, At, B0); PG8_MMA(0, 1, At, B1); PG8_BAR; PG8_SCHED;
            PG8_LDA(At, 0, 1); PG8_STAGE(PG8_SB(0, 0), b2, voffB); PG8_STAGE(PG8_SB(0, 1), b2 + hsB, voffB); PG8_STAGEG(PG8_SA(0, 0), k2, vC[0][0], vC[0][1]);
            PG8_WAIT_V(8); PG8_WAIT_L(0); PG8_BAR; PG8_MMA(1, 0, At, B0); PG8_MMA(1, 1, At, B1); PG8_BAR; PG8_SCHED;
            PG8_LDB(B0, 1, 0); PG8_LDB(B1, 1, 1); PG8_SCHED; PG8_LDA(At, 1, 0); PG8_STAGEG(PG8_SA(0, 1), k2, vC[1][0], vC[1][1]);
            PG8_WAIT_V(8); PG8_WAIT_L(0); PG8_BAR; PG8_MMA(0, 0, At, B0); PG8_MMA(0, 1, At, B1); PG8_BAR; PG8_SCHED;
            PG8_LDA(At, 1, 1); PG8_STAGE(PG8_SB(1, 0), b3, voffB); PG8_STAGE(PG8_SB(1, 1), b3 + hsB, voffB); PG8_STAGEG(PG8_SA(1, 0), k3, vC[0][0], vC[0][1]);
            PG8_WAIT_V(8); PG8_WAIT_L(0); PG8_BAR; PG8_MMA(1, 0, At, B0); PG8_MMA(1, 1, At, B1); PG8_BAR; PG8_SCHED;
        }
        if (wr == 0) PG8_BAR;
        { const int l2_ = fresh_lane(); E(acc, cur, wr, wc, l2_ & 15, l2_ >> 4); }
        if (!has_next) break;
#pragma unroll
        for (int a = 0; a < 2; ++a)
#pragma unroll
            for (int b = 0; b < 2; ++b)
#pragma unroll
                for (int m = 0; m < 4; ++m)
#pragma unroll
                    for (int n = 0; n < 2; ++n) acc[a][b][m][n] = (f32x4){0.f, 0.f, 0.f, 0.f};
        cur = nxt; cB = nB; ++ui;
        if (wr == 1) PG8_BAR;
    }
    PG8_WAIT_V(0);
    PG8_BAR;
#undef PG8_GOFF
#undef PG8_STAGEG
#undef PG8_SA
#undef PG8_SB
#undef PG8_STAGE
#undef PG8_LDA
#undef PG8_LDB
#undef PG8_MMA
#undef PG8_WAIT_V
#undef PG8_WAIT_L
#undef PG8_BAR
#undef PG8_SCHED
}
}

#define XB_TMO      128
#define XB_XCNT(j)  (256  + 64 * (j))
#define XB_XSUB(j)  (1280 + 64 * (j))
#define XB_XGEN(j)  (2304 + 64 * (j))
#define XB_TOP      3328
#define XB_TOPGEN   3392
#define XCD_BAR_WORDS 3456
#define XB_SPIN_CAP (1u << 22)
__device__ __forceinline__ unsigned xb_ld(unsigned* p)              { return __hip_atomic_load(p, __ATOMIC_RELAXED, __HIP_MEMORY_SCOPE_AGENT); }
__device__ __forceinline__ unsigned xb_add(unsigned* p, unsigned v) { return __hip_atomic_fetch_add(p, v, __ATOMIC_RELAXED, __HIP_MEMORY_SCOPE_AGENT); }
__device__ __forceinline__ unsigned xb_xcc_id() { return (unsigned)__builtin_amdgcn_s_getreg((3 << 11) | 20) & 0xFu; }
#define XB_SPIN(cond, bar) do { unsigned _sp = 0; while (cond) { __builtin_amdgcn_s_sleep(1); \
    if ((++_sp & 255u) == 0u) { if (xb_ld(&(bar)[XB_TMO])) break; if (_sp > XB_SPIN_CAP) { atomicAdd(&(bar)[XB_TMO], 1u); break; } } } } while (0)
struct XcdBarrier { unsigned* bar; unsigned x; volatile LAS unsigned* st; };
__device__ __forceinline__ XcdBarrier xcd_barrier_post(unsigned* bar, volatile LAS unsigned* st) {
    XcdBarrier b; b.bar = bar; b.x = xb_xcc_id(); b.st = st;
    if (threadIdx.x == 0) (void)xb_add(&bar[XB_XCNT(b.x)], 1u);
    return b;
}
__device__ __forceinline__ void xcd_barrier_complete(unsigned* bar, unsigned x, unsigned& nloc, unsigned& nx) {
    const unsigned G = gridDim.x * gridDim.y * gridDim.z;
    unsigned sum, cnt, mine, sp = 0u;
    for (;;) {
        sum = 0u; cnt = 0u; mine = 0u;
#pragma unroll
        for (unsigned j = 0; j < 16; ++j) { const unsigned c = xb_ld(&bar[XB_XCNT(j)]); sum += c; cnt += (c > 0u) ? 1u : 0u; mine = (j == x) ? c : mine; }
        if (sum == G) break;
        __builtin_amdgcn_s_sleep(1);
        if ((++sp & 255u) == 0u) { if (xb_ld(&bar[XB_TMO])) break; if (sp > XB_SPIN_CAP) { atomicAdd(&bar[XB_TMO], 1u); break; } }
    }
    nloc = mine > 0u ? mine : 1u; nx = cnt > 0u ? cnt : 1u;
}
__device__ __forceinline__ void xcd_barrier(const XcdBarrier& b) {
    asm volatile("s_waitcnt vmcnt(0)" ::: "memory");
    __syncthreads();
    if (threadIdx.x == 0) {
        unsigned* bar = b.bar;
        __builtin_amdgcn_s_waitcnt(0);
        unsigned nloc = b.st[0], nx = b.st[1];
        if (nloc == 0u) { xcd_barrier_complete(bar, b.x, nloc, nx); b.st[0] = nloc; b.st[1] = nx; }
        const unsigned old = xb_add(&bar[XB_XSUB(b.x)], 1u);
        const unsigned gen = old / nloc;
        if (old + 1u == (gen + 1u) * nloc) {
            __builtin_amdgcn_fence(__ATOMIC_RELEASE, "agent");
            asm volatile("s_waitcnt vmcnt(0)" ::: "memory");
            const unsigned og = xb_add(&bar[XB_TOP], 1u);
            const unsigned tg = og / nx;
            if (og + 1u == (tg + 1u) * nx) xb_add(&bar[XB_TOPGEN], 1u);
            else XB_SPIN(xb_ld(&bar[XB_TOPGEN]) == tg, bar);
            __builtin_amdgcn_fence(__ATOMIC_ACQUIRE, "agent");
            xb_add(&bar[XB_XGEN(b.x)], 1u);
            asm volatile("s_waitcnt vmcnt(0)" ::: "memory");
        } else {
            XB_SPIN(xb_ld(&bar[XB_XGEN(b.x)]) == gen, bar);
            __builtin_amdgcn_fence(__ATOMIC_ACQUIRE, "agent");
            asm volatile("s_waitcnt vmcnt(0)" ::: "memory");
        }
    }
    __syncthreads();
}

typedef const float* cfp_t;
typedef __attribute__((address_space(4))) const cfp_t* KargIn;
struct Frame {
    LAS unsigned char* lds; unsigned char* lds_generic;
    unsigned char* ws;
    unsigned* ctl;
    int tid, lane, wave, G, bid;
    struct KIn { KargIn p; __device__ __forceinline__ const float* operator[](int i) const { return (const float*)(GAS const float*)p[i]; } } in;
    float* out;
};
__device__ __forceinline__ unsigned long long opaque_ptr(unsigned long long w) {
    unsigned lo = (unsigned)w, hi = (unsigned)(w >> 32); asm volatile("" : "+v"(lo), "+v"(hi));
    lo = __builtin_amdgcn_readfirstlane(lo); hi = __builtin_amdgcn_readfirstlane(hi); return ((unsigned long long)hi << 32) | lo;
}
__device__ __forceinline__ Frame fresh(const Frame& F0) {
    Frame F = F0; int t = F0.tid; asm volatile("" : "+v"(t)); F.tid = t; F.lane = t & 63; F.wave = __builtin_amdgcn_readfirstlane(t >> 6);
    F.ws = (unsigned char*)(GAS unsigned char*)opaque_ptr((unsigned long long)F0.ws); F.ctl = (unsigned*)(F.ws + WS_CTL);
    return F;
}
enum { I_X = 0, I_C, I_CTX, I_CCTX, I_ADAW, I_ADAB, I_N1G, I_N2G, I_WIN, I_CONVW, I_CONVB, I_GATEB, I_LBRAW, I_AG, I_BG, I_CG, I_LAM, I_WBR, I_WGATE, I_BGATE, I_WOUT,
       I_RGW, I_RGB, I_REW, I_REB, I_W1, I_W3, I_W2, I_FING };

__device__ __forceinline__ float* ws_mod(const Frame& F, int l, int mi) { return (float*)(F.ws + WS_MOD) + ((size_t)l * 9 + mi) * 6144; }
__device__ __forceinline__ int row_mi(int r) { const int b = r / RPB, s = r - b * RPB; return s < TC ? 8 : b; }

struct TrItem { const float* src; bf16* dst; int ldw, K, n0, kind, par, f8; };
__device__ __forceinline__ int tr_row(const TrItem& T, int n) {
    if (T.kind == 0) return n + T.par;
    if (T.kind == 1) return 256 * (n >> 6) + 128 * (T.par >> 1) + 32 * ((n >> 4) & 3) + 8 * ((n >> 2) & 3) + 4 * (T.par & 1) + (n & 3);
    return 256 * (n >> 7) + 128 * T.par + (n & 127);
}
__device__ __forceinline__ void tr_load(const TrItem& T, int lane, f32x4 (&v)[8]) {
#pragma unroll
    for (int i = 0; i < 8; ++i) v[i] = __builtin_nontemporal_load((const f32x4*)(T.src + (size_t)(8 * i + (lane >> 3)) * T.ldw + 4 * (lane & 7)));
}
__device__ __forceinline__ void tr_finish(const TrItem& T, int lane, const f32x4 (&v)[8], LAS float* scr) {
#pragma unroll
    for (int i = 0; i < 8; ++i) { LAS float* s = scr + (8 * i + (lane >> 3)) * 33 + 4 * (lane & 7); s[0] = v[i].x; s[1] = v[i].y; s[2] = v[i].z; s[3] = v[i].w; }
    LDS_WAIT(); asm volatile("" ::: "memory");
    const int c = lane & 7;
#pragma unroll
    for (int j = 0; j < 4; ++j) { const int n = (lane >> 3) + 8 * j; const LAS float* s = scr + (8 * c) * 33 + n;
        if (T.f8) {
            u32x2 o; o.x = pk_fp8x4(F8_SW * s[0 * 33], F8_SW * s[1 * 33], F8_SW * s[2 * 33], F8_SW * s[3 * 33]); o.y = pk_fp8x4(F8_SW * s[4 * 33], F8_SW * s[5 * 33], F8_SW * s[6 * 33], F8_SW * s[7 * 33]);
            *(u32x2*)((unsigned char*)T.dst + (size_t)tr_row(T, T.n0 + n) * T.K + 8 * c) = o;
        } else {
        u32x4 o; o.x = cvt_pk_bf16(s[0 * 33], s[1 * 33]); o.y = cvt_pk_bf16(s[2 * 33], s[3 * 33]); o.z = cvt_pk_bf16(s[4 * 33], s[5 * 33]); o.w = cvt_pk_bf16(s[6 * 33], s[7 * 33]);
        *(u32x4*)(T.dst + (size_t)tr_row(T, T.n0 + n) * T.K + 8 * c) = o; } }
    LDS_WAIT(); asm volatile("" ::: "memory");
}
struct RmGate { int br; __device__ int operator()(int o) const { return 256 * (o >> 6) + 128 * (br >> 1) + 32 * ((o >> 4) & 3) + 8 * ((o >> 2) & 3) + 4 * (br & 1) + (o & 3); } };

constexpr int CI_IN1 = 16 * 144, CI_IN2 = 16 * 48, CI_G = 16 * 96, CI_BR1 = 8 * 32, CI_O = 16 * 32, CI_E13 = 16 * 16, CI_E2 = 8 * 32;
constexpr int CI_N = CI_IN1 + CI_IN2 + CI_G + 3 * CI_BR1 + CI_O + NEXP * (2 * CI_E13 + CI_E2);
__device__ __forceinline__ TrItem tr_decode(const Frame& F, int l, int it) {
    bf16* Wb = (bf16*)(F.ws + WS_W); TrItem T; T.f8 = 0; int r = it;
    if (r < CI_IN1) { const int kb = r / 144, n0 = 32 * (r % 144); T.ldw = WIN_N; T.K = 1024; T.src = F.in[I_WIN] + (size_t)l * 1024 * WIN_N + (size_t)64 * kb * WIN_N + n0; T.dst = Wb + W_IN / 2 + 64 * kb; T.n0 = n0; T.kind = 0; T.par = 0; return T; } r -= CI_IN1;
    if (r < CI_IN2) { const int kb = r / 48, n0 = 32 * (r % 48); T.ldw = WIN_N; T.K = 1024; T.src = F.in[I_WIN] + (size_t)l * 1024 * WIN_N + 4624 + (size_t)64 * kb * WIN_N + n0; T.dst = Wb + W_IN / 2 + 64 * kb; T.n0 = n0; T.kind = 0; T.par = 4608; return T; } r -= CI_IN2;
    if (r < CI_G) { const int kb = r / 96, nb = r % 96, br = nb / 32, n0 = 32 * (nb % 32); T.ldw = 3072; T.K = 1024; T.src = F.in[I_WGATE] + (size_t)l * 1024 * 3072 + br * 1024 + (size_t)64 * kb * 3072 + n0; T.dst = Wb + W_GP / 2 + 64 * kb; T.n0 = n0; T.kind = 1; T.par = br;
        if ((F8GT >> l) & 1) { T.f8 = 1; T.dst = (bf16*)((unsigned char*)(Wb + W_GP / 2) + 64 * kb); } return T; } r -= CI_G;
    if (r < 3 * CI_BR1) { const int br = r / CI_BR1, q = r % CI_BR1, kb = q / 32, n0 = 32 * (q % 32); T.ldw = 1024; T.K = 512; T.src = F.in[I_WBR] + (size_t)l * 3 * 512 * 1024 + (size_t)br * 512 * 1024 + (size_t)64 * kb * 1024 + n0; T.dst = Wb + W_BR / 2 + (size_t)br * 1024 * 512 + 64 * kb; T.n0 = n0; T.kind = 0; T.par = 0;
        if ((F8BR >> l) & 1) { T.f8 = 1; T.dst = (bf16*)((unsigned char*)(Wb + W_BR / 2) + (size_t)br * 1024 * 512 + 64 * kb); } return T; } r -= 3 * CI_BR1;
    if (r < CI_O) { const int kb = r / 32, n0 = 32 * (r % 32); T.ldw = 1024; T.K = 1024; T.src = F.in[I_WOUT] + (size_t)l * 1024 * 1024 + (size_t)64 * kb * 1024 + n0; T.dst = Wb + W_OUT / 2 + 64 * kb; T.n0 = n0; T.kind = 0; T.par = 0; return T; } r -= CI_O;
    const int e = r / (2 * CI_E13 + CI_E2); int q = r % (2 * CI_E13 + CI_E2);
    if (q < 2 * CI_E13) { const int which = q / CI_E13; q %= CI_E13; const int kb = q / 16, n0 = 32 * (q % 16); T.ldw = 512; T.K = 1024;
        T.src = F.in[which ? I_W3 : I_W1] + (size_t)l * NEXP * 1024 * 512 + (size_t)e * 1024 * 512 + (size_t)64 * kb * 512 + n0; T.dst = Wb + W_13 / 2 + (size_t)e * 1024 * 1024 + 64 * kb; T.n0 = n0; T.kind = 2; T.par = which;
        if ((F8MOE >> l) & 1) { T.f8 = 1; T.dst = (bf16*)((unsigned char*)(Wb + W_13 / 2) + (size_t)e * 1024 * 1024 + 64 * kb); } return T; }
    q -= 2 * CI_E13; { const int kb = q / 32, n0 = 32 * (q % 32); T.ldw = 1024; T.K = 512; T.src = F.in[I_W2] + (size_t)l * NEXP * 512 * 1024 + (size_t)e * 512 * 1024 + (size_t)64 * kb * 1024 + n0; T.dst = Wb + W_2 / 2 + (size_t)e * 1024 * 512 + 64 * kb; T.n0 = n0; T.kind = 0; T.par = 0;
        if ((F8MOE >> l) & 1) { T.f8 = 1; T.dst = (bf16*)((unsigned char*)(Wb + W_2 / 2) + (size_t)e * 1024 * 512 + 64 * kb); } return T; }
}
__device__ __forceinline__ void phase_convert(Frame& F, int l) {
    LAS float* scr = (LAS float*)(F.lds + F.wave * 8448);
    const int gw = F.bid * NWAVES + F.wave, NGW = F.G * NWAVES;
    bf16* Wb = (bf16*)(F.ws + WS_W);
    int it = gw; TrItem T0, T1; f32x4 v0[8], v1[8];
    T0 = tr_decode(F, l, it < CI_N ? it : 0); T1 = T0;
    if (it < CI_N) tr_load(T0, F.lane, v0);
    if (it + NGW < CI_N) { T1 = tr_decode(F, l, it + NGW); tr_load(T1, F.lane, v1); }
    while (it < CI_N) {
        const int it2 = it + 2 * NGW; TrItem T2 = T0; f32x4 v2[8];
        if (it2 < CI_N) { T2 = tr_decode(F, l, it2); tr_load(T2, F.lane, v2); }
        tr_finish(T0, F.lane, v0, scr);
        T0 = T1; T1 = T2; it += NGW;
#pragma unroll
        for (int i = 0; i < 8; ++i) { v0[i] = v1[i]; v1[i] = v2[i]; }
    }
    {
        bf16* wrt = (bf16*)(F.ws + WS_WRT); const float* rgw = F.in[I_RGW] + (size_t)l * 1024 * 4; const float* rew = F.in[I_REW] + (size_t)l * 1024 * 32;
        for (int i = F.bid * NTHR + F.tid; i < 48 * 1024; i += F.G * NTHR) { const int n = i >> 10, k = i & 1023;
            const float wv = n < 4 ? rgw[k * 4 + n] : n < 36 ? rew[k * 32 + (n - 4)] : 0.f; const bf16 hi = f2bf(wv); wrt[i] = hi; wrt[48 * 1024 + i] = f2bf(wv - bf2f(hi)); }
    }
    for (int i = gw; i < 1024; i += NGW) {
        const int row = RmGate{3}(i);
        if ((F8GT >> l) & 1) { u32x4* p = (u32x4*)((unsigned char*)(Wb + W_GP / 2) + (size_t)row * 1024) + F.lane; p[0] = (u32x4){0, 0, 0, 0}; }
        else { u32x4* p = (u32x4*)(Wb + W_GP / 2 + (size_t)row * 1024) + F.lane; p[0] = (u32x4){0, 0, 0, 0}; p[64] = (u32x4){0, 0, 0, 0}; }
    }
}

__device__ __forceinline__ void phase_init(Frame& F) {
    const int gw = F.bid * NWAVES + F.wave, NGW = F.G * NWAVES;
    float* X = (float*)(F.ws + WS_X);
#ifdef DBG_IDENT
    for (int r = gw; r < M; r += NGW) {
        const int b = r / RPB, s = r - b * RPB;
        const float* src = s < TC ? F.in[I_CTX] + ((size_t)b * TC + s) * D : F.in[I_X] + ((size_t)b * TL + (s - TC)) * D;
        const f32x4* sp = (const f32x4*)src + F.lane; f32x4* dp = (f32x4*)(X + (size_t)r * D) + F.lane;
#pragma unroll
        for (int j = 0; j < 4; ++j) dp[64 * j] = sp[64 * j];
    }
#endif
    (void)X; (void)gw; (void)NGW;
#ifdef DBG_ZERO_R2
    { u32x4* z = (u32x4*)(F.ws + WS_R2); const size_t n16 = (108 * MiB) / 16;
      for (size_t i = (size_t)F.bid * NTHR + F.tid; i < n16; i += (size_t)F.G * NTHR) z[i] = (u32x4){0, 0, 0, 0}; }
#endif
    if (F.bid == F.G - 1) {
        float* rt = (float*)(F.ws + WS_ROPE);
        for (int i = F.tid; i < 64 * 16; i += NTHR) { const int pos = i >> 4, p = i & 15;
            const float inv = powf(10000.f, -(float)p / 16.f); const float ang = (float)pos * inv; rt[2 * i] = cosf(ang); rt[2 * i + 1] = sinf(ang); }
    }
    LAS float* sc = (LAS float*)(F.lds);
    LAS float* red = (LAS float*)(F.lds + 40960);
    if (F.bid < 192) {
        for (int i = F.tid; i < 9 * 1024; i += NTHR) { const int mi = i >> 10, k = i & 1023; const float v = mi < 8 ? F.in[I_C][mi * 1024 + k] : F.in[I_CCTX][k]; sc[i] = siluf_(v); }
        __syncthreads();
        const int it = F.bid, l = it / 96, n0 = (it % 96) * 64;
        const float* aw = F.in[I_ADAW] + (size_t)l * 1024 * 6144 + n0 + F.lane;
        float acc[9];
#pragma unroll
        for (int m = 0; m < 9; ++m) acc[m] = 0.f;
        const int kb = F.wave * 128;
#pragma unroll 8
        for (int k = 0; k < 128; ++k) { const float w = aw[(size_t)(kb + k) * 6144];
#pragma unroll
            for (int m = 0; m < 9; ++m) acc[m] += sc[m * 1024 + kb + k] * w; }
#pragma unroll
        for (int m = 0; m < 9; ++m) red[(F.wave * 9 + m) * 64 + F.lane] = acc[m];
        __syncthreads();
        for (int i = F.tid; i < 9 * 64; i += NTHR) { const int m = i >> 6, n = i & 63; float s = 0.f;
#pragma unroll
            for (int w = 0; w < 8; ++w) s += red[(w * 9 + m) * 64 + n];
            ws_mod(F, l, m)[n0 + n] = s + F.in[I_ADAB][l * 6144 + n0 + n]; }
        __syncthreads();
    }
}

__device__ __forceinline__ void stage_gate_w(Frame& F, int l) {
    LAS float* gw_ = (LAS float*)F.lds;
    const float* win = F.in[I_WIN] + (size_t)l * 1024 * WIN_N + WIN_GATE0;
    for (int i = F.tid; i < 1024 * 4; i += NTHR) { const int k = i >> 2, q = i & 3; *(LAS f32x4*)(gw_ + k * 16 + (k >> 2) * 4 + q * 4) = *(const f32x4*)(win + (size_t)k * WIN_N + q * 4); }
    __syncthreads();
}
__device__ __forceinline__ void norm1_row(Frame& F, int l, int r, const f32x4 (&xv)[4], const f32x4 (&gv)[4], const f32x4 (&shv)[4], const f32x4 (&scvv)[4], float gateb) {
    float ss = 0.f;
#pragma unroll
    for (int j = 0; j < 4; ++j) ss += (xv[j].x * xv[j].x + xv[j].y * xv[j].y) + (xv[j].z * xv[j].z + xv[j].w * xv[j].w);
    const float rstd = rsqrtf(wave_sum(ss) * (1.f / D) + EPS);
    LAS float* gw_ = (LAS float*)F.lds;
    bf16* H = (bf16*)(F.ws + WS_H);
    float ga[16];
#pragma unroll
    for (int q = 0; q < 16; ++q) ga[q] = 0.f;
#pragma unroll
    for (int j = 0; j < 4; ++j) {
        const int c0 = 4 * F.lane + 256 * j;
        const f32x4 g = gv[j], sh = shv[j], scv = scvv[j];
        f32x4 h; h.x = xv[j].x * rstd * g.x * (1.f + scv.x) + sh.x; h.y = xv[j].y * rstd * g.y * (1.f + scv.y) + sh.y;
        h.z = xv[j].z * rstd * g.z * (1.f + scv.z) + sh.z; h.w = xv[j].w * rstd * g.w * (1.f + scv.w) + sh.w;
        u32x2 o; o.x = cvt_pk_bf16(h.x, h.y); o.y = cvt_pk_bf16(h.z, h.w);
        *(u32x2*)(H + (size_t)r * D + c0) = o;
        if ((F8GT >> l) & 1) *(unsigned*)(F.ws + WS_HG8 + (size_t)r * D + c0) = pk_fp8x4(F8_SH * h.x, F8_SH * h.y, F8_SH * h.z, F8_SH * h.w);
#pragma unroll
        for (int e = 0; e < 4; ++e) { const float hv = h[e];
#pragma unroll
            for (int q4 = 0; q4 < 4; ++q4) { const f32x4 w = *(const LAS f32x4*)(gw_ + (c0 + e) * 16 + (c0 >> 2) * 4 + q4 * 4);
                ga[q4 * 4 + 0] += hv * w.x; ga[q4 * 4 + 1] += hv * w.y; ga[q4 * 4 + 2] += hv * w.z; ga[q4 * 4 + 3] += hv * w.w; } }
    }
#pragma unroll
    for (int q = 0; q < 16; ++q) ga[q] = wave_sum(ga[q]);
    float mine = 0.f;
#pragma unroll
    for (int q = 0; q < 16; ++q) mine = (F.lane == q) ? ga[q] : mine;
    if (F.lane < 16) { float v = mine + gateb; if (F.lane >= 8) v = log_sigmoidf_(v); ((float*)(F.ws + WS_GATES))[(size_t)r * 16 + F.lane] = v; }
}
__device__ __forceinline__ void phase_norm1(Frame& F, int l) {
    stage_gate_w(F, l);
    const int gw = F.bid * NWAVES + F.wave, NGW = F.G * NWAVES, lane = F.lane;
    f32x4 gv[4];
#pragma unroll
    for (int j = 0; j < 4; ++j) gv[j] = *(const f32x4*)(F.in[I_N1G] + l * 1024 + 4 * lane + 256 * j);
    const float gateb = F.in[I_GATEB][l * 16 + (lane & 15)];
#define N1_SRC(r_) ((((r_) % RPB) < TC) ? F.in[I_CTX] + ((size_t)((r_) / RPB) * TC + ((r_) % RPB)) * D : F.in[I_X] + ((size_t)((r_) / RPB) * TL + (((r_) % RPB) - TC)) * D)
    f32x4 xn[4];
    { const f32x4* xp = (const f32x4*)N1_SRC(gw) + lane;
#pragma unroll
      for (int j = 0; j < 4; ++j) xn[j] = xp[64 * j]; }
    for (int r = gw; r < M; r += NGW) {
        f32x4 xv[4], shv[4], scvv[4];
#pragma unroll
        for (int j = 0; j < 4; ++j) xv[j] = xn[j];
        const float* mod = ws_mod(F, l, row_mi(r));
#pragma unroll
        for (int j = 0; j < 4; ++j) { shv[j] = *(const f32x4*)(mod + 4 * lane + 256 * j); scvv[j] = *(const f32x4*)(mod + 1024 + 4 * lane + 256 * j); }
        if (r + NGW < M) { const f32x4* xp = (const f32x4*)N1_SRC(r + NGW) + lane;
#pragma unroll
            for (int j = 0; j < 4; ++j) xn[j] = xp[64 * j]; }
        norm1_row(F, l, r, xv, gv, shv, scvv, gateb);
    }
#undef N1_SRC
    __syncthreads();
}

struct EpiPlain {
    bf16* O; int ldc, coff, zoff;
    __device__ __forceinline__ void operator()(const f32x4 (&acc)[2][2][4][2], const pg8::Unit& u, int wr, int wc, int fr, int fq) const {
        const int row0 = u.pm * 256 + wr * 64 + fr, col0 = coff + u.z * zoff + u.pn * 256 + wc * 32 + 8 * fq;
#pragma unroll
        for (int ai = 0; ai < 2; ++ai)
#pragma unroll
            for (int m = 0; m < 4; ++m) { bf16* rowp = O + (size_t)(row0 + ai * 128 + m * 16) * ldc + col0;
#pragma unroll
                for (int bj = 0; bj < 2; ++bj) { const f32x4 v0 = acc[ai][bj][m][0], v1 = acc[ai][bj][m][1];
                    u32x4 w; w.x = cvt_pk_bf16(v0[0], v0[1]); w.y = cvt_pk_bf16(v0[2], v0[3]); w.z = cvt_pk_bf16(v1[0], v1[1]); w.w = cvt_pk_bf16(v1[2], v1[3]);
                    *(u32x4*)(rowp + bj * 128) = w; } }
    }
};
struct EpiPlainS {
    bf16* O; int ldc, coff, zoff; float sc;
    __device__ __forceinline__ void operator()(const f32x4 (&acc)[2][2][4][2], const pg8::Unit& u, int wr, int wc, int fr, int fq) const {
        const int row0 = u.pm * 256 + wr * 64 + fr, col0 = coff + u.z * zoff + u.pn * 256 + wc * 32 + 8 * fq;
#pragma unroll
        for (int ai = 0; ai < 2; ++ai)
#pragma unroll
            for (int m = 0; m < 4; ++m) { bf16* rowp = O + (size_t)(row0 + ai * 128 + m * 16) * ldc + col0;
#pragma unroll
                for (int bj = 0; bj < 2; ++bj) { const f32x4 v0 = acc[ai][bj][m][0] * sc, v1 = acc[ai][bj][m][1] * sc;
                    u32x4 w; w.x = cvt_pk_bf16(v0[0], v0[1]); w.y = cvt_pk_bf16(v0[2], v0[3]); w.z = cvt_pk_bf16(v1[0], v1[1]); w.w = cvt_pk_bf16(v1[2], v1[3]);
                    *(u32x4*)(rowp + bj * 128) = w; } }
    }
};
struct EpiScaled {
    bf16* O; int ldc; float sc;
    __device__ __forceinline__ void operator()(const f32x4 (&acc)[2][2][4][2], const pg8::Unit& u, int wr, int wc, int fr, int fq) const {
        const int row0 = u.pm * 256 + wr * 64 + fr, col0 = u.pn * 256 + wc * 32 + 8 * fq;
#pragma unroll
        for (int ai = 0; ai < 2; ++ai)
#pragma unroll
            for (int m = 0; m < 4; ++m) { bf16* rowp = O + (size_t)(row0 + ai * 128 + m * 16) * ldc + col0;
#pragma unroll
                for (int bj = 0; bj < 2; ++bj) { const f32x4 v0 = acc[ai][bj][m][0] * sc, v1 = acc[ai][bj][m][1] * sc;
                    u32x4 w; w.x = cvt_pk_bf16(v0[0], v0[1]); w.y = cvt_pk_bf16(v0[2], v0[3]); w.z = cvt_pk_bf16(v1[0], v1[1]); w.w = cvt_pk_bf16(v1[2], v1[3]);
                    *(u32x4*)(rowp + bj * 128) = w; } }
    }
};
struct EpiInProj {
    bf16* P; const float* rope;
    __device__ __forceinline__ void operator()(const f32x4 (&acc)[2][2][4][2], const pg8::Unit& u, int wr, int wc, int fr, int fq) const {
        const int pn = u.pn;
        const int mode = (pn == 4 || pn == 5) ? 1 : (pn == 16 || pn == 17) ? 2 : (pn >= 18 && pn < 22 && (u.pm % 9) != 0) ? 3 : 0;
        const int row0 = u.pm * 256 + wr * 64 + fr, col0 = pn * 256 + wc * 32 + 8 * fq;
#pragma unroll
        for (int ai = 0; ai < 2; ++ai)
#pragma unroll
            for (int m = 0; m < 4; ++m) { const int row = row0 + ai * 128 + m * 16; bf16* rowp = P + (size_t)row * NP + col0;
                f32x4 cs[4];
                if (mode == 3) { const int s = row % RPB - TC; const int pos = (wc & 1) ? (s & 63) : (s >> 6);
                    const f32x4* tp = (const f32x4*)(rope + (pos * 16 + 8 * (fq & 1)) * 2);
                    cs[0] = tp[0]; cs[1] = tp[1]; cs[2] = tp[2]; cs[3] = tp[3]; }
#pragma unroll
                for (int bj = 0; bj < 2; ++bj) { f32x4 v0 = acc[ai][bj][m][0], v1 = acc[ai][bj][m][1];
                    if (mode == 1) {
#pragma unroll
                        for (int e = 0; e < 4; ++e) { v0[e] = siluf_(v0[e]); v1[e] = siluf_(v1[e]); } }
                    else if (mode == 2) {
#pragma unroll
                        for (int e = 0; e < 4; ++e) { v0[e] = sigmoidf_(v0[e]); v1[e] = sigmoidf_(v1[e]); } }
                    else if (mode == 3) {
                        f32x4 p0, p1;
#pragma unroll
                        for (int e = 0; e < 4; ++e) { auto ra = __builtin_amdgcn_permlane32_swap(__float_as_uint(v0[e]), __float_as_uint(v0[e]), false, false); auto rb = __builtin_amdgcn_permlane32_swap(__float_as_uint(v1[e]), __float_as_uint(v1[e]), false, false);
                            p0[e] = __uint_as_float(fq < 2 ? ra[1] : ra[0]); p1[e] = __uint_as_float(fq < 2 ? rb[1] : rb[0]); }
                        const float sg = (fq < 2) ? -1.f : 1.f;
                        f32x4 r0, r1;
                        r0[0] = v0[0] * cs[0][0] + sg * p0[0] * cs[0][1]; r0[1] = v0[1] * cs[0][2] + sg * p0[1] * cs[0][3];
                        r0[2] = v0[2] * cs[1][0] + sg * p0[2] * cs[1][1]; r0[3] = v0[3] * cs[1][2] + sg * p0[3] * cs[1][3];
                        r1[0] = v1[0] * cs[2][0] + sg * p1[0] * cs[2][1]; r1[1] = v1[1] * cs[2][2] + sg * p1[1] * cs[2][3];
                        r1[2] = v1[2] * cs[3][0] + sg * p1[2] * cs[3][1]; r1[3] = v1[3] * cs[3][2] + sg * p1[3] * cs[3][3];
                        v0 = r0; v1 = r1; }
                    u32x4 w; w.x = cvt_pk_bf16(v0[0], v0[1]); w.y = cvt_pk_bf16(v0[2], v0[3]); w.z = cvt_pk_bf16(v1[0], v1[1]); w.w = cvt_pk_bf16(v1[2], v1[3]);
                    *(u32x4*)(rowp + bj * 128) = w; } }
    }
};
template <bool F8> struct EpiGates {
    const bf16* U; bf16* YB; const float* bgate;
    __device__ __forceinline__ void operator()(const f32x4 (&acc)[2][2][4][2], const pg8::Unit& u, int wr, int wc, int fr, int fq) const {
        const int row0 = u.pm * 256 + wr * 64 + fr, o0 = 64 * u.pn + 16 * wc + 4 * fq;
        const f32x4 b0 = *(const f32x4*)(bgate + o0), b1 = *(const f32x4*)(bgate + 1024 + o0), b2 = *(const f32x4*)(bgate + 2048 + o0);
#pragma unroll
        for (int ai = 0; ai < 2; ++ai)
#pragma unroll
            for (int m = 0; m < 4; ++m) { const int row = row0 + ai * 128 + m * 16; const bf16* up = U + (size_t)row * 3072 + o0;
                const u32x2 u0 = *(const u32x2*)(up), u1 = *(const u32x2*)(up + 1024), u2 = *(const u32x2*)(up + 2048);
                constexpr float gsc = F8 ? 1.f / (F8_SH * F8_SW) : 1.f;
                const f32x4 g0 = acc[ai][0][m][0] * gsc, g1 = acc[ai][0][m][1] * gsc, g2 = acc[ai][1][m][0] * gsc;
                float y[4];
                y[0] = sigmoidf_(g0[0] + b0[0]) * bflo(u0.x) + sigmoidf_(g1[0] + b1[0]) * bflo(u1.x) + sigmoidf_(g2[0] + b2[0]) * bflo(u2.x);
                y[1] = sigmoidf_(g0[1] + b0[1]) * bfhi(u0.x) + sigmoidf_(g1[1] + b1[1]) * bfhi(u1.x) + sigmoidf_(g2[1] + b2[1]) * bfhi(u2.x);
                y[2] = sigmoidf_(g0[2] + b0[2]) * bflo(u0.y) + sigmoidf_(g1[2] + b1[2]) * bflo(u1.y) + sigmoidf_(g2[2] + b2[2]) * bflo(u2.y);
                y[3] = sigmoidf_(g0[3] + b0[3]) * bfhi(u0.y) + sigmoidf_(g1[3] + b1[3]) * bfhi(u1.y) + sigmoidf_(g2[3] + b2[3]) * bfhi(u2.y);
                u32x2 w; w.x = cvt_pk_bf16(y[0], y[1]); w.y = cvt_pk_bf16(y[2], y[3]);
                *(u32x2*)(YB + (size_t)row * 1024 + o0) = w; }
    }
};
struct EpiOut {
    float* X; const float* modl; const float* xin; const float* cin;
    __device__ __forceinline__ void operator()(const f32x4 (&acc)[2][2][4][2], const pg8::Unit& u, int wr, int wc, int fr, int fq) const {
        const int row0 = u.pm * 256 + wr * 64 + fr, col0 = u.pn * 256 + wc * 32 + 8 * fq;
        const int mi = (u.pm % 9) == 0 ? 8 : u.pm / 9;
        const float* gp = modl + (size_t)mi * 6144 + 2048 + col0;
        f32x4 g[2][2];
#pragma unroll
        for (int bj = 0; bj < 2; ++bj) { g[bj][0] = *(const f32x4*)(gp + bj * 128); g[bj][1] = *(const f32x4*)(gp + bj * 128 + 4); }
#pragma unroll
        for (int ai = 0; ai < 2; ++ai)
#pragma unroll
            for (int m = 0; m < 4; ++m) { const int row = row0 + ai * 128 + m * 16; float* rowp = X + (size_t)row * D + col0;
                const float* srcp = rowp;
                if (xin) { const int b = u.pm / 9, sq = row - b * RPB; srcp = (mi == 8 ? cin + ((size_t)b * TC + sq) * D : xin + ((size_t)b * TL + (sq - TC)) * D) + col0; }
#pragma unroll
                for (int bj = 0; bj < 2; ++bj) { f32x4* xp = (f32x4*)(rowp + bj * 128); const f32x4* sp = (const f32x4*)(srcp + bj * 128); f32x4 x0 = sp[0], x1 = sp[1];
                    x0 = x0 + g[bj][0] * acc[ai][bj][m][0]; x1 = x1 + g[bj][1] * acc[ai][bj][m][1]; xp[0] = x0; xp[1] = x1; } }
    }
};
template <bool F8> struct EpiMoe1 {
    bf16* UM;
    __device__ __forceinline__ void operator()(const f32x4 (&acc)[2][2][4][2], const pg8::Unit& u, int wr, int wc, int fr, int fq) const {
        const int row0 = u.pm * 256 + wr * 64 + fr, col0 = u.pn * 128 + wc * 32 + 8 * fq;
#pragma unroll
        for (int ai = 0; ai < 2; ++ai)
#pragma unroll
            for (int m = 0; m < 4; ++m) { const size_t eoff = (size_t)(row0 + ai * 128 + m * 16) * DEXP + col0;
                float y[8];
                if constexpr (F8) { constexpr float inv = 1.f / (F8_SH * F8_SW), osc = F8_SU * inv;
#pragma unroll
                    for (int n = 0; n < 2; ++n)
#pragma unroll
                        for (int e = 0; e < 4; ++e) y[4 * n + e] = siluf_(acc[ai][0][m][n][e] * inv) * (acc[ai][1][m][n][e] * osc);
                    u32x2 w; w.x = pk_fp8x4(y[0], y[1], y[2], y[3]); w.y = pk_fp8x4(y[4], y[5], y[6], y[7]);
                    *(u32x2*)((unsigned char*)UM + eoff) = w;
                } else {
#pragma unroll
                for (int n = 0; n < 2; ++n)
#pragma unroll
                    for (int e = 0; e < 4; ++e) y[4 * n + e] = siluf_(acc[ai][0][m][n][e]) * acc[ai][1][m][n][e];
                u32x4 w; w.x = cvt_pk_bf16(y[0], y[1]); w.y = cvt_pk_bf16(y[2], y[3]); w.z = cvt_pk_bf16(y[4], y[5]); w.w = cvt_pk_bf16(y[6], y[7]);
                *(u32x4*)(UM + eoff) = w; } }
    }
};
struct GroupedOrder {
    const volatile LAS int* tile_e; const volatile LAS int* tpre; const volatile LAS int* ecnt; const int* rowof; int ntiles, G, c; size_t estride;
    __device__ bool next(int i, pg8::Unit& u) const {
        const long L = (long)i * G + c; if (L >= (long)ntiles * 4) return false;
        const int t = (int)(L >> 2), e = tile_e[t], ti = t - tpre[e]; u.pm = t; u.pn = (int)(L & 3); u.z = 0; u.aoff = 0; u.boff = (size_t)e * estride;
        u.rl = rowof + (size_t)e * ECAP + ti * 256; u.rn = ecnt[e] - ti * 256; return true;
    }
};

namespace att {
constexpr int NW = 8, QBLK = 32, KVBLK = 64;
constexpr float SCALE = 0.125f, THR = 8.f;
constexpr int SHM_V = KVBLK * 128 * 2, SHM_K = KVBLK * 64 * 2, SHM_ATTN = 2 * SHM_V + 2 * SHM_K + NW * 64 * 4;
#define KSWZ64(row, colB) ((row) * 128 + ((colB) ^ ((((row) >> 1) & 7) << 4)))
#define SBAR() __builtin_amdgcn_sched_barrier(0)
__device__ __forceinline__ int crow(int r, int hi) { return (r & 3) + 8 * (r >> 2) + 4 * hi; }
__device__ __forceinline__ unsigned cvtpk(float lo, float hi) { unsigned r; asm volatile("v_cvt_pk_bf16_f32 %0, %1, %2" : "=v"(r) : "v"(lo), "v"(hi)); return r; }
__device__ __forceinline__ void partialSM(f32x16& p0, f32x16& p1, float& m_reg, float& mn, float& alpha) {
  constexpr float C = SCALE * 1.4426950408889634f;
  float pmax = p0[0];
#pragma unroll
  for (int r = 1; r < 16; ++r) pmax = fmaxf(pmax, p0[r]);
#pragma unroll
  for (int r = 0; r < 16; ++r) pmax = fmaxf(pmax, p1[r]);
  { auto rr = __builtin_amdgcn_permlane32_swap(__float_as_uint(pmax), __float_as_uint(pmax), false, false);
    pmax = fmaxf(__uint_as_float(rr[0]), __uint_as_float(rr[1])); }
  if (__builtin_expect(__all(pmax - m_reg <= THR / SCALE), 1)) { mn = m_reg; alpha = 1.f; }
  else { mn = fmaxf(m_reg, pmax); alpha = __builtin_amdgcn_exp2f((m_reg - mn) * C); m_reg = mn; }
  float mnC = -mn * C;
#pragma unroll
  for (int r = 0; r < 16; ++r) p0[r] = fmaf(p0[r], C, mnC);
#pragma unroll
  for (int r = 0; r < 16; ++r) p1[r] = fmaf(p1[r], C, mnC);
#pragma unroll
  for (int r = 0; r < 16; ++r) p0[r] = __builtin_amdgcn_exp2f(p0[r]);
}
__device__ __forceinline__ void finishSM(f32x16& p0, f32x16& p1, float alpha, float& l_reg, bf16x8& pa0, bf16x8& pa1, bf16x8& pa2, bf16x8& pa3) {
#pragma unroll
  for (int r = 0; r < 16; ++r) p1[r] = __builtin_amdgcn_exp2f(p1[r]);
  float ps = 0;
#pragma unroll
  for (int r = 0; r < 16; ++r) ps += p0[r];
#pragma unroll
  for (int r = 0; r < 16; ++r) ps += p1[r];
  { auto rr = __builtin_amdgcn_permlane32_swap(__float_as_uint(ps), __float_as_uint(ps), false, false);
    ps = __uint_as_float(rr[0]) + __uint_as_float(rr[1]); }
  l_reg = l_reg * alpha + ps;
#define PK4(P, BASE, OUT) do { unsigned a0 = cvtpk(P[BASE + 0], P[BASE + 1]), a1 = cvtpk(P[BASE + 2], P[BASE + 3]);   \
    unsigned b0 = cvtpk(P[BASE + 4], P[BASE + 5]), b1 = cvtpk(P[BASE + 6], P[BASE + 7]);                              \
    auto r0 = __builtin_amdgcn_permlane32_swap(a0, b0, false, false); auto r1 = __builtin_amdgcn_permlane32_swap(a1, b1, false, false); \
    u32x4 w = {r0[0], r1[0], r0[1], r1[1]}; OUT = *reinterpret_cast<bf16x8*>(&w); } while (0)
  PK4(p0, 0, pa0); PK4(p0, 8, pa1); PK4(p1, 0, pa2); PK4(p1, 8, pa3);
#undef PK4
}
__device__ __forceinline__ void qkt(f32x16& p0, f32x16& p1, const char* Ks, const bf16x8* qr, int r32, int hi) {
  p0 = f32x16{}; p1 = f32x16{};
#pragma unroll
  for (int d0 = 0; d0 < 4; ++d0) { int cb = (d0 * 16 + hi * 8) * 2;
    bf16x8 b0 = *reinterpret_cast<const bf16x8*>(Ks + KSWZ64(r32, cb));
    bf16x8 b1 = *reinterpret_cast<const bf16x8*>(Ks + KSWZ64(32 + r32, cb));
    p0 = __builtin_amdgcn_mfma_f32_32x32x16_bf16(b0, qr[d0], p0, 0, 0, 0);
    p1 = __builtin_amdgcn_mfma_f32_32x32x16_bf16(b1, qr[d0], p1, 0, 0, 0); }
}
__device__ __forceinline__ int v_st(int k, int c) { const int kk = (k & ~0xC) | ((k & 4) << 1) | ((k & 8) >> 1); return ((kk >> 3) * 4 + (c >> 5)) * 512 + ((kk & 7) * 32 + (c & 31)) * 2; }
__device__ __forceinline__ int v_rd_base(int lane) { return ((lane & 3) << 3) | (((lane >> 2) & 3) << 6) | (((lane >> 4) & 1) << 5) | (((lane >> 5) & 1) << 8); }
constexpr int v_rd_off(int d0, int ks, int half) { return d0 * 512 + ks * 4096 + half * 2048; }
template <int OFF> __device__ __forceinline__ s16x4 tr_read(int vb) {
  s16x4 r; asm volatile("ds_read_b64_tr_b16 %0, %1 offset:%2" : "=&v"(r) : "v"(vb), "i"(OFF) : "memory"); return r;
}
template <int D0> __device__ __forceinline__ void pv_one(f32x16& od, int vb, bf16x8 pa0, bf16x8 pa1, bf16x8 pa2, bf16x8 pa3) {
  const s16x4 l0 = tr_read<v_rd_off(D0, 0, 0)>(vb), h0 = tr_read<v_rd_off(D0, 0, 1)>(vb), l1 = tr_read<v_rd_off(D0, 1, 0)>(vb), h1 = tr_read<v_rd_off(D0, 1, 1)>(vb);
  const s16x4 l2 = tr_read<v_rd_off(D0, 2, 0)>(vb), h2 = tr_read<v_rd_off(D0, 2, 1)>(vb), l3 = tr_read<v_rd_off(D0, 3, 0)>(vb), h3 = tr_read<v_rd_off(D0, 3, 1)>(vb);
  asm volatile("s_waitcnt lgkmcnt(0)" ::: "memory"); SBAR();
#define PK(L, H) (bf16x8){L[0], L[1], L[2], L[3], H[0], H[1], H[2], H[3]}
  od = __builtin_amdgcn_mfma_f32_32x32x16_bf16(pa0, PK(l0, h0), od, 0, 0, 0);
  od = __builtin_amdgcn_mfma_f32_32x32x16_bf16(pa1, PK(l1, h1), od, 0, 0, 0);
  od = __builtin_amdgcn_mfma_f32_32x32x16_bf16(pa2, PK(l2, h2), od, 0, 0, 0);
  od = __builtin_amdgcn_mfma_f32_32x32x16_bf16(pa3, PK(l3, h3), od, 0, 0, 0);
#undef PK
}
__device__ __forceinline__ void pv_d0(f32x16* o, int vb, bf16x8 pa0, bf16x8 pa1, bf16x8 pa2, bf16x8 pa3) {
  pv_one<0>(o[0], vb, pa0, pa1, pa2, pa3); pv_one<1>(o[1], vb, pa0, pa1, pa2, pa3); pv_one<2>(o[2], vb, pa0, pa1, pa2, pa3); pv_one<3>(o[3], vb, pa0, pa1, pa2, pa3);
}
__device__ __forceinline__ void attn_unit(const bf16* __restrict__ Qb, const bf16* __restrict__ Kh, const bf16* __restrict__ Vh, bf16* __restrict__ Ob, int seq, char* lds, const int tid) {
  const int wid = tid >> 6, lane = tid & 63, r32 = lane & 31, hi = lane >> 5;
  char* V_lds = lds; char* K_lds = lds + 2 * SHM_V;
  float* ws = (float*)(lds + 2 * SHM_V + 2 * SHM_K) + wid * 64; float* li_l = ws; float* al_l = ws + 32;
  float m_reg = -1e30f, l_reg = 0; f32x16 o[4] = {}; bf16x8 qr[4];
  const bf16* Qw = Qb + (long)(wid * QBLK + r32) * NP + hi * 8;
#pragma unroll
  for (int d0 = 0; d0 < 4; ++d0) qr[d0] = *reinterpret_cast<const bf16x8*>(Qw + d0 * 16);
  const int sr = tid >> 4, sc = (tid & 15) * 8, vst0 = v_st(sr, sc), vst1 = v_st(32 + sr, sc);
  const int ksr = tid >> 3, ksc = (tid & 7) * 8, kst = KSWZ64(ksr, ksc * 2);
  const int vb0 = (int)(uintptr_t)V_lds + v_rd_base(lane);
  struct { bf16x8 vs0, vs1, ks0; } sr_[2];
#define SLOAD(i, k0) do { sr_[i].vs0 = *reinterpret_cast<const bf16x8*>(&Vh[(long)((k0) + sr) * NP + sc]); sr_[i].vs1 = *reinterpret_cast<const bf16x8*>(&Vh[(long)((k0) + 32 + sr) * NP + sc]); \
    sr_[i].ks0 = *reinterpret_cast<const bf16x8*>(&Kh[(long)((k0) + ksr) * NP + ksc]); } while (0)
#define SWRITE(b, i) do { *(bf16x8*)(V_lds + (b) * SHM_V + vst0) = sr_[i].vs0; *(bf16x8*)(V_lds + (b) * SHM_V + vst1) = sr_[i].vs1; \
    *(bf16x8*)(K_lds + (b) * SHM_K + kst) = sr_[i].ks0; } while (0)
#define SWAIT() asm volatile("s_waitcnt vmcnt(3)" ::: "memory")
#define RESC(a) do { if (__any((a) < 1.f)) { if (hi == 0) al_l[r32] = (a); asm volatile("s_waitcnt lgkmcnt(0)" ::: "memory"); \
    _Pragma("unroll") for (int d = 0; d < 4; ++d) _Pragma("unroll") for (int r = 0; r < 16; ++r) o[d][r] *= al_l[crow(r, hi)]; } } while (0)
  f32x16 pA0, pA1, pB0, pB1; float mnA, mnB, alA, alB; bf16x8 pa0, pa1, pa2, pa3; const int NT = seq / KVBLK;
  constexpr int SE = 0, SO = 1;
  SLOAD(SE, 0); asm volatile("s_waitcnt vmcnt(0)" ::: "memory"); SWRITE(0, SE); __syncthreads();
  qkt(pA0, pA1, K_lds, qr, r32, hi); partialSM(pA0, pA1, m_reg, mnA, alA);
  SLOAD(SO, KVBLK); if (2 < NT) SLOAD(SE, 2 * KVBLK);
  SWAIT(); SWRITE(1, SO); __syncthreads();
  for (int j = 1; j + 1 < NT; j += 2) {
    SBAR(); qkt(pB0, pB1, K_lds + SHM_K, qr, r32, hi);
    finishSM(pA0, pA1, alA, l_reg, pa0, pa1, pa2, pa3); SBAR();
    SLOAD(SO, (j + 2) * KVBLK); SBAR();
    pv_d0(o, vb0, pa0, pa1, pa2, pa3); partialSM(pB0, pB1, m_reg, mnB, alB);
    __syncthreads(); SWAIT(); SWRITE(0, SE);
    RESC(alB); __syncthreads();
    SBAR(); qkt(pA0, pA1, K_lds, qr, r32, hi);
    finishSM(pB0, pB1, alB, l_reg, pa0, pa1, pa2, pa3); SBAR();
    if (j + 3 < NT) SLOAD(SE, (j + 3) * KVBLK); SBAR();
    pv_d0(o, vb0 + SHM_V, pa0, pa1, pa2, pa3); partialSM(pA0, pA1, m_reg, mnA, alA);
    __syncthreads(); SWAIT(); SWRITE(1, SO);
    RESC(alA); __syncthreads();
  }
  SBAR(); qkt(pB0, pB1, K_lds + SHM_K, qr, r32, hi);
  finishSM(pA0, pA1, alA, l_reg, pa0, pa1, pa2, pa3); SBAR();
  pv_d0(o, vb0, pa0, pa1, pa2, pa3); partialSM(pB0, pB1, m_reg, mnB, alB);
  __syncthreads(); RESC(alB);
  finishSM(pB0, pB1, alB, l_reg, pa0, pa1, pa2, pa3); SBAR();
  pv_d0(o, vb0 + SHM_V, pa0, pa1, pa2, pa3);
  if (hi == 0) li_l[r32] = l_reg; asm volatile("s_waitcnt lgkmcnt(0)" ::: "memory");
  float rli[16];
#pragma unroll
  for (int r = 0; r < 16; ++r) rli[r] = __builtin_amdgcn_rcpf(li_l[crow(r, hi)]);
  bf16* Ow = Ob + (long)(wid * QBLK) * D;
#pragma unroll
  for (int r = 0; r < 16; ++r) { int orow = crow(r, hi);
#pragma unroll
    for (int d0 = 0; d0 < 4; ++d0) Ow[(long)orow * D + d0 * 32 + r32] = f2bf(o[d0][r] * rli[r]); }
  __syncthreads();
#undef SLOAD
#undef SWRITE
#undef SWAIT
#undef RESC
}
}

__device__ __forceinline__ float ex2(float x) { return __builtin_amdgcn_exp2f(x); }
__device__ __forceinline__ float lg2(float x) { return __builtin_amdgcn_logf(x); }
constexpr float LOG2E = 1.4426950408889634f;
#define MFMA16(a, b, c) __builtin_amdgcn_mfma_f32_16x16x32_bf16((a), (b), (c), 0, 0, 0)
constexpr int CH_RS = 288, CH_GS = 1088;
constexpr int OFF_QT = 0, OFF_KT = 9216, OFF_QS = 18432, OFF_KST = 27648, OFF_VT = 39936, OFF_DEC = 52224, OFF_QSUM = 52736, CH_BUF = 55296;
constexpr int OFF_NV = 2 * CH_BUF;
__device__ __forceinline__ int chain_row(int b, int dir, int p) {
    if (p < TC) return b * RPB + (dir ? TC - 1 - p : p);
    const int q = p - TC; return b * RPB + TC + (dir ? TL - 1 - q : q);
}
__device__ __forceinline__ bf16x8 pack8(const f32x4 a, const f32x4 b) {
    u32x4 w; w.x = cvt_pk_bf16(a[0], a[1]); w.y = cvt_pk_bf16(a[2], a[3]); w.z = cvt_pk_bf16(b[0], b[1]); w.w = cvt_pk_bf16(b[2], b[3]); return __builtin_bit_cast(bf16x8, w);
}
__device__ __forceinline__ bf16x8 ld2x8(const LAS char* p0, const LAS char* p1) {
    const u32x2 a = *(const LAS u32x2*)p0, b = *(const LAS u32x2*)p1; u32x4 w = {a.x, a.y, b.x, b.y}; return __builtin_bit_cast(bf16x8, w);
}

constexpr int RAWA = 24576, A_OP = 2 * RAWA;
constexpr int OFFA_QSUM = 52736;
template <int dir> __device__ __forceinline__ void chain_a(Frame& F, int l, int item) {
    const int b = item >> 3, h = (item >> 1) & 3;
    const bf16* P = (const bf16*)(F.ws + WS_R1);
    bf16* OA = (bf16*)(F.ws + WS_R2 + 36 * MiB) + (size_t)dir * M * 512;
    const int tid = F.tid, lane = F.lane, w = F.wave, i16 = lane & 15, g = lane >> 4;
    const int cp = lane, tg = w;
    const int lt = tid >> 4, lc8 = (tid & 15) * 8;
    LAS char* L0 = (LAS char*)F.lds; LAS char* L = L0 + A_OP;
    float lb0 = 0.f, lb1 = 0.f;
    if (l == 1) { const float* lr = F.in[I_LBRAW] + dir * 512 + h * 128 + 2 * cp;
        lb0 = 1.f / (1.f + __expf(lr[0] - lr[1024])); lb1 = 1.f / (1.f + __expf(lr[1] - lr[1025])); }
    const float om0 = 1.f - lb0, om1 = 1.f - lb1;
    f32x4 S[8];
#pragma unroll
    for (int i = 0; i < 8; ++i) S[i] = (f32x4){0.f, 0.f, 0.f, 0.f};
    u32x4 rz[3], rq[3], rv[3];
#define CA_ROW0(ch) ((ch) < 8 ? b * RPB + (dir ? TC - 32 - (ch) * 32 : (ch) * 32) : b * RPB + TC + (dir ? TL - 32 - ((ch) - 8) * 32 : ((ch) - 8) * 32))
#define CA_LOAD(ch, k) do { const bf16* pr = P + (size_t)(CA_ROW0(ch) + lt) * NP + h * 128 + lc8; \
        rz[k] = *(const u32x4*)(pr + PA_F + dir * 512); rq[k] = *(const u32x4*)(pr + PA_Q); rv[k] = *(const u32x4*)(pr + PA_I); } while (0)
#define CA_WRITE(buf, k) do { LAS char* rw = L0 + (buf) * RAWA + lt * 256 + lc8 * 2; *(LAS u32x4*)rw = rz[k]; *(LAS u32x4*)(rw + 8192) = rq[k]; *(LAS u32x4*)(rw + 16384) = rv[k]; } while (0)
    CA_LOAD(0, 0); CA_WRITE(0, 0); CA_LOAD(1, 1); CA_LOAD(2, 2);
    __syncthreads();
    for (int ch0 = 0; ch0 < 72; ch0 += 3) {
#pragma unroll
    for (int kk = 0; kk < 3; ++kk) { const int ch = ch0 + kk;
        if (ch + 1 < 72) CA_WRITE((ch + 1) & 1, (kk + 1) % 3);
        if (ch + 3 < 72) CA_LOAD(ch + 3, kk);
        const LAS char* R = L0 + (ch & 1) * RAWA;
        float loc0[4], loc1[4], kk0[4], kk1[4], run0 = 0.f, run1 = 0.f;
#pragma unroll
        for (int i = 0; i < 4; ++i) { const int j = 4 * tg + i, m = dir ? 31 - j : j;
            const unsigned zz = *(const LAS unsigned*)(R + m * 256 + cp * 4);
            const float z0 = fmaxf(bflo(zz), -60.f), z1 = fmaxf(bfhi(zz), -60.f);
            const float e0 = ex2(-LOG2E * z0), e1 = ex2(-LOG2E * z1); const float s0 = __builtin_amdgcn_rcpf(1.f + e0), s1 = __builtin_amdgcn_rcpf(1.f + e1);
            run0 += lg2(lb0 + om0 * s0); run1 += lg2(lb1 + om1 * s1); loc0[i] = run0; loc1[i] = run1; kk0[i] = om0 * e0 * s0; kk1[i] = om1 * e1 * s1; }
        *(LAS f32x2*)(L + OFFA_QSUM + (tg * 128 + 2 * cp) * 4) = (f32x2){run0, run1};
        __syncthreads();
        float off0 = 0.f, off1 = 0.f, r0 = 0.f, r1 = 0.f, t0 = 0.f, t1 = 0.f;
#pragma unroll
        for (int q = 0; q < 8; ++q) { const f32x2 v = *(const LAS f32x2*)(L + OFFA_QSUM + (q * 128 + 2 * cp) * 4);
            if (q < tg) { off0 += v.x; off1 += v.y; } if (q < 4) { r0 += v.x; r1 += v.y; } t0 += v.x; t1 += v.y; }
        const float Er0 = ex2(r0), Er1 = ex2(r1), Ee0 = ex2(t0 - r0), Ee1 = ex2(t1 - r1);
        float ks0[4], ks1[4]; unsigned vv[4];
#pragma unroll
        for (int i = 0; i < 4; ++i) { const int j = 4 * tg + i, m = dir ? 31 - j : j;
            const unsigned qq = *(const LAS unsigned*)(R + 8192 + m * 256 + cp * 4); vv[i] = *(const LAS unsigned*)(R + 16384 + m * 256 + cp * 4);
            const float bb0 = off0 + loc0[i], bb1 = off1 + loc1[i];
            const float a0 = ex2(bb0 - r0), a1 = ex2(bb1 - r1), ia0 = ex2(r0 - bb0), ia1 = ex2(r1 - bb1);
            const float qt0 = bflo(qq) * a0, qt1 = bfhi(qq) * a1, kt0 = kk0[i] * ia0, kt1 = kk1[i] * ia1;
            *(LAS unsigned*)(L + OFF_QT + j * CH_RS + cp * 4) = cvt_pk_bf16(qt0, qt1);
            *(LAS unsigned*)(L + OFF_KT + j * CH_RS + cp * 4) = cvt_pk_bf16(kt0, kt1);
            *(LAS unsigned*)(L + OFF_QS + j * CH_RS + cp * 4) = cvt_pk_bf16(qt0 * Er0, qt1 * Er1);
            ks0[i] = kt0 * Ee0; ks1[i] = kt1 * Ee1; }
        *(LAS u32x4*)(L + OFF_KST + tg * CH_GS + cp * 16) = (u32x4){cvt_pk_bf16(ks0[0], ks0[1]), cvt_pk_bf16(ks0[2], ks0[3]), cvt_pk_bf16(ks1[0], ks1[1]), cvt_pk_bf16(ks1[2], ks1[3])};
        *(LAS u32x4*)(L + OFF_VT + tg * CH_GS + cp * 16) = (u32x4){(vv[0] & 0xffffu) | (vv[1] << 16), (vv[2] & 0xffffu) | (vv[3] << 16), (vv[0] >> 16) | (vv[1] & 0xffff0000u), (vv[2] >> 16) | (vv[3] & 0xffff0000u)};
        if (tg == 0) *(LAS f32x2*)(L + OFF_DEC + 2 * cp * 4) = (f32x2){ex2(t0), ex2(t1)};
        __syncthreads();
        f32x4 sc00 = {0.f, 0.f, 0.f, 0.f}, sc01 = sc00, sc11 = sc00;
#pragma unroll
        for (int ks_ = 0; ks_ < 4; ++ks_) { const int co = (32 * ks_ + 8 * g) * 2;
            const bf16x8 a0 = *(const LAS bf16x8*)(L + OFF_KT + i16 * CH_RS + co), a1 = *(const LAS bf16x8*)(L + OFF_KT + (16 + i16) * CH_RS + co);
            const bf16x8 b0 = *(const LAS bf16x8*)(L + OFF_QT + i16 * CH_RS + co), b1 = *(const LAS bf16x8*)(L + OFF_QT + (16 + i16) * CH_RS + co);
            sc00 = MFMA16(a0, b0, sc00); sc01 = MFMA16(a0, b1, sc01); sc11 = MFMA16(a1, b1, sc11); }
#pragma unroll
        for (int r = 0; r < 4; ++r) { const bool keep = (4 * g + r) <= i16; sc00[r] = keep ? sc00[r] : 0.f; sc11[r] = keep ? sc11[r] : 0.f; }
        const bf16x8 pb0 = pack8(sc00, (f32x4){0.f, 0.f, 0.f, 0.f}), pb1 = pack8(sc01, sc11);
        const LAS char* vrow = L + OFF_VT + (16 * w + i16) * 8;
        const bf16x8 av = ld2x8(vrow + g * CH_GS, vrow + (4 + g) * CH_GS);
        f32x4 o0 = MFMA16(av, pb0, ((f32x4){0.f, 0.f, 0.f, 0.f})), o1 = MFMA16(av, pb1, ((f32x4){0.f, 0.f, 0.f, 0.f}));
#pragma unroll
        for (int ks_ = 0; ks_ < 4; ++ks_) { const bf16x8 as = pack8(S[2 * ks_], S[2 * ks_ + 1]);
            const LAS char* q0p = L + OFF_QS + i16 * CH_RS + (32 * ks_ + 4 * g) * 2; const LAS char* q1p = q0p + 16 * CH_RS;
            o0 = MFMA16(as, ld2x8(q0p, q0p + 32), o0); o1 = MFMA16(as, ld2x8(q1p, q1p + 32), o1); }
        { const int row0 = CA_ROW0(ch); const int ra = row0 + (dir ? 31 - i16 : i16), rb = row0 + (dir ? 15 - i16 : 16 + i16);
          u32x2 w0 = {cvt_pk_bf16(o0[0], o0[1]), cvt_pk_bf16(o0[2], o0[3])}, w1 = {cvt_pk_bf16(o1[0], o1[1]), cvt_pk_bf16(o1[2], o1[3])};
          *(u32x2*)(OA + (size_t)ra * 512 + h * 128 + 16 * w + 4 * g) = w0; *(u32x2*)(OA + (size_t)rb * 512 + h * 128 + 16 * w + 4 * g) = w1; }
        const bf16x8 bvt = ld2x8(vrow + 2 * g * CH_GS, vrow + (2 * g + 1) * CH_GS);
#pragma unroll
        for (int cb = 0; cb < 8; ++cb) { const f32x4 d4 = *(const LAS f32x4*)(L + OFF_DEC + (16 * cb + 4 * g) * 4);
            const LAS char* kp = L + OFF_KST + (16 * cb + i16) * 8 + 2 * g * CH_GS; const bf16x8 a = ld2x8(kp, kp + CH_GS);
            S[cb] = MFMA16(a, bvt, S[cb] * d4); }
    } }
    __syncthreads();
#undef CA_LOAD
#undef CA_WRITE
}

#undef CA_ROW0
constexpr int OPA2 = 47616, A2_OP = 2 * RAWA, A2_QT = 0, A2_KT = 9216, A2_QS = 18432, A2_KST = 27648, A2_VT = 36352, A2_DEC = 45056, OFFA2_QSUM = 45568;
template <int dir> __device__ __forceinline__ void chain_a2(Frame& F, int l, int item) {
    const int b = item >> 3, h = (item >> 1) & 3;
    const bf16* P = (const bf16*)(F.ws + WS_R1);
    bf16* OA = (bf16*)(F.ws + WS_R2 + 36 * MiB) + (size_t)dir * M * 512;
    const int tid = F.tid, lane = F.lane, w = F.wave, i16 = lane & 15, g = lane >> 4;
    const bool isP = w < 4;
    const int cp = lane, tg = w & 3;
    const int cw = w & 3;
    LAS char* L0 = (LAS char*)F.lds;
    float lb0 = 0.f, lb1 = 0.f;
    if (l == 1) { const float* lr = F.in[I_LBRAW] + dir * 512 + h * 128 + 2 * cp;
        lb0 = 1.f / (1.f + __expf(lr[0] - lr[1024])); lb1 = 1.f / (1.f + __expf(lr[1] - lr[1025])); }
    const float om0 = 1.f - lb0, om1 = 1.f - lb1;
    f32x4 S[2][8];
#pragma unroll
    for (int v = 0; v < 2; ++v)
#pragma unroll
        for (int i = 0; i < 8; ++i) S[v][i] = (f32x4){0.f, 0.f, 0.f, 0.f};
#define CA_ROW0(ch) ((ch) < 8 ? b * RPB + (dir ? TC - 32 - (ch) * 32 : (ch) * 32) : b * RPB + TC + (dir ? TL - 32 - ((ch) - 8) * 32 : ((ch) - 8) * 32))
    u32x4 rz[2], rq[2], rv[2];
#define CA2_LOAD(ch, idx, k) do { const bf16* pr = P + (size_t)(CA_ROW0(ch) + ((idx) >> 4)) * NP + h * 128 + ((idx) & 15) * 8; \
        rz[k] = *(const u32x4*)(pr + PA_F + dir * 512); rq[k] = *(const u32x4*)(pr + PA_Q); rv[k] = *(const u32x4*)(pr + PA_I); } while (0)
#define CA2_WRITE(buf, idx, k) do { LAS char* rw = L0 + (buf) * RAWA + ((idx) >> 4) * 256 + ((idx) & 15) * 16; *(LAS u32x4*)rw = rz[k]; *(LAS u32x4*)(rw + 8192) = rq[k]; *(LAS u32x4*)(rw + 16384) = rv[k]; } while (0)
    CA2_LOAD(0, tid, 0); CA2_LOAD(1, tid, 1); CA2_WRITE(0, tid, 0); CA2_WRITE(1, tid, 1);
    const int ci = tid & 255;
    if (!isP) { CA2_LOAD(2, ci, 0); CA2_LOAD(2, ci + 256, 1); }
    __syncthreads();
    float loc0[8], loc1[8], kk0[8], kk1[8];
#define PREP1(ch) do { const LAS char* R = L0 + ((ch) & 1) * RAWA; LAS char* L = L0 + A2_OP + ((ch) & 1) * OPA2; float run0 = 0.f, run1 = 0.f; \
        _Pragma("unroll") for (int i = 0; i < 8; ++i) { const int j = 8 * tg + i, m = dir ? 31 - j : j; \
            const unsigned zz = *(const LAS unsigned*)(R + m * 256 + cp * 4); \
            const float z0 = fmaxf(bflo(zz), -60.f), z1 = fmaxf(bfhi(zz), -60.f); \
            const float e0 = ex2(-LOG2E * z0), e1 = ex2(-LOG2E * z1); const float s0 = __builtin_amdgcn_rcpf(1.f + e0), s1 = __builtin_amdgcn_rcpf(1.f + e1); \
            run0 += lg2(lb0 + om0 * s0); run1 += lg2(lb1 + om1 * s1); loc0[i] = run0; loc1[i] = run1; kk0[i] = om0 * e0 * s0; kk1[i] = om1 * e1 * s1; } \
        *(LAS f32x2*)(L + OFFA2_QSUM + (tg * 128 + 2 * cp) * 4) = (f32x2){run0, run1}; } while (0)
#define PREP2(ch) do { const LAS char* R = L0 + ((ch) & 1) * RAWA; LAS char* L = L0 + A2_OP + ((ch) & 1) * OPA2; \
        float off0 = 0.f, off1 = 0.f, r0 = 0.f, r1 = 0.f, t0 = 0.f, t1 = 0.f; \
        _Pragma("unroll") for (int q = 0; q < 4; ++q) { const f32x2 v = *(const LAS f32x2*)(L + OFFA2_QSUM + (q * 128 + 2 * cp) * 4); \
            if (q < tg) { off0 += v.x; off1 += v.y; } if (q < 2) { r0 += v.x; r1 += v.y; } t0 += v.x; t1 += v.y; } \
        const float Er0 = ex2(r0), Er1 = ex2(r1), Ee0 = ex2(t0 - r0), Ee1 = ex2(t1 - r1); \
        float ks0[8], ks1[8]; unsigned vv[8]; \
        _Pragma("unroll") for (int i = 0; i < 8; ++i) { const int j = 8 * tg + i, m = dir ? 31 - j : j; \
            const unsigned qq = *(const LAS unsigned*)(R + 8192 + m * 256 + cp * 4); vv[i] = *(const LAS unsigned*)(R + 16384 + m * 256 + cp * 4); \
            const float bb0 = off0 + loc0[i], bb1 = off1 + loc1[i]; \
            const float a0 = ex2(bb0 - r0), a1 = ex2(bb1 - r1), ia0 = ex2(r0 - bb0), ia1 = ex2(r1 - bb1); \
            const float qt0 = bflo(qq) * a0, qt1 = bfhi(qq) * a1, kt0 = kk0[i] * ia0, kt1 = kk1[i] * ia1; \
            *(LAS unsigned*)(L + A2_QT + j * CH_RS + cp * 4) = cvt_pk_bf16(qt0, qt1); \
            *(LAS unsigned*)(L + A2_KT + j * CH_RS + cp * 4) = cvt_pk_bf16(kt0, kt1); \
            *(LAS unsigned*)(L + A2_QS + j * CH_RS + cp * 4) = cvt_pk_bf16(qt0 * Er0, qt1 * Er1); \
            ks0[i] = kt0 * Ee0; ks1[i] = kt1 * Ee1; } \
        _Pragma("unroll") for (int hh = 0; hh < 2; ++hh) { \
            *(LAS u32x4*)(L + A2_KST + (2 * tg + hh) * CH_GS + cp * 16) = (u32x4){cvt_pk_bf16(ks0[4 * hh], ks0[4 * hh + 1]), cvt_pk_bf16(ks0[4 * hh + 2], ks0[4 * hh + 3]), cvt_pk_bf16(ks1[4 * hh], ks1[4 * hh + 1]), cvt_pk_bf16(ks1[4 * hh + 2], ks1[4 * hh + 3])}; \
            *(LAS u32x4*)(L + A2_VT + (2 * tg + hh) * CH_GS + cp * 16) = (u32x4){(vv[4 * hh] & 0xffffu) | (vv[4 * hh + 1] << 16), (vv[4 * hh + 2] & 0xffffu) | (vv[4 * hh + 3] << 16), (vv[4 * hh] >> 16) | (vv[4 * hh + 1] & 0xffff0000u), (vv[4 * hh + 2] >> 16) | (vv[4 * hh + 3] & 0xffff0000u)}; } \
        if (tg == 0) *(LAS f32x2*)(L + A2_DEC + 2 * cp * 4) = (f32x2){ex2(t0), ex2(t1)}; } while (0)
    if (isP) {
        PREP1(0);
        __syncthreads();
        PREP2(0);
        __syncthreads();
        for (int ch = 0; ch < 72; ++ch) {
            if (ch + 1 < 72) PREP1(ch + 1);
            __syncthreads();
            if (ch + 1 < 72) PREP2(ch + 1);
            __syncthreads();
        }
    } else {
        __builtin_amdgcn_s_setprio(1);
        __syncthreads();
        __syncthreads();
        for (int ch = 0; ch < 72; ++ch) {
            const LAS char* L = L0 + A2_OP + (ch & 1) * OPA2;
            bf16x8 pb0, pb1; f32x4 o[2][2];
            {
                f32x4 sc00 = {0.f, 0.f, 0.f, 0.f}, sc01 = sc00, sc11 = sc00;
#pragma unroll
                for (int ks_ = 0; ks_ < 4; ++ks_) { const int co = (32 * ks_ + 8 * g) * 2;
                    const bf16x8 a0 = *(const LAS bf16x8*)(L + A2_KT + i16 * CH_RS + co), a1 = *(const LAS bf16x8*)(L + A2_KT + (16 + i16) * CH_RS + co);
                    const bf16x8 b0 = *(const LAS bf16x8*)(L + A2_QT + i16 * CH_RS + co), b1 = *(const LAS bf16x8*)(L + A2_QT + (16 + i16) * CH_RS + co);
                    sc00 = MFMA16(a0, b0, sc00); sc01 = MFMA16(a0, b1, sc01); sc11 = MFMA16(a1, b1, sc11); }
#pragma unroll
                for (int r = 0; r < 4; ++r) { const bool keep = (4 * g + r) <= i16; sc00[r] = keep ? sc00[r] : 0.f; sc11[r] = keep ? sc11[r] : 0.f; }
                pb0 = pack8(sc00, (f32x4){0.f, 0.f, 0.f, 0.f}); pb1 = pack8(sc01, sc11);
#pragma unroll
                for (int v = 0; v < 2; ++v) { const LAS char* vrow = L + A2_VT + (32 * cw + 16 * v + i16) * 8;
                    const bf16x8 av = ld2x8(vrow + g * CH_GS, vrow + (4 + g) * CH_GS);
                    o[v][0] = MFMA16(av, pb0, ((f32x4){0.f, 0.f, 0.f, 0.f})); o[v][1] = MFMA16(av, pb1, ((f32x4){0.f, 0.f, 0.f, 0.f})); }
            }
            __syncthreads();
#pragma unroll
            for (int ks_ = 0; ks_ < 4; ++ks_) { const LAS char* q0p = L + A2_QS + i16 * CH_RS + (32 * ks_ + 4 * g) * 2;
                const bf16x8 qs0 = ld2x8(q0p, q0p + 32), qs1 = ld2x8(q0p + 16 * CH_RS, q0p + 16 * CH_RS + 32);
#pragma unroll
                for (int v = 0; v < 2; ++v) { const bf16x8 as = pack8(S[v][2 * ks_], S[v][2 * ks_ + 1]); o[v][0] = MFMA16(as, qs0, o[v][0]); o[v][1] = MFMA16(as, qs1, o[v][1]); } }
            { const int row0 = CA_ROW0(ch); const int ra = row0 + (dir ? 31 - i16 : i16), rb = row0 + (dir ? 15 - i16 : 16 + i16);
#pragma unroll
              for (int v = 0; v < 2; ++v) { const int col = h * 128 + 32 * cw + 16 * v + 4 * g;
                  u32x2 w0 = {cvt_pk_bf16(o[v][0][0], o[v][0][1]), cvt_pk_bf16(o[v][0][2], o[v][0][3])}, w1 = {cvt_pk_bf16(o[v][1][0], o[v][1][1]), cvt_pk_bf16(o[v][1][2], o[v][1][3])};
                  *(u32x2*)(OA + (size_t)ra * 512 + col) = w0; *(u32x2*)(OA + (size_t)rb * 512 + col) = w1; } }
            bf16x8 bvt[2];
#pragma unroll
            for (int v = 0; v < 2; ++v) { const LAS char* vrow = L + A2_VT + (32 * cw + 16 * v + i16) * 8; bvt[v] = ld2x8(vrow + 2 * g * CH_GS, vrow + (2 * g + 1) * CH_GS); }
#pragma unroll
            for (int cb = 0; cb < 8; ++cb) { const f32x4 d4 = *(const LAS f32x4*)(L + A2_DEC + (16 * cb + 4 * g) * 4);
                const LAS char* kp = L + A2_KST + (16 * cb + i16) * 8 + 2 * g * CH_GS; const bf16x8 a = ld2x8(kp, kp + CH_GS);
                S[0][cb] = MFMA16(a, bvt[0], S[0][cb] * d4); S[1][cb] = MFMA16(a, bvt[1], S[1][cb] * d4); }
            if (ch + 2 < 72) { CA2_WRITE(ch & 1, ci, 0); CA2_WRITE(ch & 1, ci + 256, 1); }
            if (ch + 3 < 72) { CA2_LOAD(ch + 3, ci, 0); CA2_LOAD(ch + 3, ci + 256, 1); }
            __syncthreads();
        }
        __builtin_amdgcn_s_setprio(0);
    }
#undef PREP1
#undef PREP2
#undef CA2_LOAD
#undef CA2_WRITE
#undef CA_ROW0
}

constexpr int RAWB = 25856, B_OP = 2 * RAWB, OPB = 43264, OFFB_Q = 0, OFFB_K = 9216, OFFB_KWT = 18432, OFFB_VT = 30720, OFFB_BB = 43008, OFFB_NV = B_OP + 2 * OPB;
template <int dir, int VAR = 0> __device__ __forceinline__ void chain_b(Frame& F, int l, int item) {
    const int b = item >> 3, h = (item >> 1) & 3;
    const bf16* P = (const bf16*)(F.ws + WS_R1);
    const float* GT = (const float*)(F.ws + WS_GATES);
    bf16* OB = (VAR ? (bf16*)F.out : (bf16*)(F.ws + WS_R2 + 72 * MiB)) + (size_t)dir * M * 512;
    const int tid = F.tid, lane = F.lane, w = F.wave, i16 = lane & 15, g = lane >> 4;
    const int cp = lane, tg = w;
    const int lt = tid >> 4, lc8 = (tid & 15) * 8;
    LAS char* L0 = (LAS char*)F.lds;
    float wq[2][4], wk[2][4];
    { const float* cw = F.in[I_CONVW] + l * 3 * 1024; const float* cbp = F.in[I_CONVB] + l * 1024;
#pragma unroll
      for (int e = 0; e < 2; ++e) { const int qc = h * 128 + 2 * cp + e, kc = 512 + qc;
          wq[e][0] = cw[qc]; wq[e][1] = cw[1024 + qc]; wq[e][2] = cw[2048 + qc]; wq[e][3] = cbp[qc];
          wk[e][0] = cw[kc]; wk[e][1] = cw[1024 + kc]; wk[e][2] = cw[2048 + kc]; wk[e][3] = cbp[kc]; } }
    f32x4 S[8];
#pragma unroll
    for (int i = 0; i < 8; ++i) S[i] = (f32x4){0.f, 0.f, 0.f, 0.f};
    if (tid < 128) { ((LAS float*)(L0 + OFFB_NV))[tid] = 0.f; ((LAS bf16*)(L0 + OFFB_NV + 1024))[tid] = 0; }
    u32x4 rxq[3], rxk[3], rv[3]; unsigned rh[3]; float rli[3], rlf[3];
#define CB_SEG(ch, len, rbase, nlo) const int len = (ch) < 8 ? TC : TL, rbase = b * RPB + ((ch) < 8 ? 0 : TC), nlo = dir ? len - 32 - ((ch) < 8 ? (ch) : (ch) - 8) * 32 : ((ch) < 8 ? (ch) : (ch) - 8) * 32
#define CB_LOAD(ch, k) do { CB_SEG(ch, len_, rb_, nlo_); const bf16* pr = P + (size_t)(rb_ + nlo_ + lt) * NP + h * 128 + lc8; \
        rxq[k] = *(const u32x4*)(pr + PB_Q); rxk[k] = *(const u32x4*)(pr + PB_K); rv[k] = *(const u32x4*)(pr + PB_V); \
        const int hs_ = (tid >> 6) & 1, hn_ = hs_ ? nlo_ + 32 : nlo_ - 1; const bool hok_ = (hn_ >= 0) && (hn_ < len_); \
        rh[k] = *(const unsigned*)(P + (size_t)(rb_ + (hok_ ? hn_ : nlo_)) * NP + ((tid >> 7) & 1) * 512 + PB_Q + h * 128 + 2 * (tid & 63)); rh[k] &= 0u - (unsigned)hok_; \
        { const float* gp = GT + (size_t)(rb_ + nlo_ + (tid & 31)) * 16 + dir * 4 + h; rli[k] = gp[0]; rlf[k] = gp[8]; } } while (0)
#define CB_WRITE(buf, k) do { LAS char* rw = L0 + (buf) * RAWB; *(LAS u32x4*)(rw + (lt + 1) * 256 + lc8 * 2) = rxq[k]; *(LAS u32x4*)(rw + 8704 + (lt + 1) * 256 + lc8 * 2) = rxk[k]; \
        *(LAS u32x4*)(rw + 17408 + lt * 256 + lc8 * 2) = rv[k]; \
        if (tid < 256) *(LAS unsigned*)(rw + ((tid >> 7) & 1) * 8704 + (((tid >> 6) & 1) ? 33 : 0) * 256 + (tid & 63) * 4) = rh[k]; \
        if (tid < 32) { ((LAS float*)(rw + 25600))[tid] = rli[k]; ((LAS float*)(rw + 25600))[32 + tid] = rlf[k]; } } while (0)
    CB_LOAD(0, 0); CB_WRITE(0, 0); CB_LOAD(1, 1); CB_LOAD(2, 2);
    __syncthreads();
    for (int ch0 = 0; ch0 < 72; ch0 += 3) {
#pragma unroll
    for (int kk = 0; kk < 3; ++kk) { const int ch = ch0 + kk;
        if (ch + 1 < 72) CB_WRITE((ch + 1) & 1, (kk + 1) % 3);
        if (VAR != 3) { if (ch + 3 < 72) CB_LOAD(ch + 3, kk); }
        const LAS char* R = L0 + (ch & 1) * RAWB; LAS char* L = L0 + B_OP + (ch & 1) * OPB;
#ifdef EXP_DUP_PREP
        _Pragma("unroll 1") for (int rep_ = 0; rep_ < EXP_DUP_PREP; ++rep_) { asm volatile("" ::: "memory");
#endif
        if (VAR != 2) {
        const int jm = dir ? 31 - (lane & 31) : (lane & 31);
        const float li_j = ((const LAS float*)(R + 25600))[jm] * LOG2E; float bval = ((const LAS float*)(R + 25600))[32 + jm] * LOG2E;
        bval += dpp_mov<0x111>(bval); bval += dpp_mov<0x112>(bval); bval += dpp_mov<0x114>(bval); bval += dpp_mov<0x118>(bval);
        { const float tot0 = __int_as_float(__builtin_amdgcn_readlane(__float_as_int(bval), 15)); if (lane & 16) bval += tot0; }
        const float eb_j = ex2(bval), el_j = ex2(li_j - bval);
        const float e_end = __int_as_float(__builtin_amdgcn_readlane(__float_as_int(eb_j), 31));
        if (w == 0 && lane < 32) { ((LAS float*)(L + OFFB_BB))[lane] = eb_j; ((LAS float*)(L + OFFB_BB))[32 + lane] = el_j; }
        const int mlo = dir ? 28 - 4 * tg : 4 * tg;
        unsigned xq[6], xk[6], vv[4];
#pragma unroll
        for (int k = 0; k < 6; ++k) { xq[k] = *(const LAS unsigned*)(R + (mlo + k) * 256 + cp * 4); xk[k] = *(const LAS unsigned*)(R + 8704 + (mlo + k) * 256 + cp * 4); }
#pragma unroll
        for (int k = 0; k < 4; ++k) vv[k] = *(const LAS unsigned*)(R + 17408 + (mlo + k) * 256 + cp * 4);
        float kw0[4], kw1[4]; unsigned vc[4];
#pragma unroll
        for (int i = 0; i < 4; ++i) { const int k = dir ? 3 - i : i, j = 4 * tg + i;
            float q0 = wq[0][3] + wq[0][0] * bflo(xq[k]) + wq[0][1] * bflo(xq[k + 1]) + wq[0][2] * bflo(xq[k + 2]);
            float q1 = wq[1][3] + wq[1][0] * bfhi(xq[k]) + wq[1][1] * bfhi(xq[k + 1]) + wq[1][2] * bfhi(xq[k + 2]);
            float k0 = wk[0][3] + wk[0][0] * bflo(xk[k]) + wk[0][1] * bflo(xk[k + 1]) + wk[0][2] * bflo(xk[k + 2]);
            float k1 = wk[1][3] + wk[1][0] * bfhi(xk[k]) + wk[1][1] * bfhi(xk[k + 1]) + wk[1][2] * bfhi(xk[k + 2]);
            q0 = q0 * __builtin_amdgcn_rcpf(1.f + ex2(-LOG2E * q0)) * 0.088388347648318440f; q1 = q1 * __builtin_amdgcn_rcpf(1.f + ex2(-LOG2E * q1)) * 0.088388347648318440f;
            k0 = k0 * __builtin_amdgcn_rcpf(1.f + ex2(-LOG2E * k0)); k1 = k1 * __builtin_amdgcn_rcpf(1.f + ex2(-LOG2E * k1));
            const float wgt = e_end * __int_as_float(__builtin_amdgcn_readlane(__float_as_int(el_j), j));
            *(LAS unsigned*)(L + OFFB_Q + j * CH_RS + cp * 4) = cvt_pk_bf16(q0, q1); *(LAS unsigned*)(L + OFFB_K + j * CH_RS + cp * 4) = cvt_pk_bf16(k0, k1);
            kw0[i] = k0 * wgt; kw1[i] = k1 * wgt; vc[i] = vv[k]; }
        *(LAS u32x4*)(L + OFFB_KWT + tg * CH_GS + cp * 16) = (u32x4){cvt_pk_bf16(kw0[0], kw0[1]), cvt_pk_bf16(kw0[2], kw0[3]), cvt_pk_bf16(kw1[0], kw1[1]), cvt_pk_bf16(kw1[2], kw1[3])};
        *(LAS u32x4*)(L + OFFB_VT + tg * CH_GS + cp * 16) = (u32x4){(vc[0] & 0xffffu) | (vc[1] << 16), (vc[2] & 0xffffu) | (vc[3] << 16), (vc[0] >> 16) | (vc[1] & 0xffff0000u), (vc[2] >> 16) | (vc[3] & 0xffff0000u)};
        }
#ifdef EXP_DUP_PREP
        }
#endif
        __syncthreads();
        if (VAR != 1) {
        const LAS float* BB = (const LAS float*)(L + OFFB_BB); const LAS float* LI = BB + 32;
        const LAS float* NVc = (const LAS float*)(L0 + OFFB_NV) + (ch & 1) * 128; LAS float* NVn = (LAS float*)(L0 + OFFB_NV) + ((ch + 1) & 1) * 128;
        const LAS char* NVb = L0 + OFFB_NV + 1024 + (ch & 1) * 256;
        f32x4 sc00 = {0.f, 0.f, 0.f, 0.f}, sc01 = sc00, sc11 = sc00, qa0 = sc00, qa1 = sc00;
#pragma unroll
        for (int ks_ = 0; ks_ < 4; ++ks_) { const int co = (32 * ks_ + 8 * g) * 2;
            const bf16x8 a0 = *(const LAS bf16x8*)(L + OFFB_K + i16 * CH_RS + co), a1 = *(const LAS bf16x8*)(L + OFFB_K + (16 + i16) * CH_RS + co);
            const bf16x8 b0 = *(const LAS bf16x8*)(L + OFFB_Q + i16 * CH_RS + co), b1 = *(const LAS bf16x8*)(L + OFFB_Q + (16 + i16) * CH_RS + co);
            const bf16x8 nf = *(const LAS bf16x8*)(NVb + co);
            sc00 = MFMA16(a0, b0, sc00); sc01 = MFMA16(a0, b1, sc01); sc11 = MFMA16(a1, b1, sc11); qa0 = MFMA16(nf, b0, qa0); qa1 = MFMA16(nf, b1, qa1); }
        const float bt0 = BB[i16], bt1 = BB[16 + i16], dec = BB[31];
        const f32x4 ls0 = *(const LAS f32x4*)(LI + 4 * g), ls1 = *(const LAS f32x4*)(LI + 16 + 4 * g);
#pragma unroll
        for (int r = 0; r < 4; ++r) { const bool keep = (4 * g + r) <= i16;
            sc00[r] = keep ? sc00[r] * (bt0 * ls0[r]) : 0.f;
            sc01[r] = sc01[r] * (bt1 * ls0[r]);
            sc11[r] = keep ? sc11[r] * (bt1 * ls1[r]) : 0.f; }
        const bf16x8 pb0 = pack8(sc00, (f32x4){0.f, 0.f, 0.f, 0.f}), pb1 = pack8(sc01, sc11);
        const bf16x8 ones = {0x3F80, 0x3F80, 0x3F80, 0x3F80, 0x3F80, 0x3F80, 0x3F80, 0x3F80};
        const f32x4 zz4 = {0.f, 0.f, 0.f, 0.f};
        const float dsum0 = MFMA16(ones, pb0, zz4)[0], dsum1 = MFMA16(ones, pb1, zz4)[0], qn0 = qa0[0], qn1 = qa1[0];
        const LAS char* vrow = L + OFFB_VT + (16 * w + i16) * 8;
        const bf16x8 av = ld2x8(vrow + g * CH_GS, vrow + (4 + g) * CH_GS);
        const f32x4 z4 = {0.f, 0.f, 0.f, 0.f};
        f32x4 o0 = MFMA16(av, pb0, z4), o1 = MFMA16(av, pb1, z4), i0 = z4, i1 = z4;
#pragma unroll
        for (int ks_ = 0; ks_ < 4; ++ks_) { const bf16x8 as = pack8(S[2 * ks_], S[2 * ks_ + 1]);
            const LAS char* q0p = L + OFFB_Q + i16 * CH_RS + (32 * ks_ + 4 * g) * 2; const LAS char* q1p = q0p + 16 * CH_RS;
            i0 = MFMA16(as, ld2x8(q0p, q0p + 32), i0); i1 = MFMA16(as, ld2x8(q1p, q1p + 32), i1); }
        { const float e0 = bt0, e1 = bt1;
          const float den0 = dsum0 + e0 * qn0, den1 = dsum1 + e1 * qn1;
          const float s0 = __builtin_amdgcn_rcpf(fmaxf(fabsf(den0), 1.f)), s1 = __builtin_amdgcn_rcpf(fmaxf(fabsf(den1), 1.f));
          o0 = (o0 + i0 * e0) * s0; o1 = (o1 + i1 * e1) * s1;
          CB_SEG(ch, len_, rb_, nlo_); (void)len_;
          const int ra = rb_ + nlo_ + (dir ? 31 - i16 : i16), rbw = rb_ + nlo_ + (dir ? 15 - i16 : 16 + i16);
          u32x2 w0 = {cvt_pk_bf16(o0[0], o0[1]), cvt_pk_bf16(o0[2], o0[3])}, w1 = {cvt_pk_bf16(o1[0], o1[1]), cvt_pk_bf16(o1[2], o1[3])};
          *(u32x2*)(OB + (size_t)ra * 512 + h * 128 + 16 * w + 4 * g) = w0; *(u32x2*)(OB + (size_t)rbw * 512 + h * 128 + 16 * w + 4 * g) = w1; }
        const bf16x8 bvt = ld2x8(vrow + 2 * g * CH_GS, vrow + (2 * g + 1) * CH_GS);
#pragma unroll
        for (int cb = 0; cb < 8; ++cb) { const LAS char* kp = L + OFFB_KWT + (16 * cb + i16) * 8 + 2 * g * CH_GS; const bf16x8 a = ld2x8(kp, kp + CH_GS);
            S[cb] = MFMA16(a, bvt, S[cb] * dec); }
        { const LAS char* kp = L + OFFB_KWT + (16 * w + i16) * 8 + 2 * g * CH_GS; const f32x4 ns = MFMA16(ld2x8(kp, kp + CH_GS), ones, zz4);
          if (i16 == 0) { const int c4 = 16 * w + 4 * g; const f32x4 nn = ns + *(const LAS f32x4*)(NVc + c4) * dec; *(LAS f32x4*)(NVn + c4) = nn;
              *(LAS u32x2*)(L0 + OFFB_NV + 1024 + ((ch + 1) & 1) * 256 + c4 * 2) = (u32x2){cvt_pk_bf16(nn[0], nn[1]), cvt_pk_bf16(nn[2], nn[3])}; } }
        }
    } }
    __syncthreads();
#undef CB_LOAD
#undef CB_WRITE
#undef CB_SEG
}

template <int dir> __device__ __forceinline__ void chain_b2(Frame& F, int l, int item) {
    const int b = item >> 3, h = (item >> 1) & 3;
    const bf16* P = (const bf16*)(F.ws + WS_R1);
    const float* GT = (const float*)(F.ws + WS_GATES);
    bf16* OB = (bf16*)(F.ws + WS_R2 + 72 * MiB) + (size_t)dir * M * 512;
    const int tid = F.tid, lane = F.lane, w = F.wave, i16 = lane & 15, g = lane >> 4;
    const bool isP = w < 4;
    const int cp = lane, tg = w & 3, cw = w & 3;
    LAS char* L0 = (LAS char*)F.lds;
    if (tid < 128) { ((LAS float*)(L0 + OFFB_NV))[tid] = 0.f; ((LAS bf16*)(L0 + OFFB_NV + 1024))[tid] = 0; }
    u32x4 rxq[2], rxk[2], rv[2]; unsigned rh[2]; float rli[2], rlf[2];
#define CB_SEG(ch, len, rbase, nlo) const int len = (ch) < 8 ? TC : TL, rbase = b * RPB + ((ch) < 8 ? 0 : TC), nlo = dir ? len - 32 - ((ch) < 8 ? (ch) : (ch) - 8) * 32 : ((ch) < 8 ? (ch) : (ch) - 8) * 32
#define CB2_MAIN(ch, idx, k) do { CB_SEG(ch, len_, rb_, nlo_); (void)len_; const bf16* pr = P + (size_t)(rb_ + nlo_ + ((idx) >> 4)) * NP + h * 128 + ((idx) & 15) * 8; \
        rxq[k] = *(const u32x4*)(pr + PB_Q); rxk[k] = *(const u32x4*)(pr + PB_K); rv[k] = *(const u32x4*)(pr + PB_V); } while (0)
#define CB2_MAINW(buf, idx, k) do { LAS char* rw = L0 + (buf) * RAWB; *(LAS u32x4*)(rw + (((idx) >> 4) + 1) * 256 + ((idx) & 15) * 16) = rxq[k]; *(LAS u32x4*)(rw + 8704 + (((idx) >> 4) + 1) * 256 + ((idx) & 15) * 16) = rxk[k]; \
        *(LAS u32x4*)(rw + 17408 + ((idx) >> 4) * 256 + ((idx) & 15) * 16) = rv[k]; } while (0)
#define CB2_HALO(ch, hi, k) do { CB_SEG(ch, len_, rb_, nlo_); const int hn_ = (((hi) >> 6) & 1) ? nlo_ + 32 : nlo_ - 1; const bool hok_ = (hn_ >= 0) && (hn_ < len_); \
        rh[k] = *(const unsigned*)(P + (size_t)(rb_ + (hok_ ? hn_ : nlo_)) * NP + (((hi) >> 7) & 1) * 512 + PB_Q + h * 128 + 2 * ((hi) & 63)); rh[k] &= 0u - (unsigned)hok_; \
        const float* gp = GT + (size_t)(rb_ + nlo_ + ((hi) & 31)) * 16 + dir * 4 + h; rli[k] = gp[0]; rlf[k] = gp[8]; } while (0)
#define CB2_HALOW(buf, hi, k) do { LAS char* rw = L0 + (buf) * RAWB; *(LAS unsigned*)(rw + (((hi) >> 7) & 1) * 8704 + ((((hi) >> 6) & 1) ? 33 : 0) * 256 + ((hi) & 63) * 4) = rh[k]; \
        if ((hi) < 32) { ((LAS float*)(rw + 25600))[hi] = rli[k]; ((LAS float*)(rw + 25600))[32 + (hi)] = rlf[k]; } } while (0)
    CB2_MAIN(0, tid, 0); CB2_MAIN(1, tid, 1);
    if (tid < 256) { CB2_HALO(0, tid, 0); CB2_HALO(1, tid, 1); }
    CB2_MAINW(0, tid, 0); CB2_MAINW(1, tid, 1);
    if (tid < 256) { CB2_HALOW(0, tid, 0); CB2_HALOW(1, tid, 1); }
    const int ci = tid & 255;
    if (!isP) { CB2_MAIN(2, ci, 0); CB2_MAIN(2, ci + 256, 1); CB2_HALO(2, ci, 0); }
    __syncthreads();
    if (isP) {
        float wq[2][4], wk[2][4];
        { const float* cwp = F.in[I_CONVW] + l * 3 * 1024; const float* cbp = F.in[I_CONVB] + l * 1024;
#pragma unroll
          for (int e = 0; e < 2; ++e) { const int qc = h * 128 + 2 * cp + e, kc = 512 + qc;
              wq[e][0] = cwp[qc]; wq[e][1] = cwp[1024 + qc]; wq[e][2] = cwp[2048 + qc]; wq[e][3] = cbp[qc];
              wk[e][0] = cwp[kc]; wk[e][1] = cwp[1024 + kc]; wk[e][2] = cwp[2048 + kc]; wk[e][3] = cbp[kc]; } }
        for (int ch = 0; ch < 73; ++ch) {
            if (ch < 72) {
#ifdef EXP_DUP_PB2
                _Pragma("unroll 1") for (int rep_ = 0; rep_ < EXP_DUP_PB2; ++rep_) { asm volatile("" ::: "memory");
#endif
                const LAS char* R = L0 + (ch & 1) * RAWB; LAS char* L = L0 + B_OP + (ch & 1) * OPB;
                const int jm = dir ? 31 - (lane & 31) : (lane & 31);
                const float li_j = ((const LAS float*)(R + 25600))[jm] * LOG2E; float bval = ((const LAS float*)(R + 25600))[32 + jm] * LOG2E;
                bval += dpp_mov<0x111>(bval); bval += dpp_mov<0x112>(bval); bval += dpp_mov<0x114>(bval); bval += dpp_mov<0x118>(bval);
                { const float tot0 = __int_as_float(__builtin_amdgcn_readlane(__float_as_int(bval), 15)); if (lane & 16) bval += tot0; }
                const float eb_j = ex2(bval), el_j = ex2(li_j - bval);
                const float e_end = __int_as_float(__builtin_amdgcn_readlane(__float_as_int(eb_j), 31));
                if (w == 0 && lane < 32) { ((LAS float*)(L + OFFB_BB))[lane] = eb_j; ((LAS float*)(L + OFFB_BB))[32 + lane] = el_j; }
                const int mlo = dir ? 24 - 8 * tg : 8 * tg;
                unsigned xq[10], xk[10], vv[8];
#pragma unroll
                for (int k = 0; k < 10; ++k) { xq[k] = *(const LAS unsigned*)(R + (mlo + k) * 256 + cp * 4); xk[k] = *(const LAS unsigned*)(R + 8704 + (mlo + k) * 256 + cp * 4); }
#pragma unroll
                for (int k = 0; k < 8; ++k) vv[k] = *(const LAS unsigned*)(R + 17408 + (mlo + k) * 256 + cp * 4);
                float kw0[8], kw1[8]; unsigned vc[8];
#pragma unroll
                for (int i = 0; i < 8; ++i) { const int k = dir ? 7 - i : i, j = 8 * tg + i;
                    float q0 = wq[0][3] + wq[0][0] * bflo(xq[k]) + wq[0][1] * bflo(xq[k + 1]) + wq[0][2] * bflo(xq[k + 2]);
                    float q1 = wq[1][3] + wq[1][0] * bfhi(xq[k]) + wq[1][1] * bfhi(xq[k + 1]) + wq[1][2] * bfhi(xq[k + 2]);
                    float k0 = wk[0][3] + wk[0][0] * bflo(xk[k]) + wk[0][1] * bflo(xk[k + 1]) + wk[0][2] * bflo(xk[k + 2]);
                    float k1 = wk[1][3] + wk[1][0] * bfhi(xk[k]) + wk[1][1] * bfhi(xk[k + 1]) + wk[1][2] * bfhi(xk[k + 2]);
                    q0 = q0 * __builtin_amdgcn_rcpf(1.f + ex2(-LOG2E * q0)) * 0.088388347648318440f; q1 = q1 * __builtin_amdgcn_rcpf(1.f + ex2(-LOG2E * q1)) * 0.088388347648318440f;
                    k0 = k0 * __builtin_amdgcn_rcpf(1.f + ex2(-LOG2E * k0)); k1 = k1 * __builtin_amdgcn_rcpf(1.f + ex2(-LOG2E * k1));
                    const float wgt = e_end * __int_as_float(__builtin_amdgcn_readlane(__float_as_int(el_j), j));
                    *(LAS unsigned*)(L + OFFB_Q + j * CH_RS + cp * 4) = cvt_pk_bf16(q0, q1); *(LAS unsigned*)(L + OFFB_K + j * CH_RS + cp * 4) = cvt_pk_bf16(k0, k1);
                    kw0[i] = k0 * wgt; kw1[i] = k1 * wgt; vc[i] = vv[k]; }
#pragma unroll
                for (int hh = 0; hh < 2; ++hh) {
                    *(LAS u32x4*)(L + OFFB_KWT + (2 * tg + hh) * CH_GS + cp * 16) = (u32x4){cvt_pk_bf16(kw0[4 * hh], kw0[4 * hh + 1]), cvt_pk_bf16(kw0[4 * hh + 2], kw0[4 * hh + 3]), cvt_pk_bf16(kw1[4 * hh], kw1[4 * hh + 1]), cvt_pk_bf16(kw1[4 * hh + 2], kw1[4 * hh + 3])};
                    *(LAS u32x4*)(L + OFFB_VT + (2 * tg + hh) * CH_GS + cp * 16) = (u32x4){(vc[4 * hh] & 0xffffu) | (vc[4 * hh + 1] << 16), (vc[4 * hh + 2] & 0xffffu) | (vc[4 * hh + 3] << 16), (vc[4 * hh] >> 16) | (vc[4 * hh + 1] & 0xffff0000u), (vc[4 * hh + 2] >> 16) | (vc[4 * hh + 3] & 0xffff0000u)}; }
#ifdef EXP_DUP_PB2
                }
#endif
            }
            __syncthreads();
        }
    } else {
        f32x4 S[2][8];
#pragma unroll
        for (int v = 0; v < 2; ++v)
#pragma unroll
            for (int i = 0; i < 8; ++i) S[v][i] = (f32x4){0.f, 0.f, 0.f, 0.f};
        __builtin_amdgcn_s_setprio(1);
        __syncthreads();
        for (int ch = 0; ch < 72; ++ch) {
            const LAS char* L = L0 + B_OP + (ch & 1) * OPB;
            const LAS float* BB = (const LAS float*)(L + OFFB_BB); const LAS float* LI = BB + 32;
            const LAS float* NVc = (const LAS float*)(L0 + OFFB_NV) + (ch & 1) * 128; LAS float* NVn = (LAS float*)(L0 + OFFB_NV) + ((ch + 1) & 1) * 128;
            const LAS char* NVb = L0 + OFFB_NV + 1024 + (ch & 1) * 256;
            const f32x4 z4 = {0.f, 0.f, 0.f, 0.f};
            f32x4 o[2][2], in_[2][2];
#pragma unroll
            for (int v = 0; v < 2; ++v) { in_[v][0] = z4; in_[v][1] = z4; }
#pragma unroll
            for (int ks_ = 0; ks_ < 4; ++ks_) { const LAS char* q0p = L + OFFB_Q + i16 * CH_RS + (32 * ks_ + 4 * g) * 2;
                const bf16x8 qf0 = ld2x8(q0p, q0p + 32), qf1 = ld2x8(q0p + 16 * CH_RS, q0p + 16 * CH_RS + 32);
#pragma unroll
                for (int v = 0; v < 2; ++v) { const bf16x8 as = pack8(S[v][2 * ks_], S[v][2 * ks_ + 1]); in_[v][0] = MFMA16(as, qf0, in_[v][0]); in_[v][1] = MFMA16(as, qf1, in_[v][1]); } }
            f32x4 sc00 = {0.f, 0.f, 0.f, 0.f}, sc01 = sc00, sc11 = sc00, qa0 = sc00, qa1 = sc00;
#pragma unroll
            for (int ks_ = 0; ks_ < 4; ++ks_) { const int co = (32 * ks_ + 8 * g) * 2;
                const bf16x8 a0 = *(const LAS bf16x8*)(L + OFFB_K + i16 * CH_RS + co), a1 = *(const LAS bf16x8*)(L + OFFB_K + (16 + i16) * CH_RS + co);
                const bf16x8 b0 = *(const LAS bf16x8*)(L + OFFB_Q + i16 * CH_RS + co), b1 = *(const LAS bf16x8*)(L + OFFB_Q + (16 + i16) * CH_RS + co);
                const bf16x8 nf = *(const LAS bf16x8*)(NVb + co);
                sc00 = MFMA16(a0, b0, sc00); sc01 = MFMA16(a0, b1, sc01); sc11 = MFMA16(a1, b1, sc11); qa0 = MFMA16(nf, b0, qa0); qa1 = MFMA16(nf, b1, qa1); }
            const float bt0 = BB[i16], bt1 = BB[16 + i16], dec = BB[31];
            const f32x4 ls0 = *(const LAS f32x4*)(LI + 4 * g), ls1 = *(const LAS f32x4*)(LI + 16 + 4 * g);
#pragma unroll
            for (int r = 0; r < 4; ++r) { const bool keep = (4 * g + r) <= i16;
                sc00[r] = keep ? sc00[r] * (bt0 * ls0[r]) : 0.f;
                sc01[r] = sc01[r] * (bt1 * ls0[r]);
                sc11[r] = keep ? sc11[r] * (bt1 * ls1[r]) : 0.f; }
            const bf16x8 pb0 = pack8(sc00, (f32x4){0.f, 0.f, 0.f, 0.f}), pb1 = pack8(sc01, sc11);
            const bf16x8 ones = {0x3F80, 0x3F80, 0x3F80, 0x3F80, 0x3F80, 0x3F80, 0x3F80, 0x3F80};
            const float dsum0 = MFMA16(ones, pb0, z4)[0], dsum1 = MFMA16(ones, pb1, z4)[0], qn0 = qa0[0], qn1 = qa1[0];
            const float den0 = dsum0 + bt0 * qn0, den1 = dsum1 + bt1 * qn1;
            const float s0 = __builtin_amdgcn_rcpf(fmaxf(fabsf(den0), 1.f)), s1 = __builtin_amdgcn_rcpf(fmaxf(fabsf(den1), 1.f));
#pragma unroll
            for (int v = 0; v < 2; ++v) { const LAS char* vrow = L + OFFB_VT + (32 * cw + 16 * v + i16) * 8;
                const bf16x8 av = ld2x8(vrow + g * CH_GS, vrow + (4 + g) * CH_GS);
                o[v][0] = MFMA16(av, pb0, z4); o[v][1] = MFMA16(av, pb1, z4); }
            { CB_SEG(ch, len_, rb_, nlo_); (void)len_;
              const int ra = rb_ + nlo_ + (dir ? 31 - i16 : i16), rbw = rb_ + nlo_ + (dir ? 15 - i16 : 16 + i16);
#pragma unroll
              for (int v = 0; v < 2; ++v) { const int col = h * 128 + 32 * cw + 16 * v + 4 * g;
                  const f32x4 x0 = (o[v][0] + in_[v][0] * bt0) * s0, x1 = (o[v][1] + in_[v][1] * bt1) * s1;
                  u32x2 w0 = {cvt_pk_bf16(x0[0], x0[1]), cvt_pk_bf16(x0[2], x0[3])}, w1 = {cvt_pk_bf16(x1[0], x1[1]), cvt_pk_bf16(x1[2], x1[3])};
                  *(u32x2*)(OB + (size_t)ra * 512 + col) = w0; *(u32x2*)(OB + (size_t)rbw * 512 + col) = w1; } }
            bf16x8 bvt[2];
#pragma unroll
            for (int v = 0; v < 2; ++v) { const LAS char* vrow = L + OFFB_VT + (32 * cw + 16 * v + i16) * 8; bvt[v] = ld2x8(vrow + 2 * g * CH_GS, vrow + (2 * g + 1) * CH_GS); }
#pragma unroll
            for (int cb = 0; cb < 8; ++cb) { const LAS char* kp = L + OFFB_KWT + (16 * cb + i16) * 8 + 2 * g * CH_GS; const bf16x8 a = ld2x8(kp, kp + CH_GS);
                S[0][cb] = MFMA16(a, bvt[0], S[0][cb] * dec); S[1][cb] = MFMA16(a, bvt[1], S[1][cb] * dec); }
#pragma unroll
            for (int q = 0; q < 2; ++q) { const int cbn = 2 * cw + q; const LAS char* kp = L + OFFB_KWT + (16 * cbn + i16) * 8 + 2 * g * CH_GS; const f32x4 ns = MFMA16(ld2x8(kp, kp + CH_GS), ones, z4);
                if (i16 == 0) { const int c4 = 16 * cbn + 4 * g; const f32x4 nn = ns + *(const LAS f32x4*)(NVc + c4) * dec; *(LAS f32x4*)(NVn + c4) = nn;
                    *(LAS u32x2*)(L0 + OFFB_NV + 1024 + ((ch + 1) & 1) * 256 + c4 * 2) = (u32x2){cvt_pk_bf16(nn[0], nn[1]), cvt_pk_bf16(nn[2], nn[3])}; } }
            if (ch + 2 < 72) { CB2_MAINW(ch & 1, ci, 0); CB2_MAINW(ch & 1, ci + 256, 1); CB2_HALOW(ch & 1, ci, 0); }
            if (ch + 3 < 72) { CB2_MAIN(ch + 3, ci, 0); CB2_MAIN(ch + 3, ci + 256, 1); CB2_HALO(ch + 3, ci, 0); }
            __syncthreads();
        }
        __builtin_amdgcn_s_setprio(0);
    }
#undef CB_SEG
#undef CB2_MAIN
#undef CB2_MAINW
#undef CB2_HALO
#undef CB2_HALOW
}

__device__ __forceinline__ void phase_mix(Frame& F, int l) {
    volatile LAS unsigned* MISC = (volatile LAS unsigned*)(F.lds + LDSCTL_OFF);
    for (;;) {
        if (F.tid == 0) MISC[16] = __hip_atomic_fetch_add(F.ctl + CW_QUEUE + 64 * l, 1u, RLX_AGENT);
        __syncthreads();
        const int idx = (int)MISC[16];
        __syncthreads();
#if defined(TSEL) && TSEL >= 30
        if (idx >= 705) break;
        if (idx == 704) { if (l == 0) { Frame Fi = fresh(F); unsigned t0d = 0; if (F.tid == 0) t0d = (unsigned)__builtin_amdgcn_s_memrealtime();
            chain_b<0, TSEL - 30>(Fi, l, 0);
            if (F.tid == 0) MISC[224 + (TSEL % 32)] = (unsigned)__builtin_amdgcn_s_memrealtime() - t0d; } continue; }
#else
        if (idx >= 704) break;
#endif
#if defined(TSEL) && TSEL >= 20 && TSEL < 30
        const bool timed_ = (l == 0) && (idx == (TSEL == 20 ? 0 : TSEL == 21 ? 64 : TSEL == 22 ? 128 : 300));
        unsigned t0_ = 0; if (timed_ && F.tid == 0) t0_ = (unsigned)__builtin_amdgcn_s_memrealtime();
#endif
#ifndef MIXMASK
#define MIXMASK 7
#endif
        if (idx < 64) { if (MIXMASK & 1) { Frame Fi = fresh(F); if (idx & 1) chain_a2<1>(Fi, l, idx); else chain_a2<0>(Fi, l, idx); } }
        else if (idx < 128) { if (MIXMASK & 2) { Frame Fi = fresh(F); if (idx & 1) chain_b2<1>(Fi, l, idx - 64); else chain_b2<0>(Fi, l, idx - 64); } }
        else if (!(MIXMASK & 4)) {}
        else if (idx < 640) { Frame Fi = fresh(F); const bf16* P = (const bf16*)(Fi.ws + WS_R1); bf16* OC = (bf16*)(Fi.ws + WS_R2); const int u = idx - 128, qb = u & 7, cm = (u >> 3) & 1, h = (u >> 4) & 3, b = u >> 6;
            const size_t r0 = (size_t)b * RPB + TC + qb * 256, k0 = (size_t)b * RPB;
            att::attn_unit(P + r0 * NP + PC_Q + h * 128 + cm * 64, P + k0 * NP + PC_K + h * 128 + cm * 64, P + k0 * NP + PC_V + h * 128, OC + r0 * D + (h * 2 + cm) * 128, RPB, (char*)Fi.lds_generic, Fi.tid); }
        else { Frame Fi = fresh(F); const bf16* P = (const bf16*)(Fi.ws + WS_R1); bf16* OC = (bf16*)(Fi.ws + WS_R2); const int u = idx - 640, cm = u & 1, h = (u >> 1) & 3, b = u >> 3; const size_t r0 = (size_t)b * RPB;
            att::attn_unit(P + r0 * NP + PC_Q + h * 128 + cm * 64, P + r0 * NP + PC_K + h * 128 + cm * 64, P + r0 * NP + PC_V + h * 128, OC + r0 * D + (h * 2 + cm) * 128, TC, (char*)Fi.lds_generic, Fi.tid); }
#if defined(TSEL) && TSEL >= 20 && TSEL < 30
        if (timed_ && F.tid == 0) MISC[224 + (TSEL % 32)] = (unsigned)__builtin_amdgcn_s_memrealtime() - t0_;
#endif
    }
}

__device__ __forceinline__ float head_rstd(float ss) {
    return rsqrtf(row_sum(ss) * (1.f / 128.f) + EPS);
}
__device__ __forceinline__ void unpack8(const u32x4 w, float (&v)[8]) { v[0] = bflo(w.x); v[1] = bfhi(w.x); v[2] = bflo(w.y); v[3] = bfhi(w.y); v[4] = bflo(w.z); v[5] = bfhi(w.z); v[6] = bflo(w.w); v[7] = bfhi(w.w); }
__device__ __forceinline__ u32x4 pack8f(const float (&v)[8]) { u32x4 w; w.x = cvt_pk_bf16(v[0], v[1]); w.y = cvt_pk_bf16(v[2], v[3]); w.z = cvt_pk_bf16(v[4], v[5]); w.w = cvt_pk_bf16(v[6], v[7]); return w; }
__device__ __forceinline__ void phase_prep(Frame& F, int l) {
    const int gw = F.bid * NWAVES + F.wave, NGW = F.G * NWAVES, lane = F.lane, c8 = 8 * lane, head = lane >> 4;
    bf16* P = (bf16*)(F.ws + WS_R1);
    const bf16* OC = (const bf16*)(F.ws + WS_R2); const bf16* OA = (const bf16*)(F.ws + WS_R2 + 36 * MiB); const bf16* OB = (const bf16*)(F.ws + WS_R2 + 72 * MiB);
    const float lam_init = 0.8f - 0.6f * expf(-0.3f * (float)l);
    const float* lv = F.in[I_LAM] + l * 256;
    const float lam = expf(wave_sum(lv[lane] * lv[64 + lane])) - expf(wave_sum(lv[128 + lane] * lv[192 + lane])) + lam_init;
    float ag[8], bg[8], cg[8];
#pragma unroll
    for (int e = 0; e < 8; ++e) { ag[e] = F.in[I_AG][l * 512 + c8 + e]; bg[e] = F.in[I_BG][l * 512 + c8 + e]; cg[e] = F.in[I_CG][l * 512 + c8 + e] * (1.f - lam_init); }
    for (int r = gw; r < M; r += NGW) {
        if (l == 1 && (r % RPB) < TC) continue;
        bf16* pr = P + (size_t)r * NP;
        float a0[8], a1[8], gt[8], y[8];
        unpack8(*(const u32x4*)(OA + (size_t)r * 512 + c8), a0); unpack8(*(const u32x4*)(OA + (size_t)M * 512 + (size_t)r * 512 + c8), a1); unpack8(*(const u32x4*)(pr + PA_G + c8), gt);
        float ss = 0.f;
#pragma unroll
        for (int e = 0; e < 8; ++e) { a0[e] += a1[e]; ss += a0[e] * a0[e]; }
        float rs = head_rstd(ss);
#pragma unroll
        for (int e = 0; e < 8; ++e) y[e] = a0[e] * rs * ag[e] * gt[e];
        u32x4 ya; if ((F8BR >> l) & 1) { ya.x = pk_fp8x4(F8_SY * y[0], F8_SY * y[1], F8_SY * y[2], F8_SY * y[3]); ya.y = pk_fp8x4(F8_SY * y[4], F8_SY * y[5], F8_SY * y[6], F8_SY * y[7]); ya.z = 0; ya.w = 0; } else ya = pack8f(y);
        unpack8(*(const u32x4*)(OB + (size_t)r * 512 + c8), a0); unpack8(*(const u32x4*)(OB + (size_t)M * 512 + (size_t)r * 512 + c8), a1); unpack8(*(const u32x4*)(pr + PB_O + c8), gt);
        ss = 0.f;
#pragma unroll
        for (int e = 0; e < 8; ++e) { a0[e] += a1[e]; ss += a0[e] * a0[e]; }
        rs = head_rstd(ss);
#pragma unroll
        for (int e = 0; e < 8; ++e) y[e] = a0[e] * rs * bg[e] * gt[e];
        u32x4 yb; if ((F8BR >> l) & 1) { yb.x = pk_fp8x4(F8_SY * y[0], F8_SY * y[1], F8_SY * y[2], F8_SY * y[3]); yb.y = pk_fp8x4(F8_SY * y[4], F8_SY * y[5], F8_SY * y[6], F8_SY * y[7]); yb.z = 0; yb.w = 0; } else yb = pack8f(y);
        unpack8(*(const u32x4*)(OC + (size_t)r * D + (head * 2) * 128 + (c8 & 127)), a0); unpack8(*(const u32x4*)(OC + (size_t)r * D + (head * 2 + 1) * 128 + (c8 & 127)), a1);
        ss = 0.f;
#pragma unroll
        for (int e = 0; e < 8; ++e) { a0[e] -= lam * a1[e]; ss += a0[e] * a0[e]; }
        rs = head_rstd(ss);
#pragma unroll
        for (int e = 0; e < 8; ++e) y[e] = a0[e] * rs * cg[e];
        if ((F8BR >> l) & 1) {
            u32x2 yc; yc.x = pk_fp8x4(F8_SY * y[0], F8_SY * y[1], F8_SY * y[2], F8_SY * y[3]); yc.y = pk_fp8x4(F8_SY * y[4], F8_SY * y[5], F8_SY * y[6], F8_SY * y[7]);
            unsigned char* pb = (unsigned char*)pr; *(u32x2*)(pb + c8) = (u32x2){ya.x, ya.y}; *(u32x2*)(pb + 512 + c8) = (u32x2){yb.x, yb.y}; *(u32x2*)(pb + 1024 + c8) = yc;
        } else {
        const u32x4 yc = pack8f(y);
        *(u32x4*)(pr + c8) = ya; *(u32x4*)(pr + 512 + c8) = yb; *(u32x4*)(pr + 1024 + c8) = yc; }
    }
}

constexpr int N2_WCH = 32768, N2_WROW = 272, N2_WBUF = 2 * 48 * N2_WROW;
__device__ __forceinline__ void phase_norm2(Frame& F, int l) {
    const int gw = F.bid * NWAVES + F.wave, NGW = F.G * NWAVES, lane = F.lane, i16 = lane & 15, g = lane >> 4, tid = F.tid;
    const float* X = (const float*)(F.ws + WS_X); bf16* H = (bf16*)(F.ws + WS_H); bf16* LO = (bf16*)(F.ws + WS_R2);
    const float* ng = F.in[I_N2G] + l * 1024;
    const bf16* wrt = (const bf16*)(F.ws + WS_WRT);
    unsigned* cnt = F.ctl + CW_ECNT + 2048 * l;
    LAS unsigned* lcnt = (LAS unsigned*)(F.lds + 147456); LAS unsigned* gbase = lcnt + 32; LAS unsigned* lrank = lcnt + 64;
    LAS float* LG = (LAS float*)F.lds + F.wave * (16 * 48);
    LAS char* WL = (LAS char*)F.lds + N2_WCH;
    if (tid < 32) lcnt[tid] = 0u;
    u32x4 wreg[3];
#define N2_WLOAD(kc) do { _Pragma("unroll") for (int j = 0; j < 3; ++j) { const int idx = tid + 512 * j, which = idx / 768, rem = idx % 768, row = rem >> 4, seg = rem & 15; \
        wreg[j] = *(const u32x4*)(wrt + (size_t)which * 48 * 1024 + (size_t)row * 1024 + (kc) * 128 + seg * 8); } } while (0)
#define N2_WWRITE(buf) do { _Pragma("unroll") for (int j = 0; j < 3; ++j) { const int idx = tid + 512 * j, which = idx / 768, rem = idx % 768, row = rem >> 4, seg = rem & 15; \
        *(LAS u32x4*)(WL + (buf) * N2_WBUF + (which * 48 + row) * N2_WROW + seg * 16) = wreg[j]; } } while (0)
    N2_WLOAD(0);
    {
        f32x4 gnv[4];
#pragma unroll
        for (int q = 0; q < 4; ++q) gnv[q] = *(const f32x4*)(ng + 4 * lane + 256 * q);
        f32x4 xn[4];
        { const int r0 = gw; if (!(l == 1 && (r0 % RPB) < TC)) { const f32x4* xp = (const f32x4*)(X + (size_t)r0 * D) + lane;
#pragma unroll
            for (int q = 0; q < 4; ++q) xn[q] = xp[64 * q]; } }
        for (int j = 0; j < 9; ++j) { const int r = gw + j * NGW, rn = r + NGW;
            const bool ok = !(l == 1 && (r % RPB) < TC), okn = (j + 1 < 9) && !(l == 1 && (rn % RPB) < TC);
            f32x4 xv[4];
#pragma unroll
            for (int q = 0; q < 4; ++q) xv[q] = xn[q];
            const float* mod = ws_mod(F, l, row_mi(r));
            f32x4 shv[4], scv[4];
            if (ok) {
#pragma unroll
                for (int q = 0; q < 4; ++q) { const int c0 = 4 * lane + 256 * q; shv[q] = *(const f32x4*)(mod + 3072 + c0); scv[q] = *(const f32x4*)(mod + 4096 + c0); } }
            if (okn) { const f32x4* xp = (const f32x4*)(X + (size_t)rn * D) + lane;
#pragma unroll
                for (int q = 0; q < 4; ++q) xn[q] = xp[64 * q]; }
            if (!ok) continue;
            float ss = 0.f;
#pragma unroll
            for (int q = 0; q < 4; ++q) ss += (xv[q].x * xv[q].x + xv[q].y * xv[q].y) + (xv[q].z * xv[q].z + xv[q].w * xv[q].w);
            const float rstd = rsqrtf(wave_sum(ss) * (1.f / D) + EPS);
#pragma unroll
            for (int q = 0; q < 4; ++q) { const int c0 = 4 * lane + 256 * q;
                float h[4];
#pragma unroll
                for (int e = 0; e < 4; ++e) h[e] = xv[q][e] * rstd * gnv[q][e] * (1.f + scv[q][e]) + shv[q][e];
                u32x2 hi; hi.x = cvt_pk_bf16(h[0], h[1]); hi.y = cvt_pk_bf16(h[2], h[3]);
                u32x2 lo; lo.x = cvt_pk_bf16(h[0] - bflo(hi.x), h[1] - bfhi(hi.x)); lo.y = cvt_pk_bf16(h[2] - bflo(hi.y), h[3] - bfhi(hi.y));
                *(u32x2*)(H + (size_t)r * D + c0) = hi; *(u32x2*)(LO + (size_t)r * D + c0) = lo;
                if ((F8MOE >> l) & 1) *(unsigned*)(F.ws + WS_H8 + (size_t)r * D + c0) = pk_fp8x4(F8_SH * h[0], F8_SH * h[1], F8_SH * h[2], F8_SH * h[3]); }
        }
    }
    asm volatile("s_waitcnt vmcnt(0)" ::: "memory");
    N2_WWRITE(0);
    __syncthreads();
    const int rsel = i16 < 9 ? i16 : i16 - 9;
    const int r = gw + rsel * NGW;
    const bool rowok = !(l == 1 && (r % RPB) < TC);
    const bf16* hrow = H + (size_t)r * D + 8 * g; const bf16* lrow = LO + (size_t)r * D + 8 * g;
    f32x4 acc[3];
#pragma unroll
    for (int ct = 0; ct < 3; ++ct) acc[ct] = (f32x4){0.f, 0.f, 0.f, 0.f};
    bf16x8 ahn[4], aln[4];
#define N2_ALOAD(kc) do { _Pragma("unroll") for (int k4 = 0; k4 < 4; ++k4) { const int c0 = 128 * (kc) + 32 * k4; \
        ahn[k4] = rowok ? *(const bf16x8*)(hrow + c0) : (bf16x8){0, 0, 0, 0, 0, 0, 0, 0}; aln[k4] = rowok ? *(const bf16x8*)(lrow + c0) : (bf16x8){0, 0, 0, 0, 0, 0, 0, 0}; } } while (0)
    N2_ALOAD(0);
    for (int kc = 0; kc < 8; ++kc) {
        if (kc + 1 < 8) N2_WLOAD(kc + 1);
        const LAS char* wb = WL + (kc & 1) * N2_WBUF;
        bf16x8 ah[4], al[4];
#pragma unroll
        for (int k4 = 0; k4 < 4; ++k4) { ah[k4] = ahn[k4]; al[k4] = aln[k4]; }
        if (kc + 1 < 8) N2_ALOAD(kc + 1);
#pragma unroll
        for (int k4 = 0; k4 < 4; ++k4)
#pragma unroll
            for (int ct = 0; ct < 3; ++ct) { const LAS char* wp = wb + (16 * ct + i16) * N2_WROW + (32 * k4 + 8 * g) * 2;
                const bf16x8 bh = *(const LAS bf16x8*)wp, bl = *(const LAS bf16x8*)(wp + 48 * N2_WROW);
                acc[ct] = MFMA16(ah[k4], bh, acc[ct]); acc[ct] = MFMA16(ah[k4], bl, acc[ct]); acc[ct] = MFMA16(al[k4], bh, acc[ct]); }
        if (kc + 1 < 8) N2_WWRITE((kc + 1) & 1);
        __syncthreads();
    }
#undef N2_WLOAD
#undef N2_ALOAD
#undef N2_WWRITE
#pragma unroll
    for (int ct = 0; ct < 3; ++ct)
#pragma unroll
        for (int e = 0; e < 4; ++e) LG[(4 * g + e) * 48 + 16 * ct + i16] = acc[ct][e];
    LDS_WAIT(); asm volatile("" ::: "memory");
    if (lane < 9) { const int rr = gw + lane * NGW;
        if (!(l == 1 && (rr % RPB) < TC)) {
            const LAS float* lgp = LG + lane * 48;
            float gl[4];
#pragma unroll
            for (int q = 0; q < 4; ++q) gl[q] = lgp[q] + F.in[I_RGB][l * 4 + q];
            int gi = 0; float gm = gl[0];
#pragma unroll
            for (int q = 1; q < 4; ++q) if (gl[q] > gm) { gm = gl[q]; gi = q; }
            float gs = 0.f;
#pragma unroll
            for (int q = 0; q < 4; ++q) gs += expf(gl[q] - gm);
            const float pg = 1.f / gs;
            float el[8];
#pragma unroll
            for (int q = 0; q < 8; ++q) el[q] = lgp[4 + gi * 8 + q] + F.in[I_REB][l * 32 + gi * 8 + q];
            int i0 = 0; float m0 = el[0];
#pragma unroll
            for (int q = 1; q < 8; ++q) if (el[q] > m0) { m0 = el[q]; i0 = q; }
            int i1 = -1; float m1 = -3.0e38f;
#pragma unroll
            for (int q = 0; q < 8; ++q) if (q != i0 && el[q] > m1) { m1 = el[q]; i1 = q; }
            const float t = expf(m1 - m0);
            const float w0 = pg / (1.f + t), w1 = pg * t / (1.f + t);
            const int e0 = gi * 8 + i0, e1 = gi * 8 + i1;
            const unsigned p0 = __hip_atomic_fetch_add(lcnt + e0, 1u, __ATOMIC_RELAXED, __HIP_MEMORY_SCOPE_WORKGROUP), p1 = __hip_atomic_fetch_add(lcnt + e1, 1u, __ATOMIC_RELAXED, __HIP_MEMORY_SCOPE_WORKGROUP);
            LAS unsigned* lr = lrank + (F.wave * 9 + lane) * 4; lr[0] = p0; lr[1] = p1; lr[2] = (unsigned)e0; lr[3] = (unsigned)e1;
            int* rt = (int*)(F.ws + WS_ROUTE) + (size_t)rr * 8; rt[0] = e0; rt[1] = e1; ((float*)rt)[4] = w0; ((float*)rt)[5] = w1; }
    }
    __syncthreads();
    if (tid < 32) gbase[tid] = __hip_atomic_fetch_add(cnt + 64 * tid, lcnt[tid], RLX_AGENT);
    __syncthreads();
    if (lane < 9) { const int rr = gw + lane * NGW;
        if (!(l == 1 && (rr % RPB) < TC)) { int* rt = (int*)(F.ws + WS_ROUTE) + (size_t)rr * 8; const LAS unsigned* lr = lrank + (F.wave * 9 + lane) * 4;
            const int p0 = (int)(gbase[lr[2]] + lr[0]), p1 = (int)(gbase[lr[3]] + lr[1]); rt[2] = p0; rt[3] = p1;
            int* rowof = (int*)(F.ws + WS_R1); rowof[(size_t)lr[2] * ECAP + p0] = rr; rowof[(size_t)lr[3] * ECAP + p1] = rr; } }
    __syncthreads();
}

__device__ __forceinline__ int expert_pstart(const unsigned* cnt, int e) {
    int s = 0;
    for (int q = 0; q < e; ++q) s += (int)((cnt[64 * q] + 255u) & ~255u);
    return s;
}
__device__ __forceinline__ void phase_dispatch(Frame& F, int l) {
    const int gw = F.bid * NWAVES + F.wave, NGW = F.G * NWAVES, lane = F.lane;
    const unsigned* cnt = F.ctl + CW_ECNT + 2048 * l;
    LAS int* pst = (LAS int*)F.lds;
    if (F.tid < 32) pst[32 + F.tid] = (int)((cnt[64 * F.tid] + 255u) & ~255u);
    __syncthreads();
    if (F.tid == 0) { int s = 0; for (int e = 0; e < NEXP; ++e) { pst[e] = s; s += pst[32 + e]; } }
    __syncthreads();
    const bf16* H = (const bf16*)(F.ws + WS_H); bf16* XD = (bf16*)(F.ws + WS_R1);
    for (int r = gw; r < M; r += NGW) {
        if (l == 1 && (r % RPB) < TC) continue;
        int* rt = (int*)(F.ws + WS_ROUTE) + (size_t)r * 8;
        const int e0 = rt[0], e1 = rt[1], p0 = rt[2], p1 = rt[3];
        const int s0 = pst[e0] + p0, s1 = pst[e1] + p1;
        const u32x4* hp = (const u32x4*)(H + (size_t)r * D) + lane; const u32x4 v0 = hp[0], v1 = hp[64];
        u32x4* d0 = (u32x4*)(XD + (size_t)s0 * D) + lane; d0[0] = v0; d0[64] = v1;
        u32x4* d1 = (u32x4*)(XD + (size_t)s1 * D) + lane; d1[0] = v0; d1[64] = v1;
        if (lane == 0) { rt[6] = s0; rt[7] = s1; }
    }
    __syncthreads();
}
__device__ __forceinline__ int build_tile_table(Frame& F, int l) {
    volatile LAS unsigned* MISC = (volatile LAS unsigned*)(F.lds + LDSCTL_OFF);
    const unsigned* cnt = F.ctl + CW_ECNT + 2048 * l;
    if (F.tid < 32) MISC[288 + F.tid] = cnt[64 * F.tid];
    __syncthreads();
    if (F.tid == 0) { int t = 0; for (int e = 0; e < NEXP; ++e) { MISC[256 + e] = (unsigned)t; const int nt = (int)((MISC[288 + e] + 255u) >> 8); for (int k = 0; k < nt && t < 176; ++k) MISC[32 + t++] = (unsigned)e; } MISC[17] = (unsigned)t; }
    __syncthreads();
    return (int)MISC[17];
}

__device__ __forceinline__ void phase_combine(Frame& F, int l) {
    const int gw = F.bid * NWAVES + F.wave, lane = F.lane;
    float* X = (float*)(F.ws + WS_X); const bf16* YM = (const bf16*)(F.ws + WS_R2);
    (void)build_tile_table(F, l);
    volatile LAS unsigned* MISCc = (volatile LAS unsigned*)(F.lds + LDSCTL_OFF);
    if (l == 0) stage_gate_w(F, 1);
    const int nrows = l == 0 ? 9 : 8;
#define CMB_ROW(j_) (l == 0 ? gw * 9 + (j_) : ((gw * 8 + (j_)) >> 11) * RPB + TC + ((gw * 8 + (j_)) & 2047))
    f32x4 gv[4];
#pragma unroll
    for (int j = 0; j < 4; ++j) gv[j] = *(const f32x4*)((l == 0 ? F.in[I_N1G] + 1024 : F.in[I_FING]) + 4 * lane + 256 * j);
    const float gateb = F.in[I_GATEB][16 + (lane & 15)];
    int mi_cur = -1; f32x4 g2v[4], shv[4], scvv[4];
    u32x2 ya[4], yb[4], yan[4], ybn[4]; f32x4 xc[4], xn[4]; float w0 = 0.f, w1 = 0.f, w0n = 0.f, w1n = 0.f;
    int e0n, e1n, p0n, p1n; float wan, wbn;
#define CMB_RT(r_) do { const int* rt_ = (const int*)(F.ws + WS_ROUTE) + (size_t)(r_) * 8; e0n = rt_[0]; e1n = rt_[1]; p0n = rt_[2]; p1n = rt_[3]; wan = ((const float*)rt_)[4]; wbn = ((const float*)rt_)[5]; } while (0)
#define CMB_ISSUE(r_) do { const int s0_ = ((int)MISCc[256 + e0n] + (p0n >> 8)) * 256 + (p0n & 255), s1_ = ((int)MISCc[256 + e1n] + (p1n >> 8)) * 256 + (p1n & 255); w0n = wan; w1n = wbn; \
        _Pragma("unroll") for (int j = 0; j < 4; ++j) { const int c0 = 4 * lane + 256 * j; yan[j] = *(const u32x2*)(YM + (size_t)s0_ * D + c0); ybn[j] = *(const u32x2*)(YM + (size_t)s1_ * D + c0); \
            xn[j] = *((const f32x4*)(X + (size_t)(r_) * D) + lane + 64 * j); } } while (0)
    CMB_RT(CMB_ROW(0)); CMB_ISSUE(CMB_ROW(0));
    if (nrows > 1) CMB_RT(CMB_ROW(1));
    for (int jr = 0; jr < nrows; ++jr) { const int r = CMB_ROW(jr);
#pragma unroll
        for (int j = 0; j < 4; ++j) { ya[j] = yan[j]; yb[j] = ybn[j]; xc[j] = xn[j]; }
        w0 = w0n; w1 = w1n;
        if (jr + 1 < nrows) CMB_ISSUE(CMB_ROW(jr + 1));
        if (jr + 2 < nrows) CMB_RT(CMB_ROW(jr + 2));
        const int mi = row_mi(r);
        if (mi != mi_cur) { mi_cur = mi; const float* modl = ws_mod(F, l, mi); const float* mod1 = ws_mod(F, 1, mi);
#pragma unroll
            for (int j = 0; j < 4; ++j) { const int c0 = 4 * lane + 256 * j; g2v[j] = *(const f32x4*)(modl + 5120 + c0);
                if (l == 0) { shv[j] = *(const f32x4*)(mod1 + c0); scvv[j] = *(const f32x4*)(mod1 + 1024 + c0); } } }
        f32x4 xv[4];
#pragma unroll
        for (int j = 0; j < 4; ++j) { const u32x2 a = ya[j], b = yb[j]; const f32x4 g = g2v[j]; f32x4 x = xc[j];
            x.x += g.x * (w0 * bflo(a.x) + w1 * bflo(b.x)); x.y += g.y * (w0 * bfhi(a.x) + w1 * bfhi(b.x));
            x.z += g.z * (w0 * bflo(a.y) + w1 * bflo(b.y)); x.w += g.w * (w0 * bfhi(a.y) + w1 * bfhi(b.y));
            xv[j] = x; }
        if (l == 0) {
            f32x4* xp = (f32x4*)(X + (size_t)r * D) + lane;
#pragma unroll
            for (int j = 0; j < 4; ++j) xp[64 * j] = xv[j];
            norm1_row(F, 1, r, xv, gv, shv, scvv, gateb);
        } else {
            const int b = r / RPB, s = r - b * RPB;
            float ss = 0.f;
#pragma unroll
            for (int j = 0; j < 4; ++j) ss += (xv[j].x * xv[j].x + xv[j].y * xv[j].y) + (xv[j].z * xv[j].z + xv[j].w * xv[j].w);
            const float rstd = rsqrtf(wave_sum(ss) * (1.f / D) + EPS);
            f32x4* op = (f32x4*)(F.out + ((size_t)b * TL + (s - TC)) * D) + lane;
#pragma unroll
            for (int j = 0; j < 4; ++j) op[64 * j] = xv[j] * rstd * gv[j];
        }
    }
#undef CMB_ROW
#undef CMB_RT
#undef CMB_ISSUE
    __syncthreads();
}

__device__ __forceinline__ void dbg_final(Frame& Fp) {
    const int gw = Fp.bid * NWAVES + Fp.wave, NGW = Fp.G * NWAVES;
    const float* X = (const float*)(Fp.ws + WS_X);
    for (int r = gw; r < M; r += NGW) { const int b = r / RPB, s = r - b * RPB; if (s < TC) continue;
        f32x4 xv[4]; const f32x4* xp = (const f32x4*)(X + (size_t)r * D) + Fp.lane; float ss = 0.f;
#pragma unroll
        for (int j = 0; j < 4; ++j) { xv[j] = xp[64 * j]; ss += (xv[j].x * xv[j].x + xv[j].y * xv[j].y) + (xv[j].z * xv[j].z + xv[j].w * xv[j].w); }
        const float rstd = rsqrtf(wave_sum(ss) * (1.f / D) + EPS);
        f32x4* op = (f32x4*)(Fp.out + ((size_t)b * TL + (s - TC)) * D) + Fp.lane;
#pragma unroll
        for (int j = 0; j < 4; ++j) { const f32x4 g = *(const f32x4*)(Fp.in[I_FING] + 4 * Fp.lane + 256 * j); op[64 * j] = xv[j] * rstd * g; } }
}
#ifdef TSEL
#define TSTAMP(cat) do { if (F.tid == 0) { const unsigned now_ = (unsigned)__builtin_amdgcn_s_memrealtime(); MISC[224 + (cat)] += now_ - MISC[223]; MISC[223] = now_; } } while (0)
#else
#define TSTAMP(cat) do { } while (0)
#endif
#define GRID_BAR() do { XcdBarrier bb_; bb_.bar = (unsigned*)((unsigned char*)(GAS unsigned char*)opaque_ptr((unsigned long long)F.ws) + WS_CTL) + CW_BAR; bb_.x = xb_xcc_id(); bb_.st = MISC + 8; xcd_barrier(bb_); } while (0)
#ifndef PHMASK
#define PHMASK 0xffff
#endif
#define ON(k) ((PHMASK >> (k)) & 1)
template <int l> __device__ __forceinline__ void layer_body(Frame& F, volatile LAS unsigned* MISC) {
        if (ON(2)) {
            Frame Fp = fresh(F); bf16* Wb = (bf16*)(Fp.ws + WS_W);
            pg8::Gemm g{(bf16*)(Fp.ws + WS_H), Wb + W_IN / 2, 1024, 1024, 1024}; pg8::StaticOrder S; S.init(M, NP, Fp.G, Fp.bid);
            EpiInProj E{(bf16*)(Fp.ws + WS_R1), (const float*)(Fp.ws + WS_ROPE)};
            pg8::gemm_phase(Fp.lds, Fp.tid, g, S, E);
        }
        GRID_BAR(); TSTAMP(1);
        if (ON(3)) { Frame Fp = fresh(F); phase_mix(Fp, l); }
        GRID_BAR(); TSTAMP(2);
        if (ON(4)) { Frame Fp = fresh(F); phase_prep(Fp, l); }
        GRID_BAR(); TSTAMP(11);
        if (ON(5)) {
            Frame Fp = fresh(F); bf16* Wb = (bf16*)(Fp.ws + WS_W);
            constexpr bool f8 = (F8BR >> l) & 1;
            pg8::Gemm g{(bf16*)(Fp.ws + WS_R1), Wb + W_BR / 2, f8 ? 256 : 512, NP, f8 ? 256 : 512}; pg8::StaticOrder S; S.init(l == 1 ? NB * TL : M, 1024, Fp.G, Fp.bid, 3, (size_t)512 * (f8 ? 1 : 2), (size_t)1024 * 512 * (f8 ? 1 : 2), l == 1);
            if constexpr (f8) { EpiPlainS E{(bf16*)(Fp.ws + WS_R2), 3072, 0, 1024, 1.f / (F8_SY * F8_SW)}; pg8::gemm_phase<EpiPlainS, pg8::StaticOrder, false, true>(Fp.lds, Fp.tid, g, S, E); }
            else { EpiPlain E{(bf16*)(Fp.ws + WS_R2), 3072, 0, 1024}; pg8::gemm_phase(Fp.lds, Fp.tid, g, S, E); }
        }
        GRID_BAR(); TSTAMP(3);
        if (ON(6)) {
            Frame Fp = fresh(F); bf16* Wb = (bf16*)(Fp.ws + WS_W);
            constexpr bool f8 = (F8GT >> l) & 1;
            pg8::Gemm g{(bf16*)(Fp.ws + (f8 ? WS_HG8 : WS_H)), Wb + W_GP / 2, f8 ? 512 : 1024, f8 ? 512 : 1024, f8 ? 512 : 1024}; pg8::StaticOrder S; S.init(l == 1 ? NB * TL : M, 4096, Fp.G, Fp.bid, 1, 0, 0, l == 1);
            EpiGates<f8> E{(bf16*)(Fp.ws + WS_R2), (bf16*)(Fp.ws + WS_R1), Fp.in[I_BGATE] + l * 3072};
            pg8::gemm_phase<EpiGates<f8>, pg8::StaticOrder, true, f8>(Fp.lds, Fp.tid, g, S, E);
        }
        GRID_BAR(); TSTAMP(3);
        if (ON(7)) {
            Frame Fp = fresh(F); bf16* Wb = (bf16*)(Fp.ws + WS_W);
            pg8::Gemm g{(bf16*)(Fp.ws + WS_R1), Wb + W_OUT / 2, 1024, 1024, 1024}; pg8::StaticOrder S; S.init(l == 1 ? NB * TL : M, 1024, Fp.G, Fp.bid, 1, 0, 0, l == 1);
            EpiOut E{(float*)(Fp.ws + WS_X), ws_mod(Fp, l, 0), l == 0 ? Fp.in[I_X] : nullptr, l == 0 ? Fp.in[I_CTX] : nullptr};
            pg8::gemm_phase(Fp.lds, Fp.tid, g, S, E);
        }
        GRID_BAR(); TSTAMP(3);
#if defined(DBG_STOP) && DBG_STOP == 7
        { Frame Fp = fresh(F); dbg_final(Fp); return; }
#endif
        if (ON(8)) { Frame Fp = fresh(F); phase_norm2(Fp, l); }
        GRID_BAR(); TSTAMP(7);
        if (ON(10)) {
            Frame Fp = fresh(F); bf16* Wb = (bf16*)(Fp.ws + WS_W);
            const int ntiles = build_tile_table(Fp, l);
            constexpr bool f8 = (F8MOE >> l) & 1;
            pg8::Gemm g{(bf16*)(Fp.ws + (f8 ? WS_H8 : WS_H)), Wb + W_13 / 2, f8 ? 512 : 1024, f8 ? 512 : 1024, f8 ? 512 : 1024};
            GroupedOrder S{(const volatile LAS int*)(MISC + 32), (const volatile LAS int*)(MISC + 256), (const volatile LAS int*)(MISC + 288), (const int*)(Fp.ws + WS_R1), ntiles, Fp.G, Fp.bid, (size_t)1024 * 1024 * (f8 ? 1 : 2)};
            EpiMoe1<f8> E{(bf16*)(Fp.ws + WS_R1 + 88 * MiB)};
            pg8::gemm_phase_gather<EpiMoe1<f8>, GroupedOrder, f8>(Fp.lds, Fp.tid, g, S, E);
        }
        GRID_BAR(); TSTAMP(9);
        if (ON(11)) {
            Frame Fp = fresh(F); bf16* Wb = (bf16*)(Fp.ws + WS_W);
            const int ntiles = build_tile_table(Fp, l);
            constexpr bool f8 = (F8MOE >> l) & 1;
            pg8::Gemm g{(bf16*)(Fp.ws + WS_R1 + 88 * MiB), Wb + W_2 / 2, f8 ? 256 : 512, f8 ? 256 : 512, f8 ? 256 : 512};
            GroupedOrder S{(const volatile LAS int*)(MISC + 32), (const volatile LAS int*)(MISC + 256), (const volatile LAS int*)(MISC + 288), (const int*)(Fp.ws + WS_R1), ntiles, Fp.G, Fp.bid, (size_t)1024 * 512 * (f8 ? 1 : 2)};
            if constexpr (f8) { EpiScaled E{(bf16*)(Fp.ws + WS_R2), 1024, 1.f / (F8_SU * F8_SW)}; pg8::gemm_phase<EpiScaled, GroupedOrder, false, true>(Fp.lds, Fp.tid, g, S, E); }
            else { EpiPlain E{(bf16*)(Fp.ws + WS_R2), 1024, 0, 0}; pg8::gemm_phase(Fp.lds, Fp.tid, g, S, E); }
        }
        GRID_BAR(); TSTAMP(10);
        if (ON(12)) { Frame Fp = fresh(F); if (l == 0) { phase_convert(Fp, 1); __syncthreads(); } phase_combine(Fp, l); }
        if (l == 0) GRID_BAR();
        TSTAMP(6);
#if defined(DBG_STOP) && DBG_STOP == 12
        { Frame Fp = fresh(F); dbg_final(Fp); return; }
#endif
}

struct Args { const float* in[29]; float* out; unsigned char* ws; int pad[2]; };
__global__ void __launch_bounds__(NTHR, 2) fwd_kernel(Args args) {
    extern __shared__ __attribute__((aligned(16))) unsigned char lds[];
    Frame F;
    F.lds = (LAS unsigned char*)lds; F.lds_generic = lds;
    F.ws = args.ws; F.ctl = (unsigned*)(args.ws + WS_CTL);
    F.tid = threadIdx.x; F.lane = F.tid & 63; F.wave = __builtin_amdgcn_readfirstlane(F.tid >> 6); F.G = gridDim.x; F.bid = blockIdx.x;
    F.in.p = (KargIn)__builtin_amdgcn_kernarg_segment_ptr(); F.out = args.out;
    volatile LAS unsigned* MISC = (volatile LAS unsigned*)(F.lds + LDSCTL_OFF);
    for (int u = F.tid; u < 512; u += NTHR) MISC[u] = 0u;
    __syncthreads();
    (void)xcd_barrier_post(F.ctl + CW_BAR, MISC + 8);
#ifdef TSEL
    if (F.tid == 0) MISC[223] = (unsigned)__builtin_amdgcn_s_memrealtime();
#endif
#ifdef DBG_IDENT
    { { Frame Fp = fresh(F); phase_init(Fp); } GRID_BAR(); GRID_BAR(); Frame Fp = fresh(F); dbg_final(Fp); return; }
#endif
    if (ON(0)) { Frame Fp = fresh(F); phase_convert(Fp, 0); __syncthreads(); phase_init(Fp); }
    GRID_BAR(); TSTAMP(0);
    if (ON(1)) { Frame Fp = fresh(F); phase_norm1(Fp, 0); }
    GRID_BAR(); TSTAMP(5);
    layer_body<0>(F, MISC);
    layer_body<1>(F, MISC);
#ifdef TSEL
    if ((F.bid == 0 || TSEL >= 20) && F.tid == 0 && MISC[224 + (TSEL % 32)] != 0u) { const unsigned long long target = __builtin_amdgcn_s_memrealtime() + 8ull * MISC[224 + (TSEL % 32)];
        while (__builtin_amdgcn_s_memrealtime() < target) __builtin_amdgcn_s_sleep(8); }
#endif
}

extern "C" void kernel_launch(void* const* d_in, const int* in_sizes, int n_in, void* d_out, int out_size, void* d_ws, size_t ws_size, hipStream_t stream) {
    static int grid = 0;
    if (grid == 0) {
        if (n_in != 29 || out_size != NB * TL * D || ws_size < WS_END) { fprintf(stderr, "kernel_launch: unexpected shapes: n_in %d out %d ws %zu (need %zu)\n", n_in, out_size, ws_size, (size_t)WS_END); grid = -1; return; }
        int dev = 0, cus = 0, per_cu = 0;
        if (hipGetDevice(&dev) != hipSuccess || hipDeviceGetAttribute(&cus, hipDeviceAttributeMultiprocessorCount, dev) != hipSuccess) { grid = -1; return; }
        if (hipFuncSetAttribute((const void*)fwd_kernel, hipFuncAttributeMaxDynamicSharedMemorySize, LDS_BYTES) != hipSuccess) { fprintf(stderr, "kernel_launch: hipFuncSetAttribute failed\n"); grid = -1; return; }
        if (hipOccupancyMaxActiveBlocksPerMultiprocessor(&per_cu, (const void*)fwd_kernel, NTHR, LDS_BYTES) != hipSuccess || per_cu < 1) { fprintf(stderr, "kernel_launch: occupancy query says %d blocks per CU\n", per_cu); }
        (void)hipGetLastError();
        if (cus != 256) { fprintf(stderr, "kernel_launch: built for a 256-CU device (row partition of 9 rows per wave), found %d CUs; nothing launched\n", cus); grid = -1; return; }
        grid = cus;
    }
    if (grid < 0) return;
    if (hipMemsetAsync((char*)d_ws + WS_CTL, 0, CTL_ZERO_BYTES, stream) != hipSuccess) return;
    Args a{};
    for (int i = 0; i < 29; ++i) a.in[i] = (const float*)d_in[i];
    a.out = (float*)d_out; a.ws = (unsigned char*)d_ws;
    hipLaunchKernelGGL(fwd_kernel, dim3(grid), dim3(NTHR), LDS_BYTES, stream, a);
}
```
